# Optimizing an MI355X kernel written in HIP

```python
import jax, jax.numpy as jnp
from jax import lax
import numpy as np

D_MODEL = 1024
BATCH = 2
SEQ = 8192
DEPTH = 2

HEAD_DIM = 64
ROT_DIM = HEAD_DIM // 4
ROPE_THETA = 500000.0
ATTN_SCALE = HEAD_DIM ** -0.5
EPS = 1e-6
NEG_INF = -1e30

MOBA_HEADS = 8
FOX_HEADS = 8
MOBA_BLOCK = 256
MOBA_TOPK = 3
MOBA_Q_CHUNK = 64
FOX_Q_BLOCK = 128
A_W = MOBA_HEADS * HEAD_DIM
B_W = FOX_HEADS * HEAD_DIM
EVEN_COLS = 3 * A_W + 4 * B_W + FOX_HEADS
EVEN_MIX_WIDTH = A_W + B_W

SWA_Q_HEADS = 16
SWA_KV_HEADS = 2
SWA_WINDOW = 128
ODD_COLS = (SWA_Q_HEADS + 2 * SWA_KV_HEADS) * HEAD_DIM
ODD_MIX_WIDTH = SWA_Q_HEADS * HEAD_DIM

PEER_HEADS = 8
PEER_N_KEYS = 128
PEER_N_EXPERTS = PEER_N_KEYS * PEER_N_KEYS
PEER_TOPK = 16
PEER_QUERY_DIM = 128
PEER_TOKEN_CHUNK = 128

N_EVEN = (DEPTH + 1) // 2
N_ODD = DEPTH // 2

kernel_name = "hybrid_moba_fox_swa_peer"


def rms_norm(x, g):
    x32 = x.astype(jnp.float32)
    y = x32 * lax.rsqrt(jnp.mean(x32 * x32, axis=-1, keepdims=True) + EPS)
    return y.astype(x.dtype) * g


def rope_tables(seq):
    inv_freq = jnp.power(ROPE_THETA, -jnp.arange(0, ROT_DIM, 2, dtype=jnp.float32) / ROT_DIM)
    ang = jnp.arange(seq, dtype=jnp.float32)[:, None] * inv_freq[None, :]
    return jnp.cos(ang), jnp.sin(ang)


def partial_rope(x, cos, sin):
    x32 = x.astype(jnp.float32)
    half = ROT_DIM // 2
    x1 = x32[..., :half]
    x2 = x32[..., half:ROT_DIM]
    out = jnp.concatenate([x1 * cos - x2 * sin, x2 * cos + x1 * sin, x32[..., ROT_DIM:]], axis=-1)
    return out.astype(x.dtype)


def split_heads(t, n):
    b, s, _ = t.shape
    return t.reshape(b, s, n, HEAD_DIM).transpose(0, 2, 1, 3)


def merge_heads(t):
    b, h, s, d = t.shape
    return t.transpose(0, 2, 1, 3).reshape(b, s, h * d)


def moba_attention(q, k, v):
    B, H, S, D = q.shape
    Sp = -(-S // MOBA_BLOCK) * MOBA_BLOCK
    pad = ((0, 0), (0, 0), (0, Sp - S), (0, 0))
    q, k, v = jnp.pad(q, pad), jnp.pad(k, pad), jnp.pad(v, pad)
    nb = Sp // MOBA_BLOCK
    topk = min(MOBA_TOPK, nb)
    kb = k.reshape(B, H, nb, MOBA_BLOCK, D)
    vb = v.reshape(B, H, nb, MOBA_BLOCK, D)
    kmean = jnp.mean(kb.astype(jnp.float32), axis=3).astype(k.dtype)
    bi = jnp.arange(B)[:, None, None, None]
    hi = jnp.arange(H)[None, :, None, None]
    blk_ids = jnp.arange(nb)

    def step(c):
        start = c * MOBA_Q_CHUNK
        blk = start // MOBA_BLOCK
        qc = lax.dynamic_slice_in_dim(q, start, MOBA_Q_CHUNK, axis=2)
        gate = jnp.einsum('bhqd,bhnd->bhqn', qc, kmean).astype(jnp.float32)
        gate = jnp.where(blk_ids < blk, gate, -jnp.inf)
        _, sel = lax.top_k(gate, topk)
        valid = sel < blk
        ks = kb[bi, hi, sel]
        vs = vb[bi, hi, sel]
        ls = jnp.einsum('bhqd,bhqnkd->bhqnk', qc, ks).astype(jnp.float32) * ATTN_SCALE
        ls = jnp.where(valid[..., None], ls, NEG_INF)
        kown = lax.dynamic_index_in_dim(kb, blk, axis=2, keepdims=False)
        vown = lax.dynamic_index_in_dim(vb, blk, axis=2, keepdims=False)
        lo = jnp.einsum('bhqd,bhkd->bhqk', qc, kown).astype(jnp.float32) * ATTN_SCALE
        qpos = start + jnp.arange(MOBA_Q_CHUNK)
        kpos = blk * MOBA_BLOCK + jnp.arange(MOBA_BLOCK)
        lo = jnp.where(kpos[None, :] <= qpos[:, None], lo, NEG_INF)
        logits = jnp.concatenate([ls.reshape(B, H, MOBA_Q_CHUNK, topk * MOBA_BLOCK), lo], axis=-1)
        p = jax.nn.softmax(logits, axis=-1).astype(v.dtype)
        ps = p[..., :topk * MOBA_BLOCK].reshape(B, H, MOBA_Q_CHUNK, topk, MOBA_BLOCK)
        po = p[..., topk * MOBA_BLOCK:]
        return (jnp.einsum('bhqnk,bhqnkd->bhqd', ps, vs)
                + jnp.einsum('bhqk,bhkd->bhqd', po, vown))

    out = lax.map(step, jnp.arange(Sp // MOBA_Q_CHUNK))
    out = out.transpose(1, 2, 0, 3, 4).reshape(B, H, Sp, D)
    return out[:, :, :S]


def fox_attention(q, k, v, log_F):
    B, H, S, D = q.shape
    kpos = jnp.arange(S)

    def step(i):
        start = i * FOX_Q_BLOCK
        qb = lax.dynamic_slice_in_dim(q, start, FOX_Q_BLOCK, axis=2)
        fq = lax.dynamic_slice_in_dim(log_F, start, FOX_Q_BLOCK, axis=2)
        logits = (jnp.einsum('bhqd,bhkd->bhqk', qb, k).astype(jnp.float32) * ATTN_SCALE
                  + fq[..., :, None] - log_F[:, :, None, :])
        qpos = start + jnp.arange(FOX_Q_BLOCK)
        logits = jnp.where(kpos[None, :] <= qpos[:, None], logits, NEG_INF)
        p = jax.nn.softmax(logits, axis=-1).astype(v.dtype)
        return jnp.einsum('bhqk,bhkd->bhqd', p, v)

    out = lax.map(step, jnp.arange(S // FOX_Q_BLOCK))
    return out.transpose(1, 2, 0, 3, 4).reshape(B, H, S, D)


def sliding_window_attention(q, k, v, sinks):
    B, Hq, S, D = q.shape
    Hkv = k.shape[1]
    G = Hq // Hkv
    W = SWA_WINDOW
    nb = S // W
    qb = q.reshape(B, Hkv, G, nb, W, D)

    def band(t):
        tb = t.reshape(B, Hkv, nb, W, D)
        prev = jnp.concatenate([jnp.zeros_like(tb[:, :, :1]), tb[:, :, :-1]], axis=2)
        return jnp.concatenate([prev, tb], axis=3)

    kc, vc = band(k), band(v)
    logits = jnp.einsum('bkgnqd,bknjd->bkgnqj', qb, kc).astype(jnp.float32) * ATTN_SCALE
    i = jnp.arange(W)[:, None]
    j = jnp.arange(2 * W)[None, :]
    n = jnp.arange(nb)[:, None, None]
    dist = W + i - j
    allowed = (dist >= 0) & (dist < SWA_WINDOW) & (n * W + j - W >= 0)
    logits = jnp.where(allowed, logits, NEG_INF)
    sink = jnp.broadcast_to(sinks.astype(jnp.float32).reshape(1, Hkv, G, 1, 1, 1),
                            logits.shape[:-1] + (1,))
    p = jax.nn.softmax(jnp.concatenate([logits, sink], axis=-1), axis=-1)[..., :2 * W]
    o = jnp.einsum('bkgnqj,bknjd->bkgnqd', p.astype(v.dtype), vc)
    return o.reshape(B, Hq, S, D)


def even_mixer(h, w_in, f_bias, qn_a, kn_a, qn_b, kn_b, w_out, cos, sin):
    proj = h @ w_in
    offs = [A_W, 2 * A_W, 3 * A_W, 3 * A_W + B_W, 3 * A_W + 2 * B_W, 3 * A_W + 3 * B_W, 3 * A_W + 4 * B_W]
    qa, ka, va, qb, kb, vb, gb, fb = jnp.split(proj, offs, axis=-1)
    qa = partial_rope(rms_norm(split_heads(qa, MOBA_HEADS), qn_a), cos, sin)
    ka = partial_rope(rms_norm(split_heads(ka, MOBA_HEADS), kn_a), cos, sin)
    oa = moba_attention(qa, ka, split_heads(va, MOBA_HEADS))
    qb = rms_norm(split_heads(qb, FOX_HEADS), qn_b)
    kb = rms_norm(split_heads(kb, FOX_HEADS), kn_b)
    log_f = jax.nn.log_sigmoid((fb + f_bias).astype(jnp.float32)).transpose(0, 2, 1)
    log_F = jnp.cumsum(log_f, axis=-1)
    ob = fox_attention(qb, kb, split_heads(vb, FOX_HEADS), log_F)
    ob = merge_heads(ob) * jax.nn.sigmoid(gb)
    return jnp.concatenate([merge_heads(oa), ob], axis=-1) @ w_out


def odd_mixer(h, w_in, qn, kn, sinks, w_out, cos, sin):
    proj = h @ w_in
    qw = SWA_Q_HEADS * HEAD_DIM
    kw = SWA_KV_HEADS * HEAD_DIM
    q, k, v = jnp.split(proj, [qw, qw + kw], axis=-1)
    q = partial_rope(rms_norm(split_heads(q, SWA_Q_HEADS), qn), cos, sin)
    k = partial_rope(rms_norm(split_heads(k, SWA_KV_HEADS), kn), cos, sin)
    o = sliding_window_attention(q, k, split_heads(v, SWA_KV_HEADS), sinks)
    return merge_heads(o) @ w_out


def peer_ffn(h, w_query, sub_keys, expert_down, expert_up):
    B, S, D = h.shape
    T = B * S
    ht = h.reshape(T, D)
    q = (ht @ w_query).reshape(T, PEER_HEADS, 2, PEER_QUERY_DIM // 2)
    s = jnp.einsum('thpd,hpnd->thpn', q, sub_keys).astype(jnp.float32)
    s1, i1 = lax.top_k(s[:, :, 0], PEER_TOPK)
    s2, i2 = lax.top_k(s[:, :, 1], PEER_TOPK)
    cand = (s1[..., :, None] + s2[..., None, :]).reshape(T, PEER_HEADS, PEER_TOPK * PEER_TOPK)
    cand_idx = (i1[..., :, None] * PEER_N_KEYS + i2[..., None, :]).reshape(T, PEER_HEADS, PEER_TOPK * PEER_TOPK)
    top_s, pos = lax.top_k(cand, PEER_TOPK)
    idx = jnp.take_along_axis(cand_idx, pos, axis=-1)
    g = jax.nn.softmax(top_s, axis=-1)
    nc = T // PEER_TOKEN_CHUNK

    def chunk(args):
        xc, ic, gc = args
        u = expert_down[ic]
        a = jax.nn.gelu(jnp.einsum('cd,chkd->chk', xc, u).astype(jnp.float32), approximate=False)
        w = (gc * a).astype(xc.dtype)
        return jnp.einsum('chk,chkd->cd', w, expert_up[ic])

    out = lax.map(chunk, (ht.reshape(nc, PEER_TOKEN_CHUNK, D),
                          idx.reshape(nc, PEER_TOKEN_CHUNK, PEER_HEADS, PEER_TOPK),
                          g.reshape(nc, PEER_TOKEN_CHUNK, PEER_HEADS, PEER_TOPK)))
    return out.reshape(B, S, D)


def setup_inputs(seed: int = 0) -> dict:
    key = jax.random.key(seed)
    ks = jax.random.split(key, 20)
    f32 = jnp.float32

    def nrm(k, shape, scale):
        return jax.random.normal(k, shape, f32) * scale

    def gain(k, shape):
        return 1.0 + 0.05 * jax.random.normal(k, shape, f32)

    return {
        "x": jax.random.normal(ks[0], (BATCH, SEQ, D_MODEL), f32),
        "attn_norm": gain(ks[1], (DEPTH, D_MODEL)),
        "ffn_norm": gain(ks[2], (DEPTH, D_MODEL)),
        "ev_w_in": nrm(ks[3], (N_EVEN, D_MODEL, EVEN_COLS), D_MODEL ** -0.5),
        "ev_forget_bias": 2.0 + 0.1 * jax.random.normal(ks[4], (N_EVEN, FOX_HEADS), f32),
        "ev_q_norm_a": gain(ks[5], (N_EVEN, HEAD_DIM)),
        "ev_k_norm_a": gain(ks[6], (N_EVEN, HEAD_DIM)),
        "ev_q_norm_b": gain(ks[7], (N_EVEN, HEAD_DIM)),
        "ev_k_norm_b": gain(ks[8], (N_EVEN, HEAD_DIM)),
        "ev_w_out": nrm(ks[9], (N_EVEN, EVEN_MIX_WIDTH, D_MODEL), EVEN_MIX_WIDTH ** -0.5),
        "od_w_in": nrm(ks[10], (N_ODD, D_MODEL, ODD_COLS), D_MODEL ** -0.5),
        "od_q_norm": gain(ks[11], (N_ODD, HEAD_DIM)),
        "od_k_norm": gain(ks[12], (N_ODD, HEAD_DIM)),
        "od_sinks": nrm(ks[13], (N_ODD, SWA_Q_HEADS), 0.5),
        "od_w_out": nrm(ks[14], (N_ODD, ODD_MIX_WIDTH, D_MODEL), ODD_MIX_WIDTH ** -0.5),
        "peer_w_query": nrm(ks[15], (DEPTH, D_MODEL, PEER_HEADS * PEER_QUERY_DIM), D_MODEL ** -0.5),
        "peer_sub_keys": nrm(ks[16], (DEPTH, PEER_HEADS, 2, PEER_N_KEYS, PEER_QUERY_DIM // 2),
                             (PEER_QUERY_DIM // 2) ** -0.5),
        "peer_down": nrm(ks[17], (DEPTH, PEER_N_EXPERTS, D_MODEL), D_MODEL ** -0.5),
        "peer_up": nrm(ks[18], (DEPTH, PEER_N_EXPERTS, D_MODEL), 0.25),
    }


def reference(x, attn_norm, ffn_norm, ev_w_in, ev_forget_bias, ev_q_norm_a, ev_k_norm_a,
              ev_q_norm_b, ev_k_norm_b, ev_w_out, od_w_in, od_q_norm, od_k_norm, od_sinks,
              od_w_out, peer_w_query, peer_sub_keys, peer_down, peer_up):
    S = x.shape[1]
    cos, sin = rope_tables(S)
    for l in range(DEPTH):
        h = rms_norm(x, attn_norm[l])
        i = l // 2
        if l % 2 == 0:
            x = x + even_mixer(h, ev_w_in[i], ev_forget_bias[i], ev_q_norm_a[i], ev_k_norm_a[i],
                               ev_q_norm_b[i], ev_k_norm_b[i], ev_w_out[i], cos, sin)
        else:
            x = x + odd_mixer(h, od_w_in[i], od_q_norm[i], od_k_norm[i], od_sinks[i],
                              od_w_out[i], cos, sin)
        h = rms_norm(x, ffn_norm[l])
        x = x + peer_ffn(h, peer_w_query[l], peer_sub_keys[l], peer_down[l], peer_up[l])
    return x
```

```cpp
#define MK_N_LAUNCHES 12
#include <hip/hip_runtime.h>
#include <cstdio>
#include <cstdint>
namespace pg8 {
#define PG8_LAS __attribute__((address_space(3)))
typedef unsigned short bf16_t;
typedef short bf16x8 __attribute__((ext_vector_type(8)));
typedef float f32x4 __attribute__((ext_vector_type(4)));
typedef unsigned u32x4 __attribute__((ext_vector_type(4)));
constexpr int BM = 256, BK = 64, HALF = 128, HTB = HALF * BK * 2  , STAGE_BYTES = 8 * HTB, NXCD = 8, WGM = 8;

__host__ __device__ __forceinline__ int lds_byte(int r, int c) { const int st = (r >> 4) * 2 + (c >> 5), rr = r & 15, cc = c & 31, ob = rr * 64 + cc * 2; return st * 1024 + (ob ^ (((ob >> 9) & 1) << 5)); }
__host__ __device__ __forceinline__ void stage_rc(int b, int& R, int& C) { const int st = b / 1024, sb = b % 1024, swz = sb ^ (((sb >> 9) & 1) << 5); R = (st >> 1) * 16 + swz / 64; C = (st & 1) * 32 + (swz % 64) / 2; }
__host__ __device__ __forceinline__ int perm32(int rho) { const int n = rho >> 4, i = rho & 15; return 8 * (i >> 2) + 4 * n + (i & 3); }

struct Unit { int pm, pn; };
struct Gemm { const bf16_t* A; const bf16_t* Bt; int M, N, K; };

struct StaticOrder {
    int nM, nN, nwg, G, c;
    __host__ __device__ void init(int M, int N, int G_, int c_) { nM = M / BM; nN = N / BM; nwg = nM * nN; G = G_; c = c_; }
    __host__ __device__ bool next(int i, Unit& u) const {
        const long L = (long)i * G + c; if (L >= nwg) return false;
        int wgid = (int)L; { const int q = nwg / NXCD, r = nwg % NXCD, xcd = wgid % NXCD, off = wgid / NXCD; wgid = (xcd < r ? xcd * (q + 1) : r * (q + 1) + (xcd - r) * q) + off; }
        const int nig = WGM * nN, gid = wgid / nig, fm = gid * WGM, gsz = (nM - fm) < WGM ? (nM - fm) : WGM;
        u.pm = fm + ((wgid % nig) % gsz); u.pn = (wgid % nig) / gsz; return true;
    }
    __device__ __forceinline__ void a_ready(const Unit&) const {}
    __device__ __forceinline__ void done(const Unit&) const {}
};

__device__ __forceinline__ unsigned cvt_pk_bf16(float lo, float hi) { unsigned r; asm volatile("v_cvt_pk_bf16_f32 %0, %1, %2" : "=v"(r) : "v"(lo), "v"(hi)); return r; }
typedef float f32x2 __attribute__((ext_vector_type(2)));
__device__ __forceinline__ f32x2 gelu_pk(f32x2 v) {
    const f32x2 av = __builtin_elementwise_abs(v), d = av * 0.2316418882f + 1.0f;
    f32x2 t; t.x = __builtin_amdgcn_rcpf(d.x); t.y = __builtin_amdgcn_rcpf(d.y);
    f32x2 q = t * 0.5307027145f + (-0.7265760135f); q = q * t + 0.7107068705f; q = q * t + (-0.142248368f); q = q * t + 0.127414796f; q = q * t;
    const f32x2 s = (v * v) * (-0.72134752044f);
    f32x2 e; e.x = __builtin_amdgcn_exp2f(s.x); e.y = __builtin_amdgcn_exp2f(s.y);
    const f32x2 m = v * (q * e), r = v - m;
    f32x2 o; o.x = v.x < 0.f ? m.x : r.x; o.y = v.y < 0.f ? m.y : r.y; return o;
}

template <int ACT  > struct EpiBf16 {
    static constexpr bool PERM = true, AFTER_DRAIN = false; static_assert(ACT == 0 || ACT == 1, "EpiBf16: ACT is 0 (none) or 1 (gelu_pk)");
    bf16_t* O; int ldc; const float* bias; int split_cols; size_t split_stride; float scale0;
    __device__ __forceinline__ void operator()(const f32x4 (&acc)[2][2][4][2], const Unit& u, int wr, int wc, int fr, int fq) const {
        const int row0 = u.pm * BM + wr * 64 + fr; int colt = u.pn * BM; bf16_t* base = O;
        float sc = 1.f; if (split_cols) { const int t = colt / split_cols; base += (size_t)t * split_stride; colt -= t * split_cols; if (t == 0) sc = scale0; }
        const int col0 = colt + wc * 32 + 8 * fq, bcol0 = u.pn * BM + wc * 32 + 8 * fq;
        f32x4 bv[2][2];
#pragma unroll
        for (int bj = 0; bj < 2; ++bj)
#pragma unroll
            for (int n = 0; n < 2; ++n) bv[bj][n] = bias ? *(const f32x4*)(bias + bcol0 + bj * HALF + 4 * n) : (f32x4){0.f, 0.f, 0.f, 0.f};
#pragma unroll
        for (int ai = 0; ai < 2; ++ai)
#pragma unroll
            for (int m = 0; m < 4; ++m) { bf16_t* rowp = base + (size_t)(row0 + ai * HALF + m * 16) * ldc + col0;
#pragma unroll
                for (int bj = 0; bj < 2; ++bj) { f32x4 v0 = acc[ai][bj][m][0] + bv[bj][0], v1 = acc[ai][bj][m][1] + bv[bj][1];
                    if (ACT == 1) { f32x2 a = gelu_pk((f32x2){v0[0], v0[1]}), b = gelu_pk((f32x2){v0[2], v0[3]}), c = gelu_pk((f32x2){v1[0], v1[1]}), d = gelu_pk((f32x2){v1[2], v1[3]});
                        v0 = (f32x4){a.x, a.y, b.x, b.y}; v1 = (f32x4){c.x, c.y, d.x, d.y}; }
                    v0 = v0 * sc; v1 = v1 * sc; u32x4 w; w.x = cvt_pk_bf16(v0[0], v0[1]); w.y = cvt_pk_bf16(v0[2], v0[3]); w.z = cvt_pk_bf16(v1[0], v1[1]); w.w = cvt_pk_bf16(v1[2], v1[3]);
                    *(u32x4*)(rowp + bj * HALF) = w; } }
    }
};

template <class Epi, class Sched, bool ALIGN_EPI = false, bool SP2 = false>
__device__ __forceinline__ void gemm_phase(PG8_LAS unsigned char* lds, const Gemm g, const Sched& S, const Epi& E) {
    const int tid = threadIdx.x, wid = __builtin_amdgcn_readfirstlane(tid >> 6), lane = tid & 63, wr = wid >> 2, wc = wid & 3, fr = lane & 15, fq = lane >> 4;
    const int K = g.K, nt = K / BK;
    unsigned voffA[2], voffB[2];
#pragma unroll
    for (int i = 0; i < 2; ++i) { int R, C; stage_rc(tid * 16 + i * 8192, R, C); const int Rb = Epi::PERM ? ((R & ~31) + perm32(R & 31)) : R;
        voffA[i] = (unsigned)(R * K + C) * 2u; voffB[i] = (unsigned)(Rb * K + C) * 2u; }
    const size_t kstep = (size_t)(BK * 2);
    const size_t hstep = (size_t)HALF * K * 2;
    const size_t tstep = 2 * hstep;
    const unsigned ldsw = (unsigned)wid * 1024u;
    const int aoff = lds_byte(wr * 64 + fr, fq * 8), boff = lds_byte(wc * 32 + fr, fq * 8);
#define PG8_SA(b, h) (((b) * 2 + (h)) * HTB)
#define PG8_SB(b, h) ((4 + (b) * 2 + (h)) * HTB)
#define PG8_STAGE(bufoff, gbase, voff) do { _Pragma("unroll") for (int _i = 0; _i < 2; ++_i) \
        __builtin_amdgcn_global_load_lds((const unsigned*)((const char*)(gbase) + (voff)[_i]), (PG8_LAS unsigned*)(lds + (bufoff) + ldsw + _i * 8192), 16, 0, 0); } while (0)
#define PG8_LDA(dst, b, h) do { _Pragma("unroll") for (int m = 0; m < 4; ++m) _Pragma("unroll") for (int k = 0; k < 2; ++k) dst[m][k] = *(const PG8_LAS bf16x8*)(lds + PG8_SA(b, h) + aoff + m * 2048 + k * 1024); } while (0)
#define PG8_LDB(dst, b, h) do { _Pragma("unroll") for (int n = 0; n < 2; ++n) _Pragma("unroll") for (int k = 0; k < 2; ++k) dst[n][k] = *(const PG8_LAS bf16x8*)(lds + PG8_SB(b, h) + boff + n * 2048 + k * 1024); } while (0)
#define PG8_MMA(ai, bj, At, Bt) do { __builtin_amdgcn_s_setprio(1); _Pragma("unroll") for (int m = 0; m < 4; ++m) _Pragma("unroll") for (int n = 0; n < 2; ++n) _Pragma("unroll") for (int k = 0; k < 2; ++k) \
        acc[ai][bj][m][n] = __builtin_amdgcn_mfma_f32_16x16x32_bf16(Bt[n][k], At[m][k], acc[ai][bj][m][n], 0, 0, 0); __builtin_amdgcn_s_setprio(0); } while (0)
#define PG8_WAIT_V(n) asm volatile("s_waitcnt vmcnt(" #n ")" ::: "memory")
#define PG8_WAIT_L(n) asm volatile("s_waitcnt lgkmcnt(" #n ")" ::: "memory")
#define PG8_BAR __builtin_amdgcn_s_barrier()
#define PG8_SCHED __builtin_amdgcn_sched_barrier(0)
    Unit cur, nxt; int ui = 0;
    if (!S.next(0, cur)) return;
    f32x4 acc[2][2][4][2];
#pragma unroll
    for (int a = 0; a < 2; ++a)
#pragma unroll
        for (int b = 0; b < 2; ++b)
#pragma unroll
            for (int m = 0; m < 4; ++m)
#pragma unroll
                for (int n = 0; n < 2; ++n) acc[a][b][m][n] = (f32x4){0.f, 0.f, 0.f, 0.f};
    bf16x8 At[4][2], B0[2][2], B1[2][2];
    const char* cA = (const char*)g.A + (size_t)cur.pm * tstep; const char* cB = (const char*)g.Bt + (size_t)cur.pn * tstep;
    S.a_ready(cur);
    if constexpr (SP2) {
        PG8_STAGE(PG8_SB(0, 0), cB, voffB); PG8_STAGE(PG8_SB(0, 1), cB + hstep, voffB); PG8_STAGE(PG8_SA(0, 0), cA, voffA); PG8_STAGE(PG8_SA(0, 1), cA + hstep, voffA);
        if (wr == 1) PG8_BAR;
        PG8_WAIT_V(2); PG8_BAR;
        PG8_STAGE(PG8_SB(1, 0), cB + kstep, voffB); PG8_STAGE(PG8_SA(1, 0), cA + kstep, voffA); PG8_STAGE(PG8_SB(1, 1), cB + hstep + kstep, voffB);
        PG8_WAIT_V(6); PG8_BAR;
    } else {
        PG8_STAGE(PG8_SB(0, 0), cB, voffB); PG8_STAGE(PG8_SA(0, 0), cA, voffA); PG8_STAGE(PG8_SB(0, 1), cB + hstep, voffB); PG8_STAGE(PG8_SA(0, 1), cA + hstep, voffA);
        if (wr == 1) PG8_BAR;
        PG8_WAIT_V(4); PG8_BAR;
        PG8_STAGE(PG8_SB(1, 0), cB + kstep, voffB); PG8_STAGE(PG8_SA(1, 0), cA + kstep, voffA); PG8_STAGE(PG8_SB(1, 1), cB + hstep + kstep, voffB);
        PG8_WAIT_V(6); PG8_BAR;
    }
    for (;;) {
        const bool has_next = S.next(ui + 1, nxt);
        const char* nA = has_next ? (const char*)g.A + (size_t)nxt.pm * tstep : cA; const char* nB = has_next ? (const char*)g.Bt + (size_t)nxt.pn * tstep : cB;
        for (int t = 0; t < nt; t += 2) {
            const bool last = (t == nt - 2);
            const char* a1 = cA + (size_t)(t + 1) * kstep;
            const char* a2 = last ? nA : cA + (size_t)(t + 2) * kstep; const char* b2 = last ? nB : cB + (size_t)(t + 2) * kstep;
            const char* a3 = a2 + kstep; const char* b3 = b2 + kstep;
            if (last && has_next) S.a_ready(nxt);
            if constexpr (SP2) {
            PG8_LDB(B0, 0, 0); PG8_LDB(B1, 0, 1); PG8_SCHED; PG8_LDA(At, 0, 0); PG8_STAGE(PG8_SA(1, 1), a1 + hstep, voffA);
            PG8_WAIT_V(8); PG8_WAIT_L(0); PG8_BAR; PG8_MMA(0, 0, At, B0); PG8_MMA(0, 1, At, B1); PG8_BAR; PG8_SCHED;
            PG8_LDA(At, 0, 1); PG8_STAGE(PG8_SB(0, 0), b2, voffB); PG8_STAGE(PG8_SB(0, 1), b2 + hstep, voffB); PG8_STAGE(PG8_SA(0, 0), a2, voffA);
            PG8_WAIT_V(8); PG8_WAIT_L(0); PG8_BAR; PG8_MMA(1, 0, At, B0); PG8_MMA(1, 1, At, B1); PG8_BAR; PG8_SCHED;
            PG8_LDB(B0, 1, 0); PG8_LDB(B1, 1, 1); PG8_SCHED; PG8_LDA(At, 1, 0); PG8_STAGE(PG8_SA(0, 1), a2 + hstep, voffA);
            PG8_WAIT_V(8); PG8_WAIT_L(0); PG8_BAR; PG8_MMA(0, 0, At, B0); PG8_MMA(0, 1, At, B1); PG8_BAR; PG8_SCHED;
            PG8_LDA(At, 1, 1); PG8_STAGE(PG8_SB(1, 0), b3, voffB); PG8_STAGE(PG8_SB(1, 1), b3 + hstep, voffB); PG8_STAGE(PG8_SA(1, 0), a3, voffA);
            PG8_WAIT_V(8); PG8_WAIT_L(0); PG8_BAR; PG8_MMA(1, 0, At, B0); PG8_MMA(1, 1, At, B1); PG8_BAR; PG8_SCHED;
            } else {
            PG8_LDB(B0, 0, 0); PG8_SCHED; PG8_LDA(At, 0, 0); PG8_STAGE(PG8_SA(1, 1), a1 + hstep, voffA);
            PG8_WAIT_L(8); PG8_BAR; PG8_WAIT_L(0); PG8_MMA(0, 0, At, B0); PG8_BAR; PG8_SCHED;
            PG8_LDB(B1, 0, 1); PG8_STAGE(PG8_SB(0, 0), b2, voffB);
            PG8_BAR; PG8_WAIT_L(0); PG8_MMA(0, 1, At, B1); PG8_BAR;
            PG8_LDA(At, 0, 1); PG8_STAGE(PG8_SA(0, 0), a2, voffA);
            PG8_BAR; PG8_WAIT_L(0); PG8_MMA(1, 0, At, B0); PG8_BAR; PG8_SCHED;
            PG8_STAGE(PG8_SB(0, 1), b2 + hstep, voffB);
            PG8_WAIT_V(6); PG8_BAR; PG8_MMA(1, 1, At, B1); PG8_BAR;
            PG8_LDB(B0, 1, 0); PG8_SCHED; PG8_LDA(At, 1, 0); PG8_STAGE(PG8_SA(0, 1), a2 + hstep, voffA);
            PG8_WAIT_L(8); PG8_BAR; PG8_WAIT_L(0); PG8_MMA(0, 0, At, B0); PG8_BAR; PG8_SCHED;
            PG8_LDB(B1, 1, 1); PG8_STAGE(PG8_SB(1, 0), b3, voffB);
            PG8_BAR; PG8_WAIT_L(0); PG8_MMA(0, 1, At, B1); PG8_BAR;
            PG8_LDA(At, 1, 1); PG8_STAGE(PG8_SA(1, 0), a3, voffA);
            PG8_BAR; PG8_WAIT_L(0); PG8_MMA(1, 0, At, B0); PG8_BAR; PG8_SCHED;
            PG8_STAGE(PG8_SB(1, 1), b3 + hstep, voffB);
            PG8_WAIT_V(6); PG8_BAR; PG8_MMA(1, 1, At, B1); PG8_BAR;
            }
        }
        if constexpr (ALIGN_EPI) { if (wr == 0) PG8_BAR; }
        if constexpr (!Epi::AFTER_DRAIN) { E(acc, cur, wr, wc, fr, fq); S.done(cur); }
        if (!has_next) break;
#pragma unroll
        for (int a = 0; a < 2; ++a)
#pragma unroll
            for (int b = 0; b < 2; ++b)
#pragma unroll
                for (int m = 0; m < 4; ++m)
#pragma unroll
                    for (int n = 0; n < 2; ++n) acc[a][b][m][n] = (f32x4){0.f, 0.f, 0.f, 0.f};
        cur = nxt; cA = nA; cB = nB; ++ui;
        if constexpr (ALIGN_EPI) { if (wr == 1) PG8_BAR; }
    }
    PG8_WAIT_V(0);
    if constexpr (!ALIGN_EPI) { if (wr == 0) PG8_BAR; }
    PG8_BAR;
    if constexpr (Epi::AFTER_DRAIN) { E.fused(acc, cur, wr, wc, fr, fq, lds, wid, lane); S.done(cur); }
#undef PG8_SA
#undef PG8_SB
#undef PG8_STAGE
#undef PG8_LDA
#undef PG8_LDB
#undef PG8_MMA
#undef PG8_WAIT_V
#undef PG8_WAIT_L
#undef PG8_BAR
#undef PG8_SCHED
}
}
namespace pg8 {
typedef unsigned u32x2 __attribute__((ext_vector_type(2)));
constexpr float RMS_EPS = 1e-6f;
constexpr float QC2 = 0.125f * 1.4426950408889634f;
constexpr int MROWS = 16384;

template <int LAYER> struct EpiProj {
    static constexpr bool PERM = true, AFTER_DRAIN = false;
    const float* rrow; const float* cs; bf16_t* base; bf16_t* k1; bf16_t* v1; const float* gains; float* ksum;
    __device__ __forceinline__ void operator()(const f32x4 (&acc)[2][2][4][2], const Unit& u, int wr, int wc, int fr, int fq) const {
        int kind; bf16_t* dst; int pitch, col, head = 0; const float* gain;
        if (LAYER == 0) { const int grp = u.pn >> 1; head = (u.pn & 1) * 4 + wc; dst = base + (size_t)grp * ((size_t)MROWS * 512); pitch = 512; col = head * 64 + 16 * fq;
            kind = grp == 0 ? (1 | 2 | 4) : grp == 1 ? (1 | 2 | 16) : grp == 3 ? (1 | 4) : grp == 4 ? 1 : grp == 6 ? 8 : 0;
            gain = gains + 64 * (grp == 0 ? 0 : grp == 1 ? 1 : grp == 3 ? 2 : 3); }
        else { if (u.pn < 4) { dst = base; pitch = 1024; col = (u.pn * 4 + wc) * 64 + 16 * fq; kind = 1 | 2 | 4; gain = gains; }
               else if (wc < 2) { dst = k1; pitch = 128; col = wc * 64 + 16 * fq; kind = 1 | 2; gain = gains + 64; }
               else { dst = v1; pitch = 128; col = (wc - 2) * 64 + 16 * fq; kind = 0; gain = gains + 64; } }
        f32x4 gv[2][2];
#pragma unroll
        for (int bj = 0; bj < 2; ++bj)
#pragma unroll
            for (int n = 0; n < 2; ++n) gv[bj][n] = *(const f32x4*)(gain + 16 * fq + 8 * bj + 4 * n);
        f32x4 ks[2][2];
#pragma unroll
        for (int bj = 0; bj < 2; ++bj)
#pragma unroll
            for (int n = 0; n < 2; ++n) ks[bj][n] = (f32x4){0.f, 0.f, 0.f, 0.f};
#pragma unroll
        for (int ai = 0; ai < 2; ++ai)
#pragma unroll
            for (int m = 0; m < 4; ++m) {
                const int row = u.pm * BM + ai * HALF + wr * 64 + m * 16 + fr; const float rs = rrow[row];
                f32x4 v[2][2];
#pragma unroll
                for (int bj = 0; bj < 2; ++bj)
#pragma unroll
                    for (int n = 0; n < 2; ++n) v[bj][n] = acc[ai][bj][m][n] * rs;
                if (kind & 1) { float ss = 0.f;
#pragma unroll
                    for (int bj = 0; bj < 2; ++bj)
#pragma unroll
                        for (int n = 0; n < 2; ++n) { const f32x4 x = v[bj][n]; ss += (x[0] * x[0] + x[1] * x[1]) + (x[2] * x[2] + x[3] * x[3]); }
                    ss += __shfl_xor(ss, 16); ss += __shfl_xor(ss, 32);
                    const float ri = 1.0f / sqrtf(ss * (1.0f / 64.0f) + RMS_EPS);
#pragma unroll
                    for (int bj = 0; bj < 2; ++bj)
#pragma unroll
                        for (int n = 0; n < 2; ++n) v[bj][n] = (v[bj][n] * ri) * gv[bj][n]; }
                if ((kind & 2) && fq == 0) { const float* cp = cs + (size_t)(row & 8191) * 16;
#pragma unroll
                    for (int n = 0; n < 2; ++n) { const f32x4 c = *(const f32x4*)(cp + 4 * n), s = *(const f32x4*)(cp + 8 + 4 * n); const f32x4 x1 = v[0][n], x2 = v[1][n];
                        v[0][n] = x1 * c - x2 * s; v[1][n] = x2 * c + x1 * s; } }
                if (kind & 16) {
#pragma unroll
                    for (int bj = 0; bj < 2; ++bj)
#pragma unroll
                        for (int n = 0; n < 2; ++n) ks[bj][n] += v[bj][n]; }
                if (kind & 4) {
#pragma unroll
                    for (int bj = 0; bj < 2; ++bj)
#pragma unroll
                        for (int n = 0; n < 2; ++n) v[bj][n] = v[bj][n] * QC2; }
                if (kind & 8) {
#pragma unroll
                    for (int bj = 0; bj < 2; ++bj)
#pragma unroll
                        for (int n = 0; n < 2; ++n)
#pragma unroll
                            for (int j = 0; j < 4; ++j) v[bj][n][j] = 1.0f / (1.0f + __expf(-v[bj][n][j])); }
                bf16_t* rp = dst + (size_t)row * pitch + col;
#pragma unroll
                for (int bj = 0; bj < 2; ++bj) { u32x4 w; w.x = cvt_pk_bf16(v[bj][0][0], v[bj][0][1]); w.y = cvt_pk_bf16(v[bj][0][2], v[bj][0][3]); w.z = cvt_pk_bf16(v[bj][1][0], v[bj][1][1]); w.w = cvt_pk_bf16(v[bj][1][2], v[bj][1][3]);
                    *(u32x4*)(rp + 8 * bj) = w; }
            }
        if (LAYER == 0 && (kind & 16)) {
#pragma unroll
            for (int bj = 0; bj < 2; ++bj)
#pragma unroll
                for (int n = 0; n < 2; ++n)
#pragma unroll
                    for (int j = 0; j < 4; ++j) { float s = ks[bj][n][j]; s += __shfl_xor(s, 1); s += __shfl_xor(s, 2); s += __shfl_xor(s, 4); s += __shfl_xor(s, 8); ks[bj][n][j] = s; }
            if (fr == 0) { float* kp = ksum + ((size_t)((u.pm * 2 + wr) * 8 + head)) * 64 + 16 * fq;
#pragma unroll
                for (int bj = 0; bj < 2; ++bj)
#pragma unroll
                    for (int n = 0; n < 2; ++n) *(f32x4*)(kp + 8 * bj + 4 * n) = ks[bj][n]; }
        }
    }
};

struct EpiResid {
    static constexpr bool PERM = false, AFTER_DRAIN = false;
    const float* xin; float* xout; bf16_t* xb; float* rsp;
    __device__ __forceinline__ void operator()(const f32x4 (&acc)[2][2][4][2], const Unit& u, int wr, int wc, int fr, int fq) const {
        const int col0 = u.pn * BM + wc * 32 + 4 * fq;
#pragma unroll
        for (int ai = 0; ai < 2; ++ai)
#pragma unroll
            for (int m = 0; m < 4; ++m) { const int row = u.pm * BM + ai * HALF + wr * 64 + m * 16 + fr; float ss = 0.f;
#pragma unroll
                for (int bj = 0; bj < 2; ++bj)
#pragma unroll
                    for (int n = 0; n < 2; ++n) { const size_t off = (size_t)row * 1024 + col0 + bj * HALF + n * 16;
                        const f32x4 o = *(const f32x4*)(xin + off) + acc[ai][bj][m][n]; *(f32x4*)(xout + off) = o;
                        ss += (o[0] * o[0] + o[1] * o[1]) + (o[2] * o[2] + o[3] * o[3]);
                        u32x2 w; w.x = cvt_pk_bf16(o[0], o[1]); w.y = cvt_pk_bf16(o[2], o[3]); *(u32x2*)(xb + off) = w; }
                ss += __shfl_xor(ss, 16); ss += __shfl_xor(ss, 32);
                if (fq == 0) rsp[(size_t)row * 16 + u.pn * 4 + wc] = ss; }
    }
};

struct EpiPeerQ {
    static constexpr bool PERM = true, AFTER_DRAIN = false;
    const float* rsp; bf16_t* qp;
    __device__ __forceinline__ void operator()(const f32x4 (&acc)[2][2][4][2], const Unit& u, int wr, int wc, int fr, int fq) const {
        const int col0 = u.pn * BM + wc * 32 + 8 * fq;
#pragma unroll
        for (int ai = 0; ai < 2; ++ai)
#pragma unroll
            for (int m = 0; m < 4; ++m) { const int row = u.pm * BM + ai * HALF + wr * 64 + m * 16 + fr;
                const f32x4 a = *(const f32x4*)(rsp + (size_t)row * 16), b = *(const f32x4*)(rsp + (size_t)row * 16 + 4), c = *(const f32x4*)(rsp + (size_t)row * 16 + 8), d = *(const f32x4*)(rsp + (size_t)row * 16 + 12);
                const float ss = ((a[0] + a[1]) + (a[2] + a[3])) + ((b[0] + b[1]) + (b[2] + b[3])) + ((c[0] + c[1]) + (c[2] + c[3])) + ((d[0] + d[1]) + (d[2] + d[3]));
                const float rs = 1.0f / sqrtf(ss * (1.0f / 1024.0f) + RMS_EPS);
                bf16_t* rp = qp + (size_t)row * 1024 + col0;
#pragma unroll
                for (int bj = 0; bj < 2; ++bj) { const f32x4 v0 = acc[ai][bj][m][0] * rs, v1 = acc[ai][bj][m][1] * rs; u32x4 w; w.x = cvt_pk_bf16(v0[0], v0[1]); w.y = cvt_pk_bf16(v0[2], v0[3]); w.z = cvt_pk_bf16(v1[0], v1[1]); w.w = cvt_pk_bf16(v1[2], v1[3]);
                    *(u32x4*)(rp + bj * HALF) = w; } }
    }
};
}
#include <hip/hip_bf16.h>
#include <cmath>
namespace attn_body {
using bf16=__hip_bfloat16;
using bf16x8=__attribute__((ext_vector_type(8)))short;
using s16x4=__attribute__((ext_vector_type(4)))short;
using f32x16=__attribute__((ext_vector_type(16)))float;
using u32x4=__attribute__((ext_vector_type(4)))unsigned;
constexpr int BATCH=2,SEQ=8192,D=64;
constexpr int NW=8,QBLK=32,QB=QBLK*NW,KVBLK=64,NQB=SEQ/QB;
constexpr int ATTN_UNIT_ROWS=QB;
__device__ __forceinline__ int crow(int r,int hi){return (r&3)+8*(r>>2)+4*hi;}
#define SBAR() __builtin_amdgcn_sched_barrier(0)
typedef __attribute__((address_space(3))) const float* lds_cfptr;
typedef float f32x4a __attribute__((ext_vector_type(4)));
__device__ __forceinline__ float badd_s(float a,float b){float r;asm("v_add_f32_e32 %0, %1, %2":"=v"(r):"v"(a),"v"(b));return r;}
template<int VAR,bool BAND> __device__ __forceinline__ void bias_tile(f32x16&p0,f32x16&p1,int t,int jb,int qrel,int hi,lds_cfptr ftab,unsigned selm,int t0,float negs){
  const float NEG=-INFINITY;
  if(VAR==1){ const lds_cfptr f=ftab+64*t+4*hi;
    #pragma unroll
    for(int g=0;g<4;++g){ const f32x4a a=*(const __attribute__((address_space(3))) f32x4a*)(f+8*g); const f32x4a c=*(const __attribute__((address_space(3))) f32x4a*)(f+32+8*g);
      #pragma unroll
      for(int j=0;j<4;++j){p0[4*g+j]+=negs-a[j];p1[4*g+j]+=negs-c[j];} } }
  else { float s=negs;
    if(VAR==0){ if(!BAND||jb<0){ const bool ok=((selm>>((t0+t)>>2))&1u)!=0u; s=ok?negs:NEG; } }
    #pragma unroll
    for(int r=0;r<16;++r){p0[r]=badd_s(p0[r],s);p1[r]=badd_s(p1[r],s);} }
  if(BAND){
    if(VAR==2){ const int kb=64*jb+4*hi;
      #pragma unroll
      for(int r=0;r<16;++r){const int kv=kb+(r&3)+8*(r>>2); if(kv>qrel||kv<=qrel-128)p0[r]=NEG; if(kv+32>qrel||kv+32<=qrel-128)p1[r]=NEG;} }
    else if(jb>=0){ const int kb=64*jb+4*hi;
      #pragma unroll
      for(int r=0;r<16;++r){const int kv=kb+(r&3)+8*(r>>2); if(kv>qrel)p0[r]=NEG; if(kv+32>qrel)p1[r]=NEG;} }
  }
}
struct UnitArgs { const bf16*Q; const bf16*K; const bf16*V; bf16*O; int qcol,kcol,ocol; const float*Fl2; const bf16*gate; const unsigned*sel; const float*sinkp; float bl2x2; };

constexpr int NSLOT=3, SLOTB=8192;
constexpr int LDS_K=0, LDS_V=NSLOT*SLOTB, LDS_WS=2*NSLOT*SLOTB, LDS_OST=LDS_WS+NW*64*4, LDS_F=86016, LDS_BYTES=LDS_F+SEQ*4;
constexpr float C2=0.125f*1.4426950408889634f;
__device__ __forceinline__ void glds16(const void*gsrc,unsigned lds_dst){unsigned keep;
  asm volatile("s_mov_b32 %0, m0\n\ts_mov_b32 m0, %2\n\ts_nop 0\n\tglobal_load_lds_dwordx4 %1, off\n\ts_mov_b32 m0, %0":"=&s"(keep):"v"(gsrc),"s"(lds_dst):"memory");}
__device__ __forceinline__ float max3f(float a,float b,float c){float r;asm("v_max3_f32 %0, %1, %2, %3":"=v"(r):"v"(a),"v"(b),"v"(c));return r;}
__device__ __forceinline__ float max2f(float a,float b){float r;asm("v_max_f32_e32 %0, %1, %2":"=v"(r):"v"(a),"v"(b));return r;}
__device__ __forceinline__ float fadd_s(float a,float b){float r;asm("v_add_f32_e32 %0, %1, %2":"=v"(r):"v"(a),"v"(b));return r;}
__device__ __forceinline__ float fsub_s(float a,float b){float r;asm("v_sub_f32_e32 %0, %1, %2":"=v"(r):"v"(a),"v"(b));return r;}
typedef float f32x2_t __attribute__((ext_vector_type(2))); typedef __bf16 bf16x2_t __attribute__((ext_vector_type(2)));
__device__ __forceinline__ unsigned cvtpk_s(float lo,float hi){f32x2_t v={lo,hi};bf16x2_t b=__builtin_convertvector(v,bf16x2_t);return __builtin_bit_cast(unsigned,b);}
#define WAIT_BAR(N) asm volatile("s_waitcnt vmcnt(" #N ") lgkmcnt(0)\n\ts_barrier":::"memory")

__device__ __forceinline__ void qkt(f32x16&p0,f32x16&p1,const char*Kslot,const bf16x8*qr,const f32x16&negm,int r32,int hi){
  const char*kb=Kslot+hi*1024+r32*16;
  #pragma unroll
  for(int d0=0;d0<4;++d0){
    const bf16x8 b0=*reinterpret_cast<const bf16x8*>(kb+d0*2048);
    const bf16x8 b1=*reinterpret_cast<const bf16x8*>(kb+d0*2048+512);
    if(d0==0){p0=__builtin_amdgcn_mfma_f32_32x32x16_bf16(b0,qr[0],negm,0,0,0);p1=__builtin_amdgcn_mfma_f32_32x32x16_bf16(b1,qr[0],negm,0,0,0);}
    else{p0=__builtin_amdgcn_mfma_f32_32x32x16_bf16(b0,qr[d0],p0,0,0,0);p1=__builtin_amdgcn_mfma_f32_32x32x16_bf16(b1,qr[d0],p1,0,0,0);}}
}
typedef __attribute__((address_space(3))) const char* lds_cptr;
typedef short v4i16_t __attribute__((ext_vector_type(4)));
__device__ __forceinline__ void kload8(bf16x8*kf,lds_cptr kp){
  kf[0]=*(const __attribute__((address_space(3))) bf16x8*)(kp);      kf[1]=*(const __attribute__((address_space(3))) bf16x8*)(kp+512);
  kf[2]=*(const __attribute__((address_space(3))) bf16x8*)(kp+2048); kf[3]=*(const __attribute__((address_space(3))) bf16x8*)(kp+2560);
  kf[4]=*(const __attribute__((address_space(3))) bf16x8*)(kp+4096); kf[5]=*(const __attribute__((address_space(3))) bf16x8*)(kp+4608);
  kf[6]=*(const __attribute__((address_space(3))) bf16x8*)(kp+6144); kf[7]=*(const __attribute__((address_space(3))) bf16x8*)(kp+6656);
}
__device__ __forceinline__ void kload2(bf16x8*kf,lds_cptr kp,int j){ kf[2*j]=*(const __attribute__((address_space(3))) bf16x8*)(kp+j*2048); kf[2*j+1]=*(const __attribute__((address_space(3))) bf16x8*)(kp+j*2048+512); }
__device__ __forceinline__ s16x4 vtr(lds_cptr p){ return __builtin_bit_cast(s16x4,__builtin_amdgcn_ds_read_tr16_b64_v4i16((__attribute__((address_space(3))) v4i16_t*)p)); }
__device__ __forceinline__ float rowmax(const f32x16&p0,const f32x16&p1){
  float a=max3f(p0[0],p0[1],p1[0]),b=max3f(p0[2],p0[3],p1[1]);a=max3f(a,p1[2],p1[3]);
  #pragma unroll
  for(int r=4;r<16;r+=4){a=max3f(a,p0[r],p0[r+1]);b=max3f(b,p0[r+2],p0[r+3]);a=max3f(a,p1[r],p1[r+1]);b=max3f(b,p1[r+2],p1[r+3]);}
  const float m=max2f(a,b);
  auto rr=__builtin_amdgcn_permlane32_swap(__float_as_uint(m),__float_as_uint(m),false,false);
  return max2f(__uint_as_float(rr[0]),__uint_as_float(rr[1]));
}
__device__ __forceinline__ void pv(f32x16*o,int vb,bf16x8 pa0,bf16x8 pa1,bf16x8 pa2,bf16x8 pa3){
  #pragma unroll
  for(int d0=0;d0<2;++d0){s16x4 lo[4],hi[4];
    #pragma unroll
    for(int ks=0;ks<4;++ks){
      asm volatile("ds_read_b64_tr_b16 %0,%1 offset:%c2":"=&v"(lo[ks]):"v"(vb),"i"(d0*4096+ks*1024):"memory");
      asm volatile("ds_read_b64_tr_b16 %0,%1 offset:%c2":"=&v"(hi[ks]):"v"(vb),"i"(d0*4096+ks*1024+512):"memory");}
    asm volatile("s_waitcnt lgkmcnt(0)":::"memory");SBAR();
    #define PK(k) (bf16x8){lo[k][0],lo[k][1],lo[k][2],lo[k][3],hi[k][0],hi[k][1],hi[k][2],hi[k][3]}
    o[d0]=__builtin_amdgcn_mfma_f32_32x32x16_bf16(pa0,PK(0),o[d0],0,0,0);
    o[d0]=__builtin_amdgcn_mfma_f32_32x32x16_bf16(pa1,PK(1),o[d0],0,0,0);
    o[d0]=__builtin_amdgcn_mfma_f32_32x32x16_bf16(pa2,PK(2),o[d0],0,0,0);
    o[d0]=__builtin_amdgcn_mfma_f32_32x32x16_bf16(pa3,PK(3),o[d0],0,0,0);
    #undef PK
  }
}

#ifndef ATTN_STORE16
#define ATTN_STORE16(p,v) (*(u32x4*)(p)=(v))
#endif
template<int VAR,int THRL,int DMQ,int DMK,int DMO> __device__ __forceinline__ void attn_unit(int b,int qb,const UnitArgs&A,char*shm){
  int tid_=threadIdx.x; asm volatile("":"+v"(tid_)); const int tid=tid_,lane=tid&63,r32=lane&31,hi=lane>>5; const int wid=__builtin_amdgcn_readfirstlane(tid>>6);
  const long rowbase=(long)b*SEQ; const int q0=qb*QB;
  const lds_cptr shm3=(lds_cptr)shm;
  int t0=0, NT=4*qb+4; float rowc=0.f; unsigned selm=0u;
  if(VAR==2){ t0=qb?4*qb-2:0; NT=qb?6:4; }
  if(VAR==0){ selm=A.sel[q0+wid*QBLK+r32]; asm volatile("":"+s"(NT)); }
  if(VAR==1){ const float fq0=A.Fl2[q0]; const int ntile=4*qb+4;
    const bool k0=(lane<ntile)?(A.bl2x2+fq0-A.Fl2[64*lane+63]>=-160.f):true;
    const bool k1=(lane+64<ntile)?(A.bl2x2+fq0-A.Fl2[64*(lane+64)+63]>=-160.f):true;
    const unsigned long long m0=__ballot(k0), m1=__ballot(k1);
    int first=m0?(int)__builtin_ctzll(m0):64+(int)__builtin_ctzll(m1|(1ull<<63));
    first&=~1; if(first>4*qb)first=4*qb;
    t0=__builtin_amdgcn_readfirstlane(first); NT=4*qb+4-t0;
    __attribute__((address_space(3))) float*ft=(__attribute__((address_space(3))) float*)(shm3+LDS_F);
    for(int i=tid;i<64*NT;i+=NW*64)ft[i]=A.Fl2[64*t0+i]-fq0;
    rowc=A.Fl2[q0+wid*QBLK+r32]-fq0;
    asm volatile("s_waitcnt vmcnt(0) lgkmcnt(0)\n\ts_barrier":::"memory");
  }
  const lds_cfptr ftab=(lds_cfptr)(shm3+LDS_F);
  const bf16*Qw=A.Q+(rowbase+q0+wid*QBLK)*DMQ+A.qcol;
  const bf16*Kh=A.K+(rowbase+(long)t0*KVBLK)*DMK+A.kcol,*Vh=A.V+(rowbase+(long)t0*KVBLK)*DMK+A.kcol;
  const unsigned lds0=(unsigned)(uintptr_t)shm;
  float*wsf=(float*)(shm+LDS_WS)+wid*64;
  const bf16*ksrc=Kh+(long)lane*DMK+wid*8;
  const bf16*vsrc=Vh+(long)(16*(wid&3)+(lane>>2))*DMK+(wid>>2)*32+(lane&3)*8;
  const unsigned kdst=lds0+LDS_K+wid*1024, vdst=lds0+LDS_V+wid*1024;
  #define DMA_K(t,slot) glds16(ksrc+(long)(t)*KVBLK*DMK,(unsigned)__builtin_amdgcn_readfirstlane(kdst+(slot)))
  #define DMA_V(t,slot) glds16(vsrc+(long)(t)*KVBLK*DMK,(unsigned)__builtin_amdgcn_readfirstlane(vdst+(slot)))
  const int vb0=(int)(lds0+LDS_V)+((lane>>4)&1)*32+(lane&3)*8+(4*hi+((lane&15)>>2))*64;
  const char*Kbase=shm+LDS_K; bf16x8 kf[8];
  const lds_cptr kp0=shm3+LDS_K+hi*1024+r32*16; const lds_cptr vp0=shm3+LDS_V+((lane>>4)&1)*32+(lane&3)*8+(4*hi+((lane&15)>>2))*64;
  DMA_K(0,0);DMA_V(0,0);DMA_K(1,SLOTB);
  bf16x8 qr[4];
  #pragma unroll
  for(int d0=0;d0<4;++d0)qr[d0]=*reinterpret_cast<const bf16x8*>(&Qw[(long)r32*DMQ+d0*16+hi*8]);
  float mhat=0.f,l_reg=0.f;f32x16 o[2];o[0]=f32x16{};o[1]=f32x16{};const f32x16 negm=f32x16{};
  const int qrel=wid*QBLK+r32;
  #define CMASK(P0,P1,t) bias_tile<VAR,true>(P0,P1,(t),(t)-(NT-4),qrel,hi,ftab,selm,t0,rowc-mhat)
  bool resc=false;
  #define START(P0,P1) do{ const float rm=rowmax(P0,P1); resc=false; \
    { const float dl=max2f(rm,-30.f); mhat=fadd_s(mhat,dl); \
      _Pragma("unroll") for(int r=0;r<16;++r){P0[r]=fsub_s(P0[r],dl);P1[r]=fsub_s(P1[r],dl);} \
      } \
    _Pragma("unroll") for(int r=0;r<16;++r)P0[r]=__builtin_amdgcn_exp2f(P0[r]); }while(0)
  #define RESC() do{ if(resc){ asm volatile("s_waitcnt lgkmcnt(0)":::"memory"); \
      _Pragma("unroll") for(int d_=0;d_<2;++d_) _Pragma("unroll") for(int r=0;r<16;++r)o[d_][r]*=wsf[crow(r,hi)]; } }while(0)
  f32x16 pA0,pA1,pB0,pB1;
  int sl_prev=0,sl_cur=0,sl_next=SLOTB;
  #define ROT() do{sl_prev=sl_cur;sl_cur=sl_next;sl_next=(sl_next==(NSLOT-1)*SLOTB)?0:sl_next+SLOTB;}while(0)
  DMA_K(2,2*SLOTB);
  WAIT_BAR(3);
  qkt(pA0,pA1,Kbase,qr,negm,r32,hi);asm volatile("s_nop 15\n\ts_nop 7":"+v"(pA0),"+v"(pA1));CMASK(pA0,pA1,0);
  START(pA0,pA1);
  _Pragma("unroll") for(int r=0;r<16;++r)pA1[r]=__builtin_amdgcn_exp2f(pA1[r]);
  WAIT_BAR(0);
  DMA_K(3,0);DMA_V(1,SLOTB);
  ROT();
  kload8(kf,kp0+sl_cur);
  WAIT_BAR(2);
  s16x4 vlo[8],vhi[8]; u32x4 pw0,pw1,pw2,pw3;
  #define PKW(P,B) cvtpk_s(P[B],P[B+1])
  #define PAF(k) __builtin_bit_cast(bf16x8,pw##k)
  #define VFR(i) (bf16x8){vlo[i][0],vlo[i][1],vlo[i][2],vlo[i][3],vhi[i][0],vhi[i][1],vhi[i][2],vhi[i][3]}
  #define PIN(x) asm volatile("":"+v"(x))
  #define MX3(a,b,c) __builtin_fmaxf(__builtin_fmaxf((a),(b)),(c))
  #define GAPA(MF,A0,A1,A2,A3,W0,W1,PW) do{ MF; sacc+=A0; sacc+=A1; sacc+=A2; sacc+=A3; PIN(sacc); W0; W1; PIN(PW); SBAR(); }while(0)
  #define EX(v) __builtin_amdgcn_exp2f(v)
  #define GAPB(MF,X,B) do{ MF; X[B]=EX(X[B]); X[B+1]=EX(X[B+1]); X[B+2]=EX(X[B+2]); X[B+3]=EX(X[B+3]); PIN(X); SBAR(); }while(0)
  #define VRD(i) do{ vlo[i]=vtr(vp_+(((i)>>2)*4096+((i)&3)*1024)); vhi[i]=vtr(vp_+(((i)>>2)*4096+((i)&3)*1024+512)); }while(0)
  #define KRD(G,j) do{ if(G){ kload2(kf,kp0+sl_next,j); SBAR(); } }while(0)
  #define STEP(C0,C1,P0,P1,t,GK,GV,GL) do{ SBAR(); \
    const lds_cptr vp_=vp0+sl_prev; \
    VRD(0); SBAR(); float sacc=(P0[0]+P0[1]); \
    GAPA(C0=__builtin_amdgcn_mfma_f32_32x32x16_bf16(kf[0],qr[0],negm,0,0,0), P0[2],P0[3],P0[4],P0[5],     pw0[0]=PKW(P0,0), pw0[1]=PKW(P0,2), pw0); \
    VRD(4); SBAR(); GAPA(C1=__builtin_amdgcn_mfma_f32_32x32x16_bf16(kf[1],qr[0],negm,0,0,0), P0[6],P0[7],P0[8],P0[9],     pw0[2]=PKW(P0,4), pw0[3]=PKW(P0,6), pw0); \
    VRD(1); SBAR(); GAPA(C0=__builtin_amdgcn_mfma_f32_32x32x16_bf16(kf[2],qr[1],C0,0,0,0),   P0[10],P0[11],P0[12],P0[13], pw1[0]=PKW(P0,8), pw1[1]=PKW(P0,10), pw1); \
    VRD(5); SBAR(); GAPA(C1=__builtin_amdgcn_mfma_f32_32x32x16_bf16(kf[3],qr[1],C1,0,0,0),   P0[14],P0[15],P1[0],P1[1],   pw1[2]=PKW(P0,12),pw1[3]=PKW(P0,14), pw1); \
    VRD(2); SBAR(); GAPA(C0=__builtin_amdgcn_mfma_f32_32x32x16_bf16(kf[4],qr[2],C0,0,0,0),   P1[2],P1[3],P1[4],P1[5],     pw2[0]=PKW(P1,0), pw2[1]=PKW(P1,2), pw2); \
    VRD(6); SBAR(); GAPA(C1=__builtin_amdgcn_mfma_f32_32x32x16_bf16(kf[5],qr[2],C1,0,0,0),   P1[6],P1[7],P1[8],P1[9],     pw2[2]=PKW(P1,4), pw2[3]=PKW(P1,6), pw2); \
    VRD(3); SBAR(); GAPA(C0=__builtin_amdgcn_mfma_f32_32x32x16_bf16(kf[6],qr[3],C0,0,0,0),   P1[10],P1[11],P1[12],P1[13], pw3[0]=PKW(P1,8), pw3[1]=PKW(P1,10), pw3); \
    VRD(7); SBAR(); GAPA(C1=__builtin_amdgcn_mfma_f32_32x32x16_bf16(kf[7],qr[3],C1,0,0,0),   P1[14],P1[15],0.f,0.f,       pw3[2]=PKW(P1,12),pw3[3]=PKW(P1,14), pw3); \
    l_reg+=sacc; \
    if(GK){DMA_K((t)+3,sl_cur);} if(GV){DMA_V((t)+1,sl_next);} \
    CMASK(C0,C1,t); \
    { float a=MX3(C0[0],C0[1],C1[0]),b=MX3(C0[2],C0[3],C1[1]); a=MX3(a,C1[2],C1[3]); \
      _Pragma("unroll") for(int r=4;r<16;r+=4){a=MX3(a,C0[r],C0[r+1]);b=MX3(b,C0[r+2],C0[r+3]);a=MX3(a,C1[r],C1[r+1]);b=MX3(b,C1[r+2],C1[r+3]);} \
      float rm=__builtin_fmaxf(a,b); { auto rr=__builtin_amdgcn_permlane32_swap(__float_as_uint(rm),__float_as_uint(rm),false,false); rm=__builtin_fmaxf(__uint_as_float(rr[0]),__uint_as_float(rr[1])); } \
      resc=false; \
      if(__builtin_expect(__any(rm>(float)THRL),0)){ const float dl=__builtin_fmaxf(rm,0.f); mhat+=dl; \
        _Pragma("unroll") for(int r=0;r<16;++r){C0[r]-=dl;C1[r]-=dl;} \
        const float f=__builtin_amdgcn_exp2f(-dl); l_reg*=f; if(hi==0)wsf[r32]=f; resc=true; } } \
    SBAR(); \
    GAPB(o[0]=__builtin_amdgcn_mfma_f32_32x32x16_bf16(PAF(0),VFR(0),o[0],0,0,0), C0,0); \
    GAPB(o[1]=__builtin_amdgcn_mfma_f32_32x32x16_bf16(PAF(0),VFR(4),o[1],0,0,0), C0,4); \
    KRD(GL,0); GAPB(o[0]=__builtin_amdgcn_mfma_f32_32x32x16_bf16(PAF(1),VFR(1),o[0],0,0,0), C0,8); \
    KRD(GL,1); GAPB(o[1]=__builtin_amdgcn_mfma_f32_32x32x16_bf16(PAF(1),VFR(5),o[1],0,0,0), C0,12); \
    KRD(GL,2); GAPB(o[0]=__builtin_amdgcn_mfma_f32_32x32x16_bf16(PAF(2),VFR(2),o[0],0,0,0), C1,0); \
    KRD(GL,3); GAPB(o[1]=__builtin_amdgcn_mfma_f32_32x32x16_bf16(PAF(2),VFR(6),o[1],0,0,0), C1,4); \
    GAPB(o[0]=__builtin_amdgcn_mfma_f32_32x32x16_bf16(PAF(3),VFR(3),o[0],0,0,0), C1,8); \
    GAPB(o[1]=__builtin_amdgcn_mfma_f32_32x32x16_bf16(PAF(3),VFR(7),o[1],0,0,0), C1,12); \
    }while(0)
  int t=1;
  #undef CMASK
  #define CMASK(P0,P1,t) bias_tile<VAR,false>(P0,P1,(t),-1,qrel,hi,ftab,selm,t0,rowc-mhat)
  for(;t+5<NT;t+=2){
    STEP(pB0,pB1,pA0,pA1,t,true,true,true);     WAIT_BAR(2); RESC(); ROT();
    STEP(pA0,pA1,pB0,pB1,t+1,true,true,true);   WAIT_BAR(2); RESC(); ROT();
  }
  #undef CMASK
  #define CMASK(P0,P1,t) bias_tile<VAR,true>(P0,P1,(t),(t)-(NT-4),qrel,hi,ftab,selm,t0,rowc-mhat)
  #define ENDW(tt) do{ if((tt)+3<NT){WAIT_BAR(2);} else if((tt)+2<NT){WAIT_BAR(1);} else {WAIT_BAR(0);} }while(0)
  for(;t+1<NT;t+=2){
    STEP(pB0,pB1,pA0,pA1,t,(t+3<NT),(t+1<NT),(t+1<NT));       ENDW(t);   RESC(); ROT();
    STEP(pA0,pA1,pB0,pB1,t+1,(t+4<NT),(t+2<NT),(t+2<NT));     ENDW(t+1); RESC(); ROT();
  }
  STEP(pB0,pB1,pA0,pA1,NT-1,false,false,false); RESC();
  { float sacc=pB0[0]+pB0[1]; _Pragma("unroll") for(int r=2;r<16;++r)sacc+=pB0[r]; _Pragma("unroll") for(int r=0;r<16;++r)sacc+=pB1[r]; l_reg+=sacc;
    pw0=(u32x4){PKW(pB0,0),PKW(pB0,2),PKW(pB0,4),PKW(pB0,6)};pw1=(u32x4){PKW(pB0,8),PKW(pB0,10),PKW(pB0,12),PKW(pB0,14)};pw2=(u32x4){PKW(pB1,0),PKW(pB1,2),PKW(pB1,4),PKW(pB1,6)};pw3=(u32x4){PKW(pB1,8),PKW(pB1,10),PKW(pB1,12),PKW(pB1,14)};
    SBAR(); pv(o,vb0+sl_cur,PAF(0),PAF(1),PAF(2),PAF(3)); }
  #undef PKW
  #undef PAF
  #undef VFR
  #undef PIN
  #undef MX3
  #undef GAPA
  #undef GAPB
  #undef EX
  #undef VRD
  #undef KRD
  #undef STEP
  #undef ENDW
  {auto rr=__builtin_amdgcn_permlane32_swap(__float_as_uint(l_reg),__float_as_uint(l_reg),false,false);l_reg=__uint_as_float(rr[0])+__uint_as_float(rr[1]);}
  if(VAR==2)l_reg+=__builtin_amdgcn_exp2f(A.sinkp[0]*1.4426950408889634f-mhat);
  if(hi==0)wsf[32+r32]=l_reg;asm volatile("s_waitcnt lgkmcnt(0)":::"memory");
  float rli[16];
  #pragma unroll
  for(int r=0;r<16;++r)rli[r]=__builtin_amdgcn_rcpf(wsf[32+crow(r,hi)]);
  bf16*Ow=A.O+(rowbase+q0+wid*QBLK)*DMO+A.ocol;
  { bf16*stg=(bf16*)(shm+LDS_OST)+wid*2048;
    #pragma unroll
    for(int r=0;r<16;++r){const int orow=crow(r,hi);
      #pragma unroll
      for(int d0=0;d0<2;++d0)stg[orow*64+d0*32+r32]=__float2bfloat16(o[d0][r]*rli[r]);}
    asm volatile("s_waitcnt lgkmcnt(0)":::"memory");
    #pragma unroll
    for(int i=0;i<4;++i){const int row=i*8+(lane>>3),ch=lane&7; u32x4 v=*(const u32x4*)(stg+row*64+ch*8);
      if(VAR==1){ const u32x4 g=*(const u32x4*)(A.gate+(rowbase+q0+wid*QBLK+row)*512+ch*8);
        #pragma unroll
        for(int j=0;j<4;++j){ const float vl=__uint_as_float(v[j]<<16)*__uint_as_float(g[j]<<16), vh=__uint_as_float(v[j]&0xffff0000u)*__uint_as_float(g[j]&0xffff0000u); v[j]=cvtpk_s(vl,vh); } }
      ATTN_STORE16(Ow+(long)row*DMO+ch*8,v);} }
  asm volatile("s_waitcnt lgkmcnt(0)\n\ts_barrier":::"memory");
  #undef DMA_K
  #undef DMA_V
  #undef CMASK
  #undef START
  #undef RESC
  #undef ROT
}
constexpr int ATTN_LDS_BYTES=LDS_BYTES;
#undef SBAR
#undef WAIT_BAR
}
#define GAS __attribute__((address_space(1)))
#define LAS __attribute__((address_space(3)))
typedef unsigned short bf16;
typedef unsigned v4u __attribute__((ext_vector_type(4)));
typedef float f32x4 __attribute__((ext_vector_type(4)));
typedef short bf16x8 __attribute__((ext_vector_type(8)));
typedef GAS unsigned gu32;
typedef GAS unsigned long long gu64;
#define RLX_AGENT __ATOMIC_RELAXED, __HIP_MEMORY_SCOPE_AGENT
#define LDS_WAIT() asm volatile("s_waitcnt lgkmcnt(0)" ::: "memory")
#define VM_WAIT() asm volatile("s_waitcnt vmcnt(0)" ::: "memory")
__device__ __forceinline__ unsigned long long rt() { return __builtin_amdgcn_s_memrealtime(); }
__device__ __forceinline__ unsigned f2bf(float f) { unsigned u = __builtin_bit_cast(unsigned, f); return (u + 0x7fffu + ((u >> 16) & 1u)) >> 16; }
__device__ __forceinline__ unsigned pk2(float lo, float hi) { return f2bf(lo) | (f2bf(hi) << 16); }

#define XB_TMO      128
#define XB_XCNT(j)  (256  + 64 * (j))
#define XB_XSUB(j)  (1280 + 64 * (j))
#define XB_XGEN(j)  (2304 + 64 * (j))
#define XB_TOP      3328
#define XB_TOPGEN   3392
#define XCD_BAR_WORDS 3456
#define XB_SPIN_CAP (1u << 18)

__device__ __forceinline__ unsigned xb_ld(unsigned* p)              { return __hip_atomic_load(p, __ATOMIC_RELAXED, __HIP_MEMORY_SCOPE_AGENT); }
__device__ __forceinline__ unsigned xb_add(unsigned* p, unsigned v) { return __hip_atomic_fetch_add(p, v, __ATOMIC_RELAXED, __HIP_MEMORY_SCOPE_AGENT); }
__device__ __forceinline__ unsigned xb_xcc_id() { return (unsigned)__builtin_amdgcn_s_getreg((3 << 11) | 20) & 0xFu; }
#define XB_SPIN(cond, bar) do { unsigned _sp = 0; while (cond) { __builtin_amdgcn_s_sleep(1); \
    if ((++_sp & 255u) == 0u) { if (xb_ld(&(bar)[XB_TMO])) break; if (_sp > XB_SPIN_CAP) { atomicAdd(&(bar)[XB_TMO], 1u); break; } } } } while (0)

struct XcdBarrier {
    unsigned* bar; unsigned x;
    volatile LAS unsigned* st;
};

__device__ __forceinline__ XcdBarrier xcd_barrier_post(unsigned* bar, volatile LAS unsigned* st) {
    XcdBarrier b; b.bar = bar; b.x = xb_xcc_id(); b.st = st;
    if (threadIdx.x == 0) (void)xb_add(&bar[XB_XCNT(b.x)], 1u);
    return b;
}
__device__ __forceinline__ void xcd_barrier_complete(unsigned* bar, unsigned x, unsigned& nloc, unsigned& nx) {
    const unsigned G = gridDim.x * gridDim.y * gridDim.z;
    unsigned sum, cnt, mine, sp = 0u;
    for (;;) {
        sum = 0u; cnt = 0u; mine = 0u;
#pragma unroll
        for (unsigned j = 0; j < 16; ++j) { const unsigned c = xb_ld(&bar[XB_XCNT(j)]); sum += c; cnt += (c > 0u) ? 1u : 0u; mine = (j == x) ? c : mine; }
        if (sum == G) break;
        __builtin_amdgcn_s_sleep(1);
        if ((++sp & 255u) == 0u) { if (xb_ld(&bar[XB_TMO])) break; if (sp > XB_SPIN_CAP) { atomicAdd(&bar[XB_TMO], 1u); break; } }
    }
    nloc = mine > 0u ? mine : 1u; nx = cnt > 0u ? cnt : 1u;
}

__device__ __forceinline__ void xcd_barrier(const XcdBarrier& b) {
    asm volatile("s_waitcnt vmcnt(0)" ::: "memory");
    __syncthreads();
    if (threadIdx.x == 0) {
        unsigned* bar = b.bar;
        __builtin_amdgcn_s_waitcnt(0);
        unsigned nloc = b.st[0], nx = b.st[1];
        if (nloc == 0u) { xcd_barrier_complete(bar, b.x, nloc, nx); b.st[0] = nloc; b.st[1] = nx; }
        const unsigned old = xb_add(&bar[XB_XSUB(b.x)], 1u);
        const unsigned gen = old / nloc;
        if (old + 1u == (gen + 1u) * nloc) {
            __builtin_amdgcn_fence(__ATOMIC_RELEASE, "agent");
            asm volatile("s_waitcnt vmcnt(0)" ::: "memory");
            const unsigned og = xb_add(&bar[XB_TOP], 1u);
            const unsigned tg = og / nx;
            if (og + 1u == (tg + 1u) * nx) xb_add(&bar[XB_TOPGEN], 1u);
            else XB_SPIN(xb_ld(&bar[XB_TOPGEN]) == tg, bar);
            __builtin_amdgcn_fence(__ATOMIC_ACQUIRE, "agent");
            xb_add(&bar[XB_XGEN(b.x)], 1u);
            asm volatile("s_waitcnt vmcnt(0)" ::: "memory");
        } else {
            XB_SPIN(xb_ld(&bar[XB_XGEN(b.x)]) == gen, bar);
            __builtin_amdgcn_fence(__ATOMIC_ACQUIRE, "agent");
            asm volatile("s_waitcnt vmcnt(0)" ::: "memory");
        }
    }
    __syncthreads();
}
constexpr int NWAVES = 8;
constexpr int BATCH = 2, SEQ = 8192, DMODEL = 1024, M = BATCH * SEQ;
constexpr int EV_COLS = 3592, EV_N = 3584, OD_N = 1280;
constexpr int NEXP = 16384;
constexpr float L2E = 1.4426950408889634f;
constexpr float RMS_EPS = 1e-6f;

#ifndef MK_N_LAUNCHES
#define MK_N_LAUNCHES 1
#endif
constexpr int N_PHASES = 12;
constexpr int N_LAUNCHES = MK_N_LAUNCHES;

constexpr size_t MiB = 1u << 20;
constexpr size_t WS_CTL = 0, CTL_ZERO_BYTES = 1 * MiB;
constexpr size_t WS_WIN0 = 2 * MiB, WS_WOUT0 = 9 * MiB, WS_WQ0 = 11 * MiB, WS_WIN1 = 13 * MiB, WS_WOUT1 = 16 * MiB, WS_WQ1 = 18 * MiB;
constexpr size_t WS_SK = 20 * MiB;
constexpr size_t WS_ROPE = 21 * MiB;
constexpr size_t WS_RA0 = 22 * MiB, WS_RA1 = 22 * MiB + 65536;
constexpr size_t WS_LF = 23 * MiB;
constexpr size_t WS_FL2 = 24 * MiB;
constexpr size_t WS_KSUM = 25 * MiB;
constexpr size_t WS_SEL = 26 * MiB;
constexpr size_t WS_GAIN = 28 * MiB;
constexpr size_t WS_RSP = 27 * MiB;
constexpr size_t WS_XB = 32 * MiB;
constexpr size_t WS_QKV = 64 * MiB;
constexpr size_t WS_AO = 176 * MiB;
constexpr size_t WS_QP = 208 * MiB;
constexpr size_t WS_TAB = 240 * MiB;
constexpr size_t WS_END = 368 * MiB;
constexpr int CW_BAR = 4096;

constexpr int RING_BYTES = 131072;
constexpr int LDS_BYTES = 147456;
constexpr int LDSCTL_OFF = LDS_BYTES - 512, MISC_OFF = LDSCTL_OFF + 64;

typedef unsigned v2u __attribute__((ext_vector_type(2)));
typedef __bf16 bf16x2v __attribute__((ext_vector_type(2)));
__device__ __forceinline__ float bflo(unsigned w) { return __uint_as_float(w << 16); }
__device__ __forceinline__ float bfhi(unsigned w) { return __uint_as_float(w & 0xffff0000u); }
__device__ __forceinline__ float dot2bf(unsigned a, unsigned b, float c) { return __builtin_amdgcn_fdot2_f32_bf16(__builtin_bit_cast(bf16x2v, a), __builtin_bit_cast(bf16x2v, b), c, false); }
__device__ __forceinline__ float wave_sum(float v) {
#pragma unroll
    for (int o = 1; o < 64; o <<= 1) v += __shfl_xor(v, o);
    return v;
}
__device__ __forceinline__ float wave_max(float v) {
#pragma unroll
    for (int o = 1; o < 64; o <<= 1) v = fmaxf(v, __shfl_xor(v, o));
    return v;
}

struct Args { const float* in[19]; float* out; unsigned char* ws; int ph_lo, ph_hi, li, pad; };
struct Ctx { unsigned char* lds; int tid, lane, wave, vcu, G; };

__device__ __forceinline__ int perm_src_col(int c) { const int r = c & 255; return (c & ~255) + 64 * ((r >> 5) & 3) + 16 * ((r >> 3) & 3) + 8 * (r >> 7) + (r & 7); }
__device__ __forceinline__ void p0_transpose_item(const float* W, int Nsrc, const float* gain, bool permc, bf16* WT, LAS float* scr, int item, int nblk, int lane) {
    const int kb = item / nblk, nb = item % nblk, k0 = 64 * kb, n0 = 32 * nb;
    const int sc = permc ? perm_src_col(n0 + (lane & 31)) : n0 + (lane & 31);
#pragma unroll 8
    for (int i = 0; i < 32; ++i) { const int kk = 2 * i + (lane >> 5); float w = W[(size_t)(k0 + kk) * Nsrc + sc]; if (gain) w *= gain[k0 + kk]; scr[kk * 33 + (lane & 31)] = w; }
    LDS_WAIT(); asm volatile("" ::: "memory");
    const int c = lane & 7;
#pragma unroll
    for (int j = 0; j < 4; ++j) { const int n = (lane >> 3) + 8 * j; const LAS float* s = scr + (8 * c) * 33 + n;
        v4u o; o.x = pk2(s[0 * 33], s[1 * 33]); o.y = pk2(s[2 * 33], s[3 * 33]); o.z = pk2(s[4 * 33], s[5 * 33]); o.w = pk2(s[6 * 33], s[7 * 33]);
        *(GAS v4u*)(WT + (size_t)(n0 + n) * 1024 + k0 + 8 * c) = o; }
    LDS_WAIT(); asm volatile("" ::: "memory");
}
__device__ __forceinline__ void sincos_d(float af, float& s, float& c) {
    const double a = (double)af, k = __builtin_rint(a * 0.15915494309189535), r = (a - k * 6.283185307179586) - k * 2.4492935982947064e-16, r2 = r * r;
    double ts = 1.0, tc = 1.0, ss = 1.0, cc = 1.0;
#pragma unroll
    for (int i = 1; i <= 13; ++i) { tc *= -r2 / (double)((2 * i - 1) * (2 * i)); ts *= -r2 / (double)((2 * i) * (2 * i + 1)); cc += tc; ss += ts; }
    s = (float)(r * ss); c = (float)cc;
}
__device__ __forceinline__ void p0_prologue(const Args& a, const Ctx& C) {
    unsigned char* ws = a.ws;
    const int gw = C.vcu * NWAVES + C.wave, NGW = C.G * NWAVES, gt = C.vcu * (NWAVES * 64) + C.tid, NGT = C.G * NWAVES * 64;
    const float* x = a.in[0]; const float* an = a.in[1]; const float* fn = a.in[2]; const float* ev_w_in = a.in[3]; const float* fbias = a.in[4];
    LAS float* wf = (LAS float*)(C.lds + 69632);
    for (int i = C.tid; i < 1024; i += NWAVES * 64) { const float g = an[i];
#pragma unroll
        for (int h = 0; h < 8; ++h) wf[h * 1024 + i] = ev_w_in[(size_t)i * EV_COLS + EV_N + h] * g; }
    __syncthreads();
    LAS float* scr = (LAS float*)(C.lds + C.wave * 8704);
    constexpr int I_IN0 = 16 * (EV_N / 32), I_SQ = 16 * 32, I_IN1 = 16 * (OD_N / 32);
    constexpr int NITEMS = I_IN0 + 2 * I_SQ + I_IN1 + 2 * I_SQ;
    for (int it = gw; it < NITEMS; it += NGW) {
        int r = it;
        if (r < I_IN0) { p0_transpose_item(ev_w_in, EV_COLS, an, true, (bf16*)(ws + WS_WIN0), scr, r, EV_N / 32, C.lane); continue; } r -= I_IN0;
        if (r < I_SQ) { p0_transpose_item(a.in[9], 1024, nullptr, false, (bf16*)(ws + WS_WOUT0), scr, r, 32, C.lane); continue; } r -= I_SQ;
        if (r < I_SQ) { p0_transpose_item(a.in[15], 1024, fn, false, (bf16*)(ws + WS_WQ0), scr, r, 32, C.lane); continue; } r -= I_SQ;
        if (r < I_IN1) { p0_transpose_item(a.in[10], OD_N, an + 1024, true, (bf16*)(ws + WS_WIN1), scr, r, OD_N / 32, C.lane); continue; } r -= I_IN1;
        if (r < I_SQ) { p0_transpose_item(a.in[14], 1024, nullptr, false, (bf16*)(ws + WS_WOUT1), scr, r, 32, C.lane); continue; } r -= I_SQ;
        p0_transpose_item(a.in[15] + (size_t)1024 * 1024, 1024, fn + 1024, false, (bf16*)(ws + WS_WQ1), scr, r, 32, C.lane);
    }
    { bf16* xb = (bf16*)(ws + WS_XB); float* ra0 = (float*)(ws + WS_RA0); float* lf = (float*)(ws + WS_LF);
      for (int m = gw; m < M; m += NGW) {
        const GAS f32x4* xr = (const GAS f32x4*)(x + (size_t)m * DMODEL) + C.lane;
        f32x4 v[4]; float s = 0.f; float fa[8];
#pragma unroll
        for (int h = 0; h < 8; ++h) fa[h] = 0.f;
#pragma unroll
        for (int j = 0; j < 4; ++j) { v[j] = xr[64 * j]; s += (v[j].x * v[j].x + v[j].y * v[j].y) + (v[j].z * v[j].z + v[j].w * v[j].w);
#pragma unroll
            for (int h = 0; h < 8; ++h) { const f32x4 w = *(const LAS f32x4*)(wf + h * 1024 + 256 * j + 4 * C.lane); fa[h] += (v[j].x * w.x + v[j].y * w.y) + (v[j].z * w.z + v[j].w * w.w); } }
        const float r = 1.0f / sqrtf(wave_sum(s) * (1.0f / DMODEL) + RMS_EPS);
        GAS unsigned long long* o8 = (GAS unsigned long long*)(xb + (size_t)m * DMODEL) + C.lane;
#pragma unroll
        for (int j = 0; j < 4; ++j) o8[64 * j] = (unsigned long long)pk2(v[j].x, v[j].y) | ((unsigned long long)pk2(v[j].z, v[j].w) << 32);
        float mine = 0.f;
#pragma unroll
        for (int h = 0; h < 8; ++h) { const float t = wave_sum(fa[h]); if (C.lane == h) mine = t; }
        if (C.lane < 8) { const float z = r * mine + fbias[C.lane]; lf[(size_t)m * 8 + C.lane] = z >= 0.f ? -log1pf(expf(-z)) : z - log1pf(expf(z)); }
        if (C.lane == 0) ra0[m] = r;
      } }
    { const size_t nchunk = (size_t)2 * NEXP * 1024 / 8;
      for (int t = 0; t < 2; ++t) { const float* src = a.in[17 + t];
        for (size_t i = gt; i < nchunk; i += NGT) { const size_t layer = i / ((size_t)NEXP * 128), rem = i % ((size_t)NEXP * 128);
            const f32x4 p = __builtin_nontemporal_load((const f32x4*)src + 2 * i), q = __builtin_nontemporal_load((const f32x4*)src + 2 * i + 1);
            v4u o; o.x = pk2(p.x, p.y); o.y = pk2(p.z, p.w); o.z = pk2(q.x, q.y); o.w = pk2(q.z, q.w);
            *((v4u*)(ws + WS_TAB + (2 * layer + t) * 32 * MiB) + rem) = o; } }
      const float* sk = a.in[16];
      for (size_t i = gt; i < (size_t)262144 / 8; i += NGT) { const f32x4 p = *((const f32x4*)sk + 2 * i), q = *((const f32x4*)sk + 2 * i + 1);
            v4u o; o.x = pk2(p.x, p.y); o.y = pk2(p.z, p.w); o.z = pk2(q.x, q.y); o.w = pk2(q.z, q.w); *((v4u*)(ws + WS_SK) + i) = o; } }
    if (gt < 384) { const int g = gt >> 6, d = gt & 63; const float* src = g == 0 ? a.in[5] : g == 1 ? a.in[6] : g == 2 ? a.in[7] : g == 3 ? a.in[8] : g == 4 ? a.in[11] : a.in[12]; ((float*)(ws + WS_GAIN))[gt] = src[d]; }
    { float* cs = (float*)(ws + WS_ROPE);
      for (int i = gt; i < SEQ * 8; i += NGT) { const int pos = i >> 3, f = i & 7; const float inv = powf(500000.0f, -0.125f * (float)f), ang = (float)pos * inv; float s, c; sincos_d(ang, s, c);
          cs[pos * 16 + f] = c; cs[pos * 16 + 8 + f] = s; } }
}

__device__ __forceinline__ void p2_route(const Args& a, const Ctx& C) {
    unsigned char* ws = a.ws;
    if (C.vcu < 16) { const int b = C.vcu >> 3, h = C.vcu & 7; const float* lf = (const float*)(ws + WS_LF); float* fl2 = (float*)(ws + WS_FL2) + (size_t)C.vcu * SEQ;
        LAS double* wtot = (LAS double*)(C.lds + 32768);
        double loc[16]; double run = 0.0;
#pragma unroll
        for (int i = 0; i < 16; ++i) { run += (double)lf[((size_t)b * SEQ + 16 * C.tid + i) * 8 + h]; loc[i] = run; }
        double inc = run;
#pragma unroll
        for (int o = 1; o < 64; o <<= 1) { const double y = __shfl_up(inc, o); if (C.lane >= o) inc += y; }
        if (C.lane == 63) wtot[C.wave] = inc;
        __syncthreads();
        double base = inc - run;
        for (int w = 0; w < C.wave; ++w) base += wtot[w];
#pragma unroll
        for (int i = 0; i < 16; ++i) fl2[16 * C.tid + i] = (float)((base + loc[i]) * 1.4426950408889634);
    }
    __syncthreads();
    { const int unit = 2 * C.vcu + (C.tid >> 8), qi = C.tid & 255, half = C.tid >> 8; const int b = unit >> 8, h = (unit >> 5) & 7, qb = unit & 31;
      if (unit < 512) {
        LAS float* km = (LAS float*)(C.lds) + half * 2048;
        const float* ksum = (const float*)(ws + WS_KSUM);
        for (int i = qi; i < qb * 64; i += 256) { const int j = i >> 6, d = i & 63; const size_t p0 = ((size_t)(((b * 32 + j) * 2 + 0) * 8 + h)) * 64 + d, p1 = ((size_t)(((b * 32 + j) * 2 + 1) * 8 + h)) * 64 + d;
            km[i] = (ksum[p0] + ksum[p1]) * (1.0f / 256.0f); }
      }
      __syncthreads();
      if (unit < 512) {
        const LAS float* km = (const LAS float*)(C.lds) + half * 2048;
        const bf16* qa = (const bf16*)(ws + WS_QKV);
        const v4u* qp = (const v4u*)(qa + ((size_t)b * SEQ + 256 * qb + qi) * 512 + h * 64);
        float q[64];
#pragma unroll
        for (int c = 0; c < 8; ++c) { const v4u w = qp[c];
#pragma unroll
            for (int j = 0; j < 4; ++j) { q[8 * c + 2 * j] = bflo(w[j]); q[8 * c + 2 * j + 1] = bfhi(w[j]); } }
        float v0 = -INFINITY, v1 = -INFINITY, v2 = -INFINITY; int i0 = -1, i1 = -1, i2 = -1;
        for (int j = 0; j < qb; ++j) { float g0 = 0.f, g1 = 0.f, g2 = 0.f, g3 = 0.f;
#pragma unroll
            for (int d = 0; d < 64; d += 4) { const f32x4 k = *(const LAS f32x4*)(km + j * 64 + d); g0 += q[d] * k.x; g1 += q[d + 1] * k.y; g2 += q[d + 2] * k.z; g3 += q[d + 3] * k.w; }
            const float g = (g0 + g1) + (g2 + g3);
            if (g > v0) { v2 = v1; i2 = i1; v1 = v0; i1 = i0; v0 = g; i0 = j; } else if (g > v1) { v2 = v1; i2 = i1; v1 = g; i1 = j; } else if (g > v2) { v2 = g; i2 = j; } }
        unsigned msk = 0u; if (i0 >= 0) msk |= 1u << i0; if (i1 >= 0) msk |= 1u << i1; if (i2 >= 0) msk |= 1u << i2;
        ((unsigned*)(ws + WS_SEL))[((size_t)(b * 8 + h)) * SEQ + 256 * qb + qi] = msk;
      }
    }
}

__device__ __forceinline__ void p3_attn_l0(const Args& a, const Ctx& C) {
    unsigned char* ws = a.ws; const attn_body::bf16* qkv = (const attn_body::bf16*)(ws + WS_QKV); const size_t BUF = (size_t)M * 512;
    const int bh = C.vcu >> 4, s = C.vcu & 15, b = bh >> 3, h = bh & 7;
    const float gq = wave_max(fabsf(a.in[7][C.lane])), gk = wave_max(fabsf(a.in[8][C.lane]));
    const float bl2x2 = 2.0f * (64.0f * gq * gk * attn_body::C2 * 1.02f + 1.0f);
    attn_body::UnitArgs um; um.Q = qkv; um.K = qkv + BUF; um.V = qkv + 2 * BUF; um.O = (attn_body::bf16*)(ws + WS_AO); um.qcol = h * 64; um.kcol = h * 64; um.ocol = h * 64;
    um.Fl2 = nullptr; um.gate = nullptr; um.sel = (const unsigned*)(ws + WS_SEL) + (size_t)bh * SEQ; um.sinkp = nullptr; um.bl2x2 = 0.f;
    attn_body::UnitArgs uf; uf.Q = qkv + 3 * BUF; uf.K = qkv + 4 * BUF; uf.V = qkv + 5 * BUF; uf.O = um.O; uf.qcol = h * 64; uf.kcol = h * 64; uf.ocol = 512 + h * 64;
    uf.Fl2 = (const float*)(ws + WS_FL2) + (size_t)bh * SEQ; uf.gate = qkv + 6 * BUF + h * 64; uf.sel = nullptr; uf.sinkp = nullptr; uf.bl2x2 = bl2x2;
    char* shm = (char*)C.lds;
    if (C.vcu < 256) {
#ifndef NO_MOBA
        for (int i = 0; i < 2; ++i) attn_body::attn_unit<0, 8, 512, 512, 1024>(b, i ? s : 31 - s, um, shm);
#endif
#ifndef NO_FOX
        for (int i = 0; i < 2; ++i) attn_body::attn_unit<1, 8, 512, 512, 1024>(b, i ? s : 31 - s, uf, shm);
#endif
    }
}
__device__ __forceinline__ void p8_attn_l1(const Args& a, const Ctx& C) {
    unsigned char* ws = a.ws;
    const int combo = C.vcu >> 3, s = C.vcu & 7, b = combo >> 4, hq = combo & 15;
    attn_body::UnitArgs u; u.Q = (const attn_body::bf16*)(ws + WS_QKV); u.K = (const attn_body::bf16*)(ws + WS_QKV + 32 * MiB); u.V = (const attn_body::bf16*)(ws + WS_QKV + 36 * MiB); u.O = (attn_body::bf16*)(ws + WS_AO);
    u.qcol = hq * 64; u.kcol = (hq >> 3) * 64; u.ocol = hq * 64; u.Fl2 = nullptr; u.gate = nullptr; u.sel = nullptr; u.sinkp = a.in[13] + hq; u.bl2x2 = 0.f;
    char* shm = (char*)C.lds;
    if (C.vcu < 256)
        for (int i = 0; i < 4; ++i) attn_body::attn_unit<2, 8, 1024, 128, 1024>(b, 4 * s + i, u, shm);
}

constexpr int SC_LD = 129;
constexpr int PL_TOPIDX = 256 * SC_LD * 4;
constexpr int PL_ALDS = PL_TOPIDX + 4096;
constexpr int PL_END = PL_ALDS + 4096;
static_assert(PL_END <= LDSCTL_OFF, "PEER LDS map");
__device__ __forceinline__ float gelu_erf(float v) { return 0.5f * v * (1.0f + erff(v * 0.70710678118654752f)); }

template <bool LAST> __device__ __forceinline__ void peer_phase(const Args& a, const Ctx& C, int layer) {
    unsigned char* ws = a.ws;
    const bf16* qp = (const bf16*)(ws + WS_QP);
    const bf16* skb = (const bf16*)(ws + WS_SK) + (size_t)layer * 131072;
    const bf16* Dt = (const bf16*)(ws + WS_TAB + (size_t)(2 * layer) * 32 * MiB);
    const bf16* Ut = (const bf16*)(ws + WS_TAB + (size_t)(2 * layer + 1) * 32 * MiB);
    const float* rsp = (const float*)(ws + WS_RSP);
    const float* gffn = a.in[2] + layer * 1024;
    float* xio = a.out;
    LAS float* sc = (LAS float*)C.lds;
    LAS unsigned char* topidx = (LAS unsigned char*)(C.lds + PL_TOPIDX);
    LAS float* alds = (LAS float*)(C.lds + PL_ALDS) + C.wave * 128;
    LAS v2u* plist = (LAS v2u*)C.lds;
    const int w = C.wave;
    for (int tile = C.vcu; tile < M / 16; tile += C.G) {
        const int tok0 = tile * 16;
        int tid_ = C.tid; asm volatile("" : "+v"(tid_));
        const int tid = tid_, lane = tid & 63, l15 = lane & 15, lg = lane >> 4;
        {
            typedef float f32x4v __attribute__((ext_vector_type(4)));
#pragma unroll
            for (int p = 0; p < 2; ++p) {
                const bf16* qrow = qp + (size_t)(tok0 + l15) * 1024 + 128 * w + 64 * p + 8 * lg;
                const bf16x8 a0 = *(const bf16x8*)(qrow), a1 = *(const bf16x8*)(qrow + 32);
                const bf16* kb = skb + ((size_t)(w * 2 + p) * 128 + l15) * 64 + 8 * lg;
#pragma unroll
                for (int nt = 0; nt < 8; ++nt) {
                    const bf16x8 b0 = *(const bf16x8*)(kb + (size_t)nt * 16 * 64), b1 = *(const bf16x8*)(kb + (size_t)nt * 16 * 64 + 32);
                    f32x4v acc = {0.f, 0.f, 0.f, 0.f};
                    acc = __builtin_amdgcn_mfma_f32_16x16x32_bf16(a0, b0, acc, 0, 0, 0);
                    acc = __builtin_amdgcn_mfma_f32_16x16x32_bf16(a1, b1, acc, 0, 0, 0);
#pragma unroll
                    for (int r = 0; r < 4; ++r) sc[((w * 2 + p) * 16 + 4 * lg + r) * SC_LD + 16 * nt + l15] = acc[r];
                }
            }
        }
        __syncthreads();
        if (tid < 256) {
            const LAS float* row = sc + tid * SC_LD;
            float L[16];
#pragma unroll
            for (int i = 0; i < 16; ++i) L[i] = -INFINITY;
            for (int k0 = 0; k0 < 128; k0 += 8) {
#pragma unroll
                for (int kk = 0; kk < 8; ++kk) { const int k = k0 + kk;
                    const float v = __uint_as_float((__float_as_uint(row[k]) & 0xffffff80u) | (unsigned)(127 - k));
#pragma unroll
                    for (int i = 15; i >= 1; --i) L[i] = __builtin_amdgcn_fmed3f(L[i - 1], v, L[i]);
                    L[0] = fmaxf(L[0], v); }
            }
            unsigned pk[4];
#pragma unroll
            for (int i = 0; i < 4; ++i) pk[i] = (127u - (__float_as_uint(L[4 * i]) & 127u)) | ((127u - (__float_as_uint(L[4 * i + 1]) & 127u)) << 8) | ((127u - (__float_as_uint(L[4 * i + 2]) & 127u)) << 16) | ((127u - (__float_as_uint(L[4 * i + 3]) & 127u)) << 24);
            *(LAS v4u*)(topidx + tid * 16) = (v4u){pk[0], pk[1], pk[2], pk[3]};
        }
        __syncthreads();
        unsigned myidx[16]; float myg[16];
        if (tid < 128) {
            const int head = tid >> 4, token = tid & 15, P1 = (head * 2) * 16 + token, P2 = P1 + 16;
            const v4u i1 = *(const LAS v4u*)(topidx + P1 * 16), i2 = *(const LAS v4u*)(topidx + P2 * 16);
            float s1[16], s2[16];
#pragma unroll
            for (int i = 0; i < 16; ++i) { s1[i] = sc[P1 * SC_LD + ((i1[i >> 2] >> (8 * (i & 3))) & 255u)]; s2[i] = sc[P2 * SC_LD + ((i2[i >> 2] >> (8 * (i & 3))) & 255u)]; }
            float L[16];
#pragma unroll
            for (int i = 0; i < 16; ++i) L[i] = -INFINITY;
#pragma unroll
            for (int aa = 0; aa < 16; ++aa)
#pragma unroll
                for (int bb = 0; bb < 16; ++bb) if ((aa + 1) * (bb + 1) <= 16) {
                    const float v = __uint_as_float((__float_as_uint(s1[aa] + s2[bb]) & 0xffffff00u) | (unsigned)(255 - (aa * 16 + bb)));
#pragma unroll
                    for (int i = 15; i >= 1; --i) L[i] = __builtin_amdgcn_fmed3f(L[i - 1], v, L[i]);
                    L[0] = fmaxf(L[0], v); }
            float ts[16]; float mx = -INFINITY;
#pragma unroll
            for (int i = 0; i < 16; ++i) { const unsigned code = 255u - (__float_as_uint(L[i]) & 255u), aa = code >> 4, bb = code & 15u;
                const unsigned k1 = topidx[P1 * 16 + aa], k2 = topidx[P2 * 16 + bb];
                ts[i] = sc[P1 * SC_LD + k1] + sc[P2 * SC_LD + k2]; myidx[i] = k1 * 128u + k2; mx = fmaxf(mx, ts[i]); }
            float sum = 0.f;
#pragma unroll
            for (int i = 0; i < 16; ++i) { ts[i] = __expf(ts[i] - mx); sum += ts[i]; }
            const float inv = 1.0f / sum;
#pragma unroll
            for (int i = 0; i < 16; ++i) myg[i] = ts[i] * inv;
        }
        __syncthreads();
        if (tid < 128) { const int head = tid >> 4, token = tid & 15;
#pragma unroll
            for (int i = 0; i < 16; ++i) plist[token * 128 + head * 16 + i] = (v2u){myidx[i], __float_as_uint(myg[i])}; }
        __syncthreads();
        for (int tt = 0; tt < 2; ++tt) {
            int ln_ = tid; asm volatile("" : "+v"(ln_)); const int lane = ln_ & 63;
            const int token = 2 * w + tt, row = tok0 + token;
            const v2u pa = plist[token * 128 + lane], pb = plist[token * 128 + 64 + lane];
            const int e0 = (int)pa.x, e1 = (int)pb.x; const float g0 = __uint_as_float(pa.y), g1 = __uint_as_float(pb.y);
            float* xr = xio + (size_t)row * 1024;
            f32x4 xv[4]; xv[0] = *(const f32x4*)(xr + 8 * lane); xv[1] = *(const f32x4*)(xr + 8 * lane + 4); xv[2] = *(const f32x4*)(xr + 512 + 8 * lane); xv[3] = *(const f32x4*)(xr + 512 + 8 * lane + 4);
            float rn; { const f32x4 ra = *(const f32x4*)(rsp + (size_t)row * 16), rb = *(const f32x4*)(rsp + (size_t)row * 16 + 4), rc = *(const f32x4*)(rsp + (size_t)row * 16 + 8), rd = *(const f32x4*)(rsp + (size_t)row * 16 + 12);
                const float ss = ((ra[0] + ra[1]) + (ra[2] + ra[3])) + ((rb[0] + rb[1]) + (rb[2] + rb[3])) + ((rc[0] + rc[1]) + (rc[2] + rc[3])) + ((rd[0] + rd[1]) + (rd[2] + rd[3]));
                rn = 1.0f / sqrtf(ss * (1.0f / 1024.0f) + RMS_EPS); }
            unsigned xh[8];
            { const f32x4 ga = *(const f32x4*)(gffn + 8 * lane), gb = *(const f32x4*)(gffn + 8 * lane + 4), gc = *(const f32x4*)(gffn + 512 + 8 * lane), gd = *(const f32x4*)(gffn + 512 + 8 * lane + 4);
              const f32x4 n0 = xv[0] * rn * ga, n1 = xv[1] * rn * gb, n2 = xv[2] * rn * gc, n3 = xv[3] * rn * gd;
              xh[0] = pk2(n0.x, n0.y); xh[1] = pk2(n0.z, n0.w); xh[2] = pk2(n1.x, n1.y); xh[3] = pk2(n1.z, n1.w); xh[4] = pk2(n2.x, n2.y); xh[5] = pk2(n2.z, n2.w); xh[6] = pk2(n3.x, n3.y); xh[7] = pk2(n3.z, n3.w); }
            const bool hi32 = lane >= 32, b4 = (lane >> 4) & 1, b3 = (lane >> 3) & 1;
#pragma unroll 1
            for (int kk = 0; kk < 128; kk += 8) {
                v4u d0[8], d1[8];
#pragma unroll
                for (int i = 0; i < 8; ++i) { const int k = kk + i; const int e = (k < 64) ? __builtin_amdgcn_readlane(e0, k) : __builtin_amdgcn_readlane(e1, k - 64);
                    const bf16* rp = Dt + (size_t)e * 1024 + 8 * lane; d0[i] = *(const v4u*)rp; d1[i] = *(const v4u*)(rp + 512); }
                float p[8];
#pragma unroll
                for (int i = 0; i < 8; ++i) { float s0 = dot2bf(d0[i].x, xh[0], 0.f), s1 = dot2bf(d0[i].y, xh[1], 0.f); s0 = dot2bf(d0[i].z, xh[2], s0); s1 = dot2bf(d0[i].w, xh[3], s1);
                    s0 = dot2bf(d1[i].x, xh[4], s0); s1 = dot2bf(d1[i].y, xh[5], s1); s0 = dot2bf(d1[i].z, xh[6], s0); s1 = dot2bf(d1[i].w, xh[7], s1); p[i] = s0 + s1; }
                float q4[4], r2[2], s1v;
#pragma unroll
                for (int i = 0; i < 4; ++i) { const float send = hi32 ? p[i] : p[i + 4], keep = hi32 ? p[i + 4] : p[i]; q4[i] = keep + __shfl_xor(send, 32); }
#pragma unroll
                for (int i = 0; i < 2; ++i) { const float send = b4 ? q4[i] : q4[i + 2], keep = b4 ? q4[i + 2] : q4[i]; r2[i] = keep + __shfl_xor(send, 16); }
                { const float send = b3 ? r2[0] : r2[1], keep = b3 ? r2[1] : r2[0]; s1v = keep + __shfl_xor(send, 8); }
                s1v += __shfl_xor(s1v, 4); s1v += __shfl_xor(s1v, 2); s1v += __shfl_xor(s1v, 1);
                if ((lane & 7) == 0) alds[kk + 4 * (lane >> 5) + 2 * ((lane >> 4) & 1) + ((lane >> 3) & 1)] = s1v;
            }
            LDS_WAIT();
            const float w0 = g0 * gelu_erf(alds[lane]), w1 = g1 * gelu_erf(alds[64 + lane]);
            float o[16];
#pragma unroll
            for (int i = 0; i < 16; ++i) o[i] = 0.f;
#pragma unroll 1
            for (int kk = 0; kk < 128; kk += 8) {
                v4u u0[8], u1[8]; float wk[8];
#pragma unroll
                for (int i = 0; i < 8; ++i) { const int k = kk + i; const int e = (k < 64) ? __builtin_amdgcn_readlane(e0, k) : __builtin_amdgcn_readlane(e1, k - 64);
                    wk[i] = (k < 64) ? __uint_as_float(__builtin_amdgcn_readlane(__float_as_uint(w0), k)) : __uint_as_float(__builtin_amdgcn_readlane(__float_as_uint(w1), k - 64));
                    const bf16* rp = Ut + (size_t)e * 1024 + 8 * lane; u0[i] = *(const v4u*)rp; u1[i] = *(const v4u*)(rp + 512); }
#pragma unroll
                for (int i = 0; i < 8; ++i) {
#pragma unroll
                    for (int j = 0; j < 4; ++j) { o[2 * j] += wk[i] * bflo(u0[i][j]); o[2 * j + 1] += wk[i] * bfhi(u0[i][j]); o[8 + 2 * j] += wk[i] * bflo(u1[i][j]); o[8 + 2 * j + 1] += wk[i] * bfhi(u1[i][j]); } }
            }
            f32x4 y[4];
            y[0] = xv[0] + (f32x4){o[0], o[1], o[2], o[3]}; y[1] = xv[1] + (f32x4){o[4], o[5], o[6], o[7]}; y[2] = xv[2] + (f32x4){o[8], o[9], o[10], o[11]}; y[3] = xv[3] + (f32x4){o[12], o[13], o[14], o[15]};
            *(f32x4*)(xr + 8 * lane) = y[0]; *(f32x4*)(xr + 8 * lane + 4) = y[1]; *(f32x4*)(xr + 512 + 8 * lane) = y[2]; *(f32x4*)(xr + 512 + 8 * lane + 4) = y[3];
            if (!LAST) { bf16* xb = (bf16*)(ws + WS_XB) + (size_t)row * 1024; float ss = 0.f;
#pragma unroll
                for (int j = 0; j < 4; ++j) ss += (y[j].x * y[j].x + y[j].y * y[j].y) + (y[j].z * y[j].z + y[j].w * y[j].w);
                ss = wave_sum(ss);
                *(v4u*)(xb + 8 * lane) = (v4u){pk2(y[0].x, y[0].y), pk2(y[0].z, y[0].w), pk2(y[1].x, y[1].y), pk2(y[1].z, y[1].w)};
                *(v4u*)(xb + 512 + 8 * lane) = (v4u){pk2(y[2].x, y[2].y), pk2(y[2].z, y[2].w), pk2(y[3].x, y[3].y), pk2(y[3].z, y[3].w)};
                if (lane == 0) ((float*)(ws + WS_RA1))[row] = 1.0f / sqrtf(ss * (1.0f / 1024.0f) + RMS_EPS); }
        }
        __syncthreads();
    }
}

__global__ void __launch_bounds__(NWAVES * 64, 2) mk_fwd(Args args) {
    extern __shared__ __attribute__((aligned(16))) unsigned char lds[];
    Ctx C; C.lds = lds; C.tid = threadIdx.x; C.lane = C.tid & 63; C.wave = __builtin_amdgcn_readfirstlane(C.tid >> 6);
    C.G = gridDim.x; { const int bx = blockIdx.x; C.vcu = (C.G % 8 == 0) ? (bx % 8) * (C.G / 8) + bx / 8 : bx; }
    LAS unsigned char* lds3 = (LAS unsigned char*)lds;
    volatile LAS unsigned* MISC = (volatile LAS unsigned*)(lds3 + MISC_OFF);
    for (int u = C.tid; u < (LDS_BYTES - LDSCTL_OFF) / 4; u += NWAVES * 64) ((LAS unsigned*)(lds3 + LDSCTL_OFF))[u] = 0u;
    __syncthreads();
    unsigned char* ws = args.ws;
    gu32* ctl = (gu32*)(ws + WS_CTL);
    XcdBarrier bar; bar.bar = (unsigned*)(ctl + CW_BAR); bar.x = 0; bar.st = nullptr;
    if (N_LAUNCHES == 1) bar = xcd_barrier_post((unsigned*)(ctl + CW_BAR), MISC + 8);
    const int lo = args.ph_lo, hi = args.ph_hi;
#ifdef ONLY_PHASE
#define IN(k) ((k) == ONLY_PHASE && lo <= (k) && (k) < hi)
#else
#define IN(k) (lo <= (k) && (k) < hi)
#endif
#define SEAM(k) do { if (IN(k) && IN((k) + 1)) xcd_barrier(bar); } while (0)
    bf16* xb = (bf16*)(ws + WS_XB);
    if (IN(0)) { p0_prologue(args, C); SEAM(0); }
    if (IN(1)) {
        pg8::Gemm g{xb, (const bf16*)(ws + WS_WIN0), M, EV_N, DMODEL}; pg8::StaticOrder S; S.init(M, EV_N, C.G, (int)blockIdx.x);
        pg8::EpiProj<0> E{(const float*)(ws + WS_RA0), (const float*)(ws + WS_ROPE), (bf16*)(ws + WS_QKV), nullptr, nullptr, (const float*)(ws + WS_GAIN), (float*)(ws + WS_KSUM)};
        pg8::gemm_phase<pg8::EpiProj<0>, pg8::StaticOrder, true, true>(lds3, g, S, E);
        SEAM(1); }
    if (IN(2)) { p2_route(args, C); SEAM(2); }
    if (IN(3)) { p3_attn_l0(args, C); SEAM(3); }
    if (IN(4)) {
        pg8::Gemm g{(const bf16*)(ws + WS_AO), (const bf16*)(ws + WS_WOUT0), M, DMODEL, DMODEL}; pg8::StaticOrder S; S.init(M, DMODEL, C.G, (int)blockIdx.x);
        pg8::EpiResid E{args.in[0], args.out, xb, (float*)(ws + WS_RSP)};
        pg8::gemm_phase<pg8::EpiResid, pg8::StaticOrder, true, true>(lds3, g, S, E);
        SEAM(4); }
    if (IN(5)) {
        pg8::Gemm g{xb, (const bf16*)(ws + WS_WQ0), M, DMODEL, DMODEL}; pg8::StaticOrder S; S.init(M, DMODEL, C.G, (int)blockIdx.x);
        pg8::EpiPeerQ E{(const float*)(ws + WS_RSP), (bf16*)(ws + WS_QP)};
        pg8::gemm_phase<pg8::EpiPeerQ, pg8::StaticOrder, true, true>(lds3, g, S, E);
        SEAM(5); }
    if (IN(6)) { peer_phase<false>(args, C, 0); SEAM(6); }
    if (IN(7)) {
        pg8::Gemm g{xb, (const bf16*)(ws + WS_WIN1), M, OD_N, DMODEL}; pg8::StaticOrder S; S.init(M, OD_N, C.G, (int)blockIdx.x);
        pg8::EpiProj<1> E{(const float*)(ws + WS_RA1), (const float*)(ws + WS_ROPE), (bf16*)(ws + WS_QKV), (bf16*)(ws + WS_QKV + 32 * MiB), (bf16*)(ws + WS_QKV + 36 * MiB), (const float*)(ws + WS_GAIN) + 256, nullptr};
        pg8::gemm_phase<pg8::EpiProj<1>, pg8::StaticOrder, true, true>(lds3, g, S, E);
        SEAM(7); }
    if (IN(8)) { p8_attn_l1(args, C); SEAM(8); }
    if (IN(9)) {
        pg8::Gemm g{(const bf16*)(ws + WS_AO), (const bf16*)(ws + WS_WOUT1), M, DMODEL, DMODEL}; pg8::StaticOrder S; S.init(M, DMODEL, C.G, (int)blockIdx.x);
        pg8::EpiResid E{args.out, args.out, xb, (float*)(ws + WS_RSP)};
        pg8::gemm_phase<pg8::EpiResid, pg8::StaticOrder, true, true>(lds3, g, S, E);
        SEAM(9); }
    if (IN(10)) {
        pg8::Gemm g{xb, (const bf16*)(ws + WS_WQ1), M, DMODEL, DMODEL}; pg8::StaticOrder S; S.init(M, DMODEL, C.G, (int)blockIdx.x);
        pg8::EpiPeerQ E{(const float*)(ws + WS_RSP), (bf16*)(ws + WS_QP)};
        pg8::gemm_phase<pg8::EpiPeerQ, pg8::StaticOrder, true, true>(lds3, g, S, E);
        SEAM(10); }
    if (IN(11)) { peer_phase<true>(args, C, 1); }
#undef IN
#undef SEAM
}

extern "C" void kernel_launch(void* const* d_in, const int* in_sizes, int n_in, void* d_out, int out_size, void* d_ws, size_t ws_size, hipStream_t stream) {
    static int grid = 0;
    if (grid == 0) {
        if (n_in != 19 || in_sizes[0] != M * DMODEL || out_size != M * DMODEL || ws_size < WS_END) { fprintf(stderr, "kernel_launch: unexpected shapes (n_in %d, in0 %d, out %d, ws %zu); nothing launched\n", n_in, n_in > 0 ? in_sizes[0] : -1, out_size, ws_size); grid = -1; return; }
        int dev = 0, cus = 0, per_cu = 0;
        if (hipGetDevice(&dev) != hipSuccess || hipDeviceGetAttribute(&cus, hipDeviceAttributeMultiprocessorCount, dev) != hipSuccess) { grid = -1; return; }
        if (hipFuncSetAttribute((const void*)mk_fwd, hipFuncAttributeMaxDynamicSharedMemorySize, LDS_BYTES) != hipSuccess) { fprintf(stderr, "kernel_launch: hipFuncSetAttribute failed\n"); grid = -1; return; }
        if (hipOccupancyMaxActiveBlocksPerMultiprocessor(&per_cu, (const void*)mk_fwd, NWAVES * 64, LDS_BYTES) != hipSuccess || per_cu < 1) { fprintf(stderr, "kernel_launch: occupancy query reports %d workgroups per CU\n", per_cu); }
        (void)hipGetLastError();
        grid = cus;
        if (grid != 256) fprintf(stderr, "kernel_launch: %d CUs; the phase schedules assume 256\n", grid);
    }
    if (grid < 0) return;
    if (hipMemsetAsync((char*)d_ws + WS_CTL, 0, CTL_ZERO_BYTES, stream) != hipSuccess) { fprintf(stderr, "kernel_launch: hipMemsetAsync failed\n"); return; }
    Args a{};
    for (int i = 0; i < 19; ++i) a.in[i] = (const float*)d_in[i];
    a.out = (float*)d_out; a.ws = (unsigned char*)d_ws;
    for (int li = 0; li < N_LAUNCHES; ++li) {
        a.ph_lo = (N_LAUNCHES == 1) ? 0 : li; a.ph_hi = (N_LAUNCHES == 1) ? N_PHASES : li + 1; a.li = li;
        hipLaunchKernelGGL(mk_fwd, dim3(grid), dim3(NWAVES * 64), LDS_BYTES, stream, a);
        const hipError_t le = hipPeekAtLastError();
        if (le != hipSuccess) { fprintf(stderr, "kernel_launch: launch %d failed: %s\n", li, hipGetErrorName(le)); break; }
    }
}
```

```cpp
#define MK_N_LAUNCHES 1
#include <hip/hip_runtime.h>
#include <cstdio>
#include <cstdint>
namespace pg8 {
#define PG8_LAS __attribute__((address_space(3)))
typedef unsigned short bf16_t;
typedef short bf16x8 __attribute__((ext_vector_type(8)));
typedef float f32x4 __attribute__((ext_vector_type(4)));
typedef unsigned u32x4 __attribute__((ext_vector_type(4)));
constexpr int BM = 256, BK = 64, HALF = 128, HTB = HALF * BK * 2  , STAGE_BYTES = 8 * HTB, NXCD = 8, WGM = 8;

__host__ __device__ __forceinline__ int lds_byte(int r, int c) { const int st = (r >> 4) * 2 + (c >> 5), rr = r & 15, cc = c & 31, ob = rr * 64 + cc * 2; return st * 1024 + (ob ^ (((ob >> 9) & 1) << 5)); }
__host__ __device__ __forceinline__ void stage_rc(int b, int& R, int& C) { const int st = b / 1024, sb = b % 1024, swz = sb ^ (((sb >> 9) & 1) << 5); R = (st >> 1) * 16 + swz / 64; C = (st & 1) * 32 + (swz % 64) / 2; }
__host__ __device__ __forceinline__ int perm32(int rho) { const int n = rho >> 4, i = rho & 15; return 8 * (i >> 2) + 4 * n + (i & 3); }

struct Unit { int pm, pn; };
struct Gemm { const bf16_t* A; const bf16_t* Bt; int M, N, K; };

struct StaticOrder {
    int nM, nN, nwg, G, c;
    __host__ __device__ void init(int M, int N, int G_, int c_) { nM = M / BM; nN = N / BM; nwg = nM * nN; G = G_; c = c_; }
    __host__ __device__ bool next(int i, Unit& u) const {
        const long L = (long)i * G + c; if (L >= nwg) return false;
        int wgid = (int)L; { const int q = nwg / NXCD, r = nwg % NXCD, xcd = wgid % NXCD, off = wgid / NXCD; wgid = (xcd < r ? xcd * (q + 1) : r * (q + 1) + (xcd - r) * q) + off; }
        const int nig = WGM * nN, gid = wgid / nig, fm = gid * WGM, gsz = (nM - fm) < WGM ? (nM - fm) : WGM;
        u.pm = fm + ((wgid % nig) % gsz); u.pn = (wgid % nig) / gsz; return true;
    }
    __device__ __forceinline__ void a_ready(const Unit&) const {}
    __device__ __forceinline__ void done(const Unit&) const {}
};

__device__ __forceinline__ unsigned cvt_pk_bf16(float lo, float hi) { unsigned r; asm volatile("v_cvt_pk_bf16_f32 %0, %1, %2" : "=v"(r) : "v"(lo), "v"(hi)); return r; }
typedef float f32x2 __attribute__((ext_vector_type(2)));
__device__ __forceinline__ f32x2 gelu_pk(f32x2 v) {
    const f32x2 av = __builtin_elementwise_abs(v), d = av * 0.2316418882f + 1.0f;
    f32x2 t; t.x = __builtin_amdgcn_rcpf(d.x); t.y = __builtin_amdgcn_rcpf(d.y);
    f32x2 q = t * 0.5307027145f + (-0.7265760135f); q = q * t + 0.7107068705f; q = q * t + (-0.142248368f); q = q * t + 0.127414796f; q = q * t;
    const f32x2 s = (v * v) * (-0.72134752044f);
    f32x2 e; e.x = __builtin_amdgcn_exp2f(s.x); e.y = __builtin_amdgcn_exp2f(s.y);
    const f32x2 m = v * (q * e), r = v - m;
    f32x2 o; o.x = v.x < 0.f ? m.x : r.x; o.y = v.y < 0.f ? m.y : r.y; return o;
}

template <int ACT  > struct EpiBf16 {
    static constexpr bool PERM = true, AFTER_DRAIN = false; static_assert(ACT == 0 || ACT == 1, "EpiBf16: ACT is 0 (none) or 1 (gelu_pk)");
    bf16_t* O; int ldc; const float* bias; int split_cols; size_t split_stride; float scale0;
    __device__ __forceinline__ void operator()(const f32x4 (&acc)[2][2][4][2], const Unit& u, int wr, int wc, int fr, int fq) const {
        const int row0 = u.pm * BM + wr * 64 + fr; int colt = u.pn * BM; bf16_t* base = O;
        float sc = 1.f; if (split_cols) { const int t = colt / split_cols; base += (size_t)t * split_stride; colt -= t * split_cols; if (t == 0) sc = scale0; }
        const int col0 = colt + wc * 32 + 8 * fq, bcol0 = u.pn * BM + wc * 32 + 8 * fq;
        f32x4 bv[2][2];
#pragma unroll
        for (int bj = 0; bj < 2; ++bj)
#pragma unroll
            for (int n = 0; n < 2; ++n) bv[bj][n] = bias ? *(const f32x4*)(bias + bcol0 + bj * HALF + 4 * n) : (f32x4){0.f, 0.f, 0.f, 0.f};
#pragma unroll
        for (int ai = 0; ai < 2; ++ai)
#pragma unroll
            for (int m = 0; m < 4; ++m) { bf16_t* rowp = base + (size_t)(row0 + ai * HALF + m * 16) * ldc + col0;
#pragma unroll
                for (int bj = 0; bj < 2; ++bj) { f32x4 v0 = acc[ai][bj][m][0] + bv[bj][0], v1 = acc[ai][bj][m][1] + bv[bj][1];
                    if (ACT == 1) { f32x2 a = gelu_pk((f32x2){v0[0], v0[1]}), b = gelu_pk((f32x2){v0[2], v0[3]}), c = gelu_pk((f32x2){v1[0], v1[1]}), d = gelu_pk((f32x2){v1[2], v1[3]});
                        v0 = (f32x4){a.x, a.y, b.x, b.y}; v1 = (f32x4){c.x, c.y, d.x, d.y}; }
                    v0 = v0 * sc; v1 = v1 * sc; u32x4 w; w.x = cvt_pk_bf16(v0[0], v0[1]); w.y = cvt_pk_bf16(v0[2], v0[3]); w.z = cvt_pk_bf16(v1[0], v1[1]); w.w = cvt_pk_bf16(v1[2], v1[3]);
                    *(u32x4*)(rowp + bj * HALF) = w; } }
    }
};

template <class Epi, class Sched, bool ALIGN_EPI = false, bool SP2 = false>
__device__ __forceinline__ void gemm_phase(PG8_LAS unsigned char* lds, const Gemm g, const Sched& S, const Epi& E) {
    const int tid = threadIdx.x, wid = __builtin_amdgcn_readfirstlane(tid >> 6), lane = tid & 63, wr = wid >> 2, wc = wid & 3, fr = lane & 15, fq = lane >> 4;
    const int K = g.K, nt = K / BK;
    unsigned voffA[2], voffB[2];
#pragma unroll
    for (int i = 0; i < 2; ++i) { int R, C; stage_rc(tid * 16 + i * 8192, R, C); const int Rb = Epi::PERM ? ((R & ~31) + perm32(R & 31)) : R;
        voffA[i] = (unsigned)(R * K + C) * 2u; voffB[i] = (unsigned)(Rb * K + C) * 2u; }
    const size_t kstep = (size_t)(BK * 2);
    const size_t hstep = (size_t)HALF * K * 2;
    const size_t tstep = 2 * hstep;
    const unsigned ldsw = (unsigned)wid * 1024u;
    const int aoff = lds_byte(wr * 64 + fr, fq * 8), boff = lds_byte(wc * 32 + fr, fq * 8);
#define PG8_SA(b, h) (((b) * 2 + (h)) * HTB)
#define PG8_SB(b, h) ((4 + (b) * 2 + (h)) * HTB)
#define PG8_STAGE(bufoff, gbase, voff) do { _Pragma("unroll") for (int _i = 0; _i < 2; ++_i) \
        __builtin_amdgcn_global_load_lds((const unsigned*)((const char*)(gbase) + (voff)[_i]), (PG8_LAS unsigned*)(lds + (bufoff) + ldsw + _i * 8192), 16, 0, 0); } while (0)
#define PG8_LDA(dst, b, h) do { _Pragma("unroll") for (int m = 0; m < 4; ++m) _Pragma("unroll") for (int k = 0; k < 2; ++k) dst[m][k] = *(const PG8_LAS bf16x8*)(lds + PG8_SA(b, h) + aoff + m * 2048 + k * 1024); } while (0)
#define PG8_LDB(dst, b, h) do { _Pragma("unroll") for (int n = 0; n < 2; ++n) _Pragma("unroll") for (int k = 0; k < 2; ++k) dst[n][k] = *(const PG8_LAS bf16x8*)(lds + PG8_SB(b, h) + boff + n * 2048 + k * 1024); } while (0)
#define PG8_MMA(ai, bj, At, Bt) do { __builtin_amdgcn_s_setprio(1); _Pragma("unroll") for (int m = 0; m < 4; ++m) _Pragma("unroll") for (int n = 0; n < 2; ++n) _Pragma("unroll") for (int k = 0; k < 2; ++k) \
        acc[ai][bj][m][n] = __builtin_amdgcn_mfma_f32_16x16x32_bf16(Bt[n][k], At[m][k], acc[ai][bj][m][n], 0, 0, 0); __builtin_amdgcn_s_setprio(0); } while (0)
#define PG8_WAIT_V(n) asm volatile("s_waitcnt vmcnt(" #n ")" ::: "memory")
#define PG8_WAIT_L(n) asm volatile("s_waitcnt lgkmcnt(" #n ")" ::: "memory")
#define PG8_BAR __builtin_amdgcn_s_barrier()
#define PG8_SCHED __builtin_amdgcn_sched_barrier(0)
    Unit cur, nxt; int ui = 0;
    if (!S.next(0, cur)) return;
    f32x4 acc[2][2][4][2];
#pragma unroll
    for (int a = 0; a < 2; ++a)
#pragma unroll
        for (int b = 0; b < 2; ++b)
#pragma unroll
            for (int m = 0; m < 4; ++m)
#pragma unroll
                for (int n = 0; n < 2; ++n) acc[a][b][m][n] = (f32x4){0.f, 0.f, 0.f, 0.f};
    bf16x8 At[4][2], B0[2][2], B1[2][2];
    const char* cA = (const char*)g.A + (size_t)cur.pm * tstep; const char* cB = (const char*)g.Bt + (size_t)cur.pn * tstep;
    S.a_ready(cur);
    if constexpr (SP2) {
        PG8_STAGE(PG8_SB(0, 0), cB, voffB); PG8_STAGE(PG8_SB(0, 1), cB + hstep, voffB); PG8_STAGE(PG8_SA(0, 0), cA, voffA); PG8_STAGE(PG8_SA(0, 1), cA + hstep, voffA);
        if (wr == 1) PG8_BAR;
        PG8_WAIT_V(2); PG8_BAR;
        PG8_STAGE(PG8_SB(1, 0), cB + kstep, voffB); PG8_STAGE(PG8_SA(1, 0), cA + kstep, voffA); PG8_STAGE(PG8_SB(1, 1), cB + hstep + kstep, voffB);
        PG8_WAIT_V(6); PG8_BAR;
    } else {
        PG8_STAGE(PG8_SB(0, 0), cB, voffB); PG8_STAGE(PG8_SA(0, 0), cA, voffA); PG8_STAGE(PG8_SB(0, 1), cB + hstep, voffB); PG8_STAGE(PG8_SA(0, 1), cA + hstep, voffA);
        if (wr == 1) PG8_BAR;
        PG8_WAIT_V(4); PG8_BAR;
        PG8_STAGE(PG8_SB(1, 0), cB + kstep, voffB); PG8_STAGE(PG8_SA(1, 0), cA + kstep, voffA); PG8_STAGE(PG8_SB(1, 1), cB + hstep + kstep, voffB);
        PG8_WAIT_V(6); PG8_BAR;
    }
    for (;;) {
        const bool has_next = S.next(ui + 1, nxt);
        const char* nA = has_next ? (const char*)g.A + (size_t)nxt.pm * tstep : cA; const char* nB = has_next ? (const char*)g.Bt + (size_t)nxt.pn * tstep : cB;
        for (int t = 0; t < nt; t += 2) {
            const bool last = (t == nt - 2);
            const char* a1 = cA + (size_t)(t + 1) * kstep;
            const char* a2 = last ? nA : cA + (size_t)(t + 2) * kstep; const char* b2 = last ? nB : cB + (size_t)(t + 2) * kstep;
            const char* a3 = a2 + kstep; const char* b3 = b2 + kstep;
            if (last && has_next) S.a_ready(nxt);
            if constexpr (SP2) {
            PG8_LDB(B0, 0, 0); PG8_LDB(B1, 0, 1); PG8_SCHED; PG8_LDA(At, 0, 0); PG8_STAGE(PG8_SA(1, 1), a1 + hstep, voffA);
            PG8_WAIT_V(8); PG8_WAIT_L(0); PG8_BAR; PG8_MMA(0, 0, At, B0); PG8_MMA(0, 1, At, B1); PG8_BAR; PG8_SCHED;
            PG8_LDA(At, 0, 1); PG8_STAGE(PG8_SB(0, 0), b2, voffB); PG8_STAGE(PG8_SB(0, 1), b2 + hstep, voffB); PG8_STAGE(PG8_SA(0, 0), a2, voffA);
            PG8_WAIT_V(8); PG8_WAIT_L(0); PG8_BAR; PG8_MMA(1, 0, At, B0); PG8_MMA(1, 1, At, B1); PG8_BAR; PG8_SCHED;
            PG8_LDB(B0, 1, 0); PG8_LDB(B1, 1, 1); PG8_SCHED; PG8_LDA(At, 1, 0); PG8_STAGE(PG8_SA(0, 1), a2 + hstep, voffA);
            PG8_WAIT_V(8); PG8_WAIT_L(0); PG8_BAR; PG8_MMA(0, 0, At, B0); PG8_MMA(0, 1, At, B1); PG8_BAR; PG8_SCHED;
            PG8_LDA(At, 1, 1); PG8_STAGE(PG8_SB(1, 0), b3, voffB); PG8_STAGE(PG8_SB(1, 1), b3 + hstep, voffB); PG8_STAGE(PG8_SA(1, 0), a3, voffA);
            PG8_WAIT_V(8); PG8_WAIT_L(0); PG8_BAR; PG8_MMA(1, 0, At, B0); PG8_MMA(1, 1, At, B1); PG8_BAR; PG8_SCHED;
            } else {
            PG8_LDB(B0, 0, 0); PG8_SCHED; PG8_LDA(At, 0, 0); PG8_STAGE(PG8_SA(1, 1), a1 + hstep, voffA);
            PG8_WAIT_L(8); PG8_BAR; PG8_WAIT_L(0); PG8_MMA(0, 0, At, B0); PG8_BAR; PG8_SCHED;
            PG8_LDB(B1, 0, 1); PG8_STAGE(PG8_SB(0, 0), b2, voffB);
            PG8_BAR; PG8_WAIT_L(0); PG8_MMA(0, 1, At, B1); PG8_BAR;
            PG8_LDA(At, 0, 1); PG8_STAGE(PG8_SA(0, 0), a2, voffA);
            PG8_BAR; PG8_WAIT_L(0); PG8_MMA(1, 0, At, B0); PG8_BAR; PG8_SCHED;
            PG8_STAGE(PG8_SB(0, 1), b2 + hstep, voffB);
            PG8_WAIT_V(6); PG8_BAR; PG8_MMA(1, 1, At, B1); PG8_BAR;
            PG8_LDB(B0, 1, 0); PG8_SCHED; PG8_LDA(At, 1, 0); PG8_STAGE(PG8_SA(0, 1), a2 + hstep, voffA);
            PG8_WAIT_L(8); PG8_BAR; PG8_WAIT_L(0); PG8_MMA(0, 0, At, B0); PG8_BAR; PG8_SCHED;
            PG8_LDB(B1, 1, 1); PG8_STAGE(PG8_SB(1, 0), b3, voffB);
            PG8_BAR; PG8_WAIT_L(0); PG8_MMA(0, 1, At, B1); PG8_BAR;
            PG8_LDA(At, 1, 1); PG8_STAGE(PG8_SA(1, 0), a3, voffA);
            PG8_BAR; PG8_WAIT_L(0); PG8_MMA(1, 0, At, B0); PG8_BAR; PG8_SCHED;
            PG8_STAGE(PG8_SB(1, 1), b3 + hstep, voffB);
            PG8_WAIT_V(6); PG8_BAR; PG8_MMA(1, 1, At, B1); PG8_BAR;
            }
        }
        if constexpr (ALIGN_EPI) { if (wr == 0) PG8_BAR; }
        if constexpr (!Epi::AFTER_DRAIN) { E(acc, cur, wr, wc, fr, fq); S.done(cur); }
        if (!has_next) break;
#pragma unroll
        for (int a = 0; a < 2; ++a)
#pragma unroll
            for (int b = 0; b < 2; ++b)
#pragma unroll
                for (int m = 0; m < 4; ++m)
#pragma unroll
                    for (int n = 0; n < 2; ++n) acc[a][b][m][n] = (f32x4){0.f, 0.f, 0.f, 0.f};
        cur = nxt; cA = nA; cB = nB; ++ui;
        if constexpr (ALIGN_EPI) { if (wr == 1) PG8_BAR; }
    }
    PG8_WAIT_V(0);
    if constexpr (!ALIGN_EPI) { if (wr == 0) PG8_BAR; }
    PG8_BAR;
    if constexpr (Epi::AFTER_DRAIN) { E.fused(acc, cur, wr, wc, fr, fq, lds, wid, lane); S.done(cur); }
#undef PG8_SA
#undef PG8_SB
#undef PG8_STAGE
#undef PG8_LDA
#undef PG8_LDB
#undef PG8_MMA
#undef PG8_WAIT_V
#undef PG8_WAIT_L
#undef PG8_BAR
#undef PG8_SCHED
}
}
namespace pg8 {
typedef unsigned u32x2 __attribute__((ext_vector_type(2)));
constexpr float RMS_EPS = 1e-6f;
constexpr float QC2 = 0.125f * 1.4426950408889634f;
constexpr int MROWS = 16384;

template <int LAYER> struct EpiProj {
    static constexpr bool PERM = true, AFTER_DRAIN = false;
    const float* rrow; const float* cs; bf16_t* base; bf16_t* k1; bf16_t* v1; const float* gains; float* ksum; int pn_off;
    __device__ __forceinline__ void operator()(const f32x4 (&acc)[2][2][4][2], const Unit& u, int wr, int wc, int fr, int fq) const {
        int kind; bf16_t* dst; int pitch, col, head = 0; const float* gain;
        if (LAYER == 0) { const int pnx = u.pn + pn_off; const int grp = pnx >> 1; head = (pnx & 1) * 4 + wc; dst = base + (size_t)grp * ((size_t)MROWS * 512); pitch = 512; col = head * 64 + 16 * fq;
            kind = grp == 0 ? (1 | 2 | 4) : grp == 1 ? (1 | 2 | 16) : grp == 3 ? (1 | 4) : grp == 4 ? 1 : grp == 6 ? 8 : 0;
            gain = gains + 64 * (grp == 0 ? 0 : grp == 1 ? 1 : grp == 3 ? 2 : 3); }
        else { if (u.pn < 4) { dst = base; pitch = 1024; col = (u.pn * 4 + wc) * 64 + 16 * fq; kind = 1 | 2 | 4; gain = gains; }
               else if (wc < 2) { dst = k1; pitch = 128; col = wc * 64 + 16 * fq; kind = 1 | 2; gain = gains + 64; }
               else { dst = v1; pitch = 128; col = (wc - 2) * 64 + 16 * fq; kind = 0; gain = gains + 64; } }
        f32x4 gv[2][2];
#pragma unroll
        for (int bj = 0; bj < 2; ++bj)
#pragma unroll
            for (int n = 0; n < 2; ++n) gv[bj][n] = *(const f32x4*)(gain + 16 * fq + 8 * bj + 4 * n);
        f32x4 ks[2][2];
#pragma unroll
        for (int bj = 0; bj < 2; ++bj)
#pragma unroll
            for (int n = 0; n < 2; ++n) ks[bj][n] = (f32x4){0.f, 0.f, 0.f, 0.f};
#pragma unroll
        for (int ai = 0; ai < 2; ++ai)
#pragma unroll
            for (int m = 0; m < 4; ++m) {
                const int row = u.pm * BM + ai * HALF + wr * 64 + m * 16 + fr; const float rs = rrow[row];
                f32x4 v[2][2];
#pragma unroll
                for (int bj = 0; bj < 2; ++bj)
#pragma unroll
                    for (int n = 0; n < 2; ++n) v[bj][n] = acc[ai][bj][m][n] * rs;
                if (kind & 1) { float ss = 0.f;
#pragma unroll
                    for (int bj = 0; bj < 2; ++bj)
#pragma unroll
                        for (int n = 0; n < 2; ++n) { const f32x4 x = v[bj][n]; ss += (x[0] * x[0] + x[1] * x[1]) + (x[2] * x[2] + x[3] * x[3]); }
                    ss += __shfl_xor(ss, 16); ss += __shfl_xor(ss, 32);
                    const float ri = 1.0f / sqrtf(ss * (1.0f / 64.0f) + RMS_EPS);
#pragma unroll
                    for (int bj = 0; bj < 2; ++bj)
#pragma unroll
                        for (int n = 0; n < 2; ++n) v[bj][n] = (v[bj][n] * ri) * gv[bj][n]; }
                if ((kind & 2) && fq == 0) { const float* cp = cs + (size_t)(row & 8191) * 16;
#pragma unroll
                    for (int n = 0; n < 2; ++n) { const f32x4 c = *(const f32x4*)(cp + 4 * n), s = *(const f32x4*)(cp + 8 + 4 * n); const f32x4 x1 = v[0][n], x2 = v[1][n];
                        v[0][n] = x1 * c - x2 * s; v[1][n] = x2 * c + x1 * s; } }
                if (kind & 16) {
#pragma unroll
                    for (int bj = 0; bj < 2; ++bj)
#pragma unroll
                        for (int n = 0; n < 2; ++n) ks[bj][n] += v[bj][n]; }
                if (kind & 4) {
#pragma unroll
                    for (int bj = 0; bj < 2; ++bj)
#pragma unroll
                        for (int n = 0; n < 2; ++n) v[bj][n] = v[bj][n] * QC2; }
                if (kind & 8) {
#pragma unroll
                    for (int bj = 0; bj < 2; ++bj)
#pragma unroll
                        for (int n = 0; n < 2; ++n)
#pragma unroll
                            for (int j = 0; j < 4; ++j) v[bj][n][j] = 1.0f / (1.0f + __expf(-v[bj][n][j])); }
                bf16_t* rp = dst + (size_t)row * pitch + col;
#pragma unroll
                for (int bj = 0; bj < 2; ++bj) { u32x4 w; w.x = cvt_pk_bf16(v[bj][0][0], v[bj][0][1]); w.y = cvt_pk_bf16(v[bj][0][2], v[bj][0][3]); w.z = cvt_pk_bf16(v[bj][1][0], v[bj][1][1]); w.w = cvt_pk_bf16(v[bj][1][2], v[bj][1][3]);
                    *(u32x4*)(rp + 8 * bj) = w; }
            }
        if (LAYER == 0 && (kind & 16)) {
#pragma unroll
            for (int bj = 0; bj < 2; ++bj)
#pragma unroll
                for (int n = 0; n < 2; ++n)
#pragma unroll
                    for (int j = 0; j < 4; ++j) { float s = ks[bj][n][j]; s += __shfl_xor(s, 1); s += __shfl_xor(s, 2); s += __shfl_xor(s, 4); s += __shfl_xor(s, 8); ks[bj][n][j] = s; }
            if (fr == 0) { float* kp = ksum + ((size_t)((u.pm * 2 + wr) * 8 + head)) * 64 + 16 * fq;
#pragma unroll
                for (int bj = 0; bj < 2; ++bj)
#pragma unroll
                    for (int n = 0; n < 2; ++n) *(f32x4*)(kp + 8 * bj + 4 * n) = ks[bj][n]; }
        }
    }
};

struct EpiResid {
    static constexpr bool PERM = false, AFTER_DRAIN = false;
    const float* xin; float* xout; bf16_t* xb; float* rsp;
    __device__ __forceinline__ void operator()(const f32x4 (&acc)[2][2][4][2], const Unit& u, int wr, int wc, int fr, int fq) const {
        const int col0 = u.pn * BM + wc * 32 + 4 * fq;
#pragma unroll
        for (int ai = 0; ai < 2; ++ai)
#pragma unroll
            for (int m = 0; m < 4; ++m) { const int row = u.pm * BM + ai * HALF + wr * 64 + m * 16 + fr; float ss = 0.f;
#pragma unroll
                for (int bj = 0; bj < 2; ++bj)
#pragma unroll
                    for (int n = 0; n < 2; ++n) { const size_t off = (size_t)row * 1024 + col0 + bj * HALF + n * 16;
                        const f32x4 o = *(const f32x4*)(xin + off) + acc[ai][bj][m][n]; *(f32x4*)(xout + off) = o;
                        ss += (o[0] * o[0] + o[1] * o[1]) + (o[2] * o[2] + o[3] * o[3]);
                        u32x2 w; w.x = cvt_pk_bf16(o[0], o[1]); w.y = cvt_pk_bf16(o[2], o[3]); *(u32x2*)(xb + off) = w; }
                ss += __shfl_xor(ss, 16); ss += __shfl_xor(ss, 32);
                if (fq == 0) rsp[(size_t)row * 16 + u.pn * 4 + wc] = ss; }
    }
};

struct EpiPeerQ {
    static constexpr bool PERM = true, AFTER_DRAIN = false;
    const float* rsp; bf16_t* qp;
    __device__ __forceinline__ void operator()(const f32x4 (&acc)[2][2][4][2], const Unit& u, int wr, int wc, int fr, int fq) const {
        const int col0 = u.pn * BM + wc * 32 + 8 * fq;
#pragma unroll
        for (int ai = 0; ai < 2; ++ai)
#pragma unroll
            for (int m = 0; m < 4; ++m) { const int row = u.pm * BM + ai * HALF + wr * 64 + m * 16 + fr;
                const f32x4 a = *(const f32x4*)(rsp + (size_t)row * 16), b = *(const f32x4*)(rsp + (size_t)row * 16 + 4), c = *(const f32x4*)(rsp + (size_t)row * 16 + 8), d = *(const f32x4*)(rsp + (size_t)row * 16 + 12);
                const float ss = ((a[0] + a[1]) + (a[2] + a[3])) + ((b[0] + b[1]) + (b[2] + b[3])) + ((c[0] + c[1]) + (c[2] + c[3])) + ((d[0] + d[1]) + (d[2] + d[3]));
                const float rs = 1.0f / sqrtf(ss * (1.0f / 1024.0f) + RMS_EPS);
                bf16_t* rp = qp + (size_t)row * 1024 + col0;
#pragma unroll
                for (int bj = 0; bj < 2; ++bj) { const f32x4 v0 = acc[ai][bj][m][0] * rs, v1 = acc[ai][bj][m][1] * rs; u32x4 w; w.x = cvt_pk_bf16(v0[0], v0[1]); w.y = cvt_pk_bf16(v0[2], v0[3]); w.z = cvt_pk_bf16(v1[0], v1[1]); w.w = cvt_pk_bf16(v1[2], v1[3]);
                    *(u32x4*)(rp + bj * HALF) = w; } }
    }
};
}
#include <hip/hip_bf16.h>
#include <cmath>
namespace attn_body {
using bf16=__hip_bfloat16;
using bf16x8=__attribute__((ext_vector_type(8)))short;
using s16x4=__attribute__((ext_vector_type(4)))short;
using f32x16=__attribute__((ext_vector_type(16)))float;
using u32x4=__attribute__((ext_vector_type(4)))unsigned;
constexpr int BATCH=2,SEQ=8192,D=64;
constexpr int NW=8,QBLK=32,QB=QBLK*NW,KVBLK=64,NQB=SEQ/QB;
constexpr int ATTN_UNIT_ROWS=QB;
__device__ __forceinline__ int crow(int r,int hi){return (r&3)+8*(r>>2)+4*hi;}
#define SBAR() __builtin_amdgcn_sched_barrier(0)
typedef __attribute__((address_space(3))) const float* lds_cfptr;
typedef float f32x4a __attribute__((ext_vector_type(4)));
__device__ __forceinline__ float badd_s(float a,float b){float r;asm("v_add_f32_e32 %0, %1, %2":"=v"(r):"v"(a),"v"(b));return r;}
template<int VAR,bool BAND> __device__ __forceinline__ void bias_tile(f32x16&p0,f32x16&p1,int t,int jb,int qrel,int hi,lds_cfptr ftab,unsigned selm,int t0,float negs){
  const float NEG=-INFINITY;
  if(VAR==1){ const lds_cfptr f=ftab+64*t+4*hi;
    #pragma unroll
    for(int g=0;g<4;++g){ const f32x4a a=*(const __attribute__((address_space(3))) f32x4a*)(f+8*g); const f32x4a c=*(const __attribute__((address_space(3))) f32x4a*)(f+32+8*g);
      #pragma unroll
      for(int j=0;j<4;++j){p0[4*g+j]+=negs-a[j];p1[4*g+j]+=negs-c[j];} } }
  else { float s=negs;
    if(VAR==0){ if(!BAND||jb<0){ const bool ok=((selm>>((t0+t)>>2))&1u)!=0u; s=ok?negs:NEG; } }
    #pragma unroll
    for(int r=0;r<16;++r){p0[r]+=s;p1[r]+=s;} }
  if(BAND){
    if(VAR==2){ const int kb=64*jb+4*hi;
      #pragma unroll
      for(int r=0;r<16;++r){const int kv=kb+(r&3)+8*(r>>2); if(kv>qrel||kv<=qrel-128)p0[r]=NEG; if(kv+32>qrel||kv+32<=qrel-128)p1[r]=NEG;} }
    else if(jb>=0&&VAR!=3){ const int kb=64*jb+4*hi;
      #pragma unroll
      for(int r=0;r<16;++r){const int kv=kb+(r&3)+8*(r>>2); if(kv>qrel)p0[r]=NEG; if(kv+32>qrel)p1[r]=NEG;} }
  }
}
struct UnitArgs { const bf16*Q; const bf16*K; const bf16*V; bf16*O; int qcol,kcol,ocol; const float*Fl2; const bf16*gate; const unsigned*sel; const float*sinkp; float bl2x2; const unsigned short*glist; int gn; bf16*PO; float*LSE; int kvres; };

constexpr int NSLOT=3, SLOTB=8192;
constexpr int LDS_K=0, LDS_V=NSLOT*SLOTB, LDS_WS=2*NSLOT*SLOTB, LDS_OST=LDS_WS+NW*256*4, LDS_F=90112, LDS_BYTES=LDS_F+SEQ*4;
constexpr float C2=0.125f*1.4426950408889634f;
__device__ __forceinline__ void glds16(const void*gsrc,unsigned lds_dst){unsigned keep;
  asm volatile("s_mov_b32 %0, m0\n\ts_mov_b32 m0, %2\n\ts_nop 0\n\tglobal_load_lds_dwordx4 %1, off\n\ts_mov_b32 m0, %0":"=&s"(keep):"v"(gsrc),"s"(lds_dst):"memory");}
__device__ __forceinline__ float max3f(float a,float b,float c){float r;asm("v_max3_f32 %0, %1, %2, %3":"=v"(r):"v"(a),"v"(b),"v"(c));return r;}
__device__ __forceinline__ float max2f(float a,float b){float r;asm("v_max_f32_e32 %0, %1, %2":"=v"(r):"v"(a),"v"(b));return r;}
__device__ __forceinline__ float fadd_s(float a,float b){float r;asm("v_add_f32_e32 %0, %1, %2":"=v"(r):"v"(a),"v"(b));return r;}
__device__ __forceinline__ float fsub_s(float a,float b){float r;asm("v_sub_f32_e32 %0, %1, %2":"=v"(r):"v"(a),"v"(b));return r;}
typedef float f32x2_t __attribute__((ext_vector_type(2))); typedef __bf16 bf16x2_t __attribute__((ext_vector_type(2)));
__device__ __forceinline__ unsigned cvtpk_s(float lo,float hi){f32x2_t v={lo,hi};bf16x2_t b=__builtin_convertvector(v,bf16x2_t);return __builtin_bit_cast(unsigned,b);}
#define WAIT_BAR(N) asm volatile("s_waitcnt vmcnt(" #N ") lgkmcnt(0)\n\ts_barrier":::"memory")

__device__ __forceinline__ void qkt(f32x16&p0,f32x16&p1,const char*Kslot,const bf16x8*qr,const f32x16&negm,int r32,int hi){
  const char*kb=Kslot+hi*1024+r32*16;
  #pragma unroll
  for(int d0=0;d0<4;++d0){
    const bf16x8 b0=*reinterpret_cast<const bf16x8*>(kb+d0*2048);
    const bf16x8 b1=*reinterpret_cast<const bf16x8*>(kb+d0*2048+512);
    if(d0==0){p0=__builtin_amdgcn_mfma_f32_32x32x16_bf16(b0,qr[0],negm,0,0,0);p1=__builtin_amdgcn_mfma_f32_32x32x16_bf16(b1,qr[0],negm,0,0,0);}
    else{p0=__builtin_amdgcn_mfma_f32_32x32x16_bf16(b0,qr[d0],p0,0,0,0);p1=__builtin_amdgcn_mfma_f32_32x32x16_bf16(b1,qr[d0],p1,0,0,0);}}
}
typedef __attribute__((address_space(3))) const char* lds_cptr;
typedef short v4i16_t __attribute__((ext_vector_type(4)));
__device__ __forceinline__ void kload8(bf16x8*kf,lds_cptr kp){
  kf[0]=*(const __attribute__((address_space(3))) bf16x8*)(kp);      kf[1]=*(const __attribute__((address_space(3))) bf16x8*)(kp+512);
  kf[2]=*(const __attribute__((address_space(3))) bf16x8*)(kp+2048); kf[3]=*(const __attribute__((address_space(3))) bf16x8*)(kp+2560);
  kf[4]=*(const __attribute__((address_space(3))) bf16x8*)(kp+4096); kf[5]=*(const __attribute__((address_space(3))) bf16x8*)(kp+4608);
  kf[6]=*(const __attribute__((address_space(3))) bf16x8*)(kp+6144); kf[7]=*(const __attribute__((address_space(3))) bf16x8*)(kp+6656);
}
__device__ __forceinline__ void kload2(bf16x8*kf,lds_cptr kp,int j){ kf[2*j]=*(const __attribute__((address_space(3))) bf16x8*)(kp+j*2048); kf[2*j+1]=*(const __attribute__((address_space(3))) bf16x8*)(kp+j*2048+512); }
__device__ __forceinline__ s16x4 vtr(lds_cptr p){ return __builtin_bit_cast(s16x4,__builtin_amdgcn_ds_read_tr16_b64_v4i16((__attribute__((address_space(3))) v4i16_t*)p)); }
__device__ __forceinline__ float rowmax(const f32x16&p0,const f32x16&p1){
  float a=max3f(p0[0],p0[1],p1[0]),b=max3f(p0[2],p0[3],p1[1]);a=max3f(a,p1[2],p1[3]);
  #pragma unroll
  for(int r=4;r<16;r+=4){a=max3f(a,p0[r],p0[r+1]);b=max3f(b,p0[r+2],p0[r+3]);a=max3f(a,p1[r],p1[r+1]);b=max3f(b,p1[r+2],p1[r+3]);}
  const float m=max2f(a,b);
  auto rr=__builtin_amdgcn_permlane32_swap(__float_as_uint(m),__float_as_uint(m),false,false);
  return max2f(__uint_as_float(rr[0]),__uint_as_float(rr[1]));
}
__device__ __forceinline__ void pv(f32x16*o,int vb,bf16x8 pa0,bf16x8 pa1,bf16x8 pa2,bf16x8 pa3){
  #pragma unroll
  for(int d0=0;d0<2;++d0){s16x4 lo[4],hi[4];
    #pragma unroll
    for(int ks=0;ks<4;++ks){
      asm volatile("ds_read_b64_tr_b16 %0,%1 offset:%c2":"=&v"(lo[ks]):"v"(vb),"i"(d0*4096+ks*1024):"memory");
      asm volatile("ds_read_b64_tr_b16 %0,%1 offset:%c2":"=&v"(hi[ks]):"v"(vb),"i"(d0*4096+ks*1024+512):"memory");}
    asm volatile("s_waitcnt lgkmcnt(0)":::"memory");SBAR();
    #define PK(k) (bf16x8){lo[k][0],lo[k][1],lo[k][2],lo[k][3],hi[k][0],hi[k][1],hi[k][2],hi[k][3]}
    o[d0]=__builtin_amdgcn_mfma_f32_32x32x16_bf16(pa0,PK(0),o[d0],0,0,0);
    o[d0]=__builtin_amdgcn_mfma_f32_32x32x16_bf16(pa1,PK(1),o[d0],0,0,0);
    o[d0]=__builtin_amdgcn_mfma_f32_32x32x16_bf16(pa2,PK(2),o[d0],0,0,0);
    o[d0]=__builtin_amdgcn_mfma_f32_32x32x16_bf16(pa3,PK(3),o[d0],0,0,0);
    #undef PK
  }
}

#ifndef ATTN_STORE16
#define ATTN_STORE16(p,v) (*(u32x4*)(p)=(v))
#endif
template<int VAR,int THRL,int DMQ,int DMK,int DMO> __device__ __forceinline__ void attn_unit(int b,int qb,const UnitArgs&A,char*shm){
  int tid_=threadIdx.x; asm volatile("":"+v"(tid_)); const int tid=tid_,lane=tid&63,r32=lane&31,hi=lane>>5; const int wid=__builtin_amdgcn_readfirstlane(tid>>6);
  const long rowbase=(long)b*SEQ; const int q0=qb*QB;
  const lds_cptr shm3=(lds_cptr)shm;
  int t0=0, NT=4*qb+4; float rowc=0.f; unsigned selm=0u;
  if(VAR==2){ t0=qb?4*qb-2:0; NT=qb?6:4; }
  if(VAR==3||VAR==4){ t0=4*qb; NT=4; }
  int gpos=q0+wid*QBLK+r32; bool gvalid=true;
  if(VAR==3){ const int gi=wid*QBLK+r32; gvalid=gi<A.gn; gpos=(int)A.glist[gvalid?gi:0]; }
  if(VAR==4){ selm=A.sel[gpos]; }
  if(VAR==0){ selm=A.sel[q0+wid*QBLK+r32]; asm volatile("":"+s"(NT)); }
  if(VAR==1){ const float fq0=A.Fl2[q0]; const int ntile=4*qb+4;
    const bool k0=(lane<ntile)?(A.bl2x2+fq0-A.Fl2[64*lane+63]>=-160.f):true;
    const bool k1=(lane+64<ntile)?(A.bl2x2+fq0-A.Fl2[64*(lane+64)+63]>=-160.f):true;
    const unsigned long long m0=__ballot(k0), m1=__ballot(k1);
    int first=m0?(int)__builtin_ctzll(m0):64+(int)__builtin_ctzll(m1|(1ull<<63));
    first&=~1; if(first>4*qb)first=4*qb;
    t0=__builtin_amdgcn_readfirstlane(first); NT=4*qb+4-t0;
    __attribute__((address_space(3))) float*ft=(__attribute__((address_space(3))) float*)(shm3+LDS_F);
    for(int i=tid;i<64*NT;i+=NW*64)ft[i]=A.Fl2[64*t0+i]-fq0;
    rowc=A.Fl2[q0+wid*QBLK+r32]-fq0;
    asm volatile("s_waitcnt vmcnt(0) lgkmcnt(0)\n\ts_barrier":::"memory");
  }
  const lds_cfptr ftab=(lds_cfptr)(shm3+LDS_F);
  const bf16*Qrow=A.Q+(rowbase+gpos)*DMQ+A.qcol;
  const bf16*Kh=A.K+(rowbase+(long)t0*KVBLK)*DMK+A.kcol,*Vh=A.V+(rowbase+(long)t0*KVBLK)*DMK+A.kcol;
  const unsigned lds0=(unsigned)(uintptr_t)shm;
  constexpr bool RES=(VAR>=3); constexpr int NSL=RES?4:3, LV=NSL*SLOTB, LWS=2*NSL*SLOTB, LOST=LWS+NW*256*4;
  float*wsf=(float*)(shm+LWS)+wid*256;
  const bf16*ksrc=Kh+(long)lane*DMK+wid*8;
  const bf16*vsrc=Vh+(long)(16*(wid&3)+(lane>>2))*DMK+(wid>>2)*32+(lane&3)*8;
  const unsigned kdst=lds0+LDS_K+wid*1024, vdst=lds0+LV+wid*1024;
  #define DMA_K(t,slot) glds16(ksrc+(long)(t)*KVBLK*DMK,(unsigned)__builtin_amdgcn_readfirstlane(kdst+(slot)))
  #define DMA_V(t,slot) glds16(vsrc+(long)(t)*KVBLK*DMK,(unsigned)__builtin_amdgcn_readfirstlane(vdst+(slot)))
  const int vb0=(int)(lds0+LV)+((lane>>4)&1)*32+(lane&3)*8+(4*hi+((lane&15)>>2))*64;
  const char*Kbase=shm+LDS_K; bf16x8 kf[8];
  const lds_cptr kp0=shm3+LDS_K+hi*1024+r32*16; const lds_cptr vp0=shm3+LV+((lane>>4)&1)*32+(lane&3)*8+(4*hi+((lane&15)>>2))*64;
  const bool kvres=(VAR==3)&&A.kvres;
  if(!kvres){DMA_K(0,0);DMA_V(0,0);DMA_K(1,SLOTB); if(RES){DMA_V(1,SLOTB);}}
  bf16x8 qr[4];
  #pragma unroll
  for(int d0=0;d0<4;++d0)qr[d0]=*reinterpret_cast<const bf16x8*>(&Qrow[d0*16+hi*8]);
  float lse0=-INFINITY,lse1=-INFINITY,lse2=-INFINITY,sinkv=0.f;
  if(VAR==3){ selm=A.sel[gpos]; }
  if(VAR==4){ const int ns=__builtin_popcount(selm); if(ns>0)lse0=A.LSE[(long)gpos*3+0]; if(ns>1)lse1=A.LSE[(long)gpos*3+1]; if(ns>2)lse2=A.LSE[(long)gpos*3+2]; }
  if(VAR==2){ sinkv=A.sinkp[0]; }
  float mhat=0.f,l_reg=0.f;f32x16 o[2];o[0]=f32x16{};o[1]=f32x16{};const f32x16 negm=f32x16{};
  const int qrel=wid*QBLK+r32;
  #define CMASK(P0,P1,t) bias_tile<VAR,true>(P0,P1,(t),(t)-(NT-4),qrel,hi,ftab,selm,t0,rowc-mhat)
  bool resc=false;
  #define START(P0,P1) do{ const float rm=rowmax(P0,P1); resc=false; \
    { const float dl=max2f(rm,-30.f); mhat=fadd_s(mhat,dl); \
      _Pragma("unroll") for(int r=0;r<16;++r){P0[r]=fsub_s(P0[r],dl);P1[r]=fsub_s(P1[r],dl);} \
      } \
    _Pragma("unroll") for(int r=0;r<16;++r)P0[r]=__builtin_amdgcn_exp2f(P0[r]); }while(0)
  #define RESC() do{ if(resc){ asm volatile("s_waitcnt lgkmcnt(0)":::"memory"); \
      _Pragma("unroll") for(int d_=0;d_<2;++d_) _Pragma("unroll") for(int r=0;r<16;++r)o[d_][r]*=wsf[crow(r,hi)]; } }while(0)
  f32x16 pA0,pA1,pB0,pB1;
  int sl_prev=0,sl_cur=0,sl_next=SLOTB;
  #define ROT() do{sl_prev=sl_cur;sl_cur=sl_next;sl_next=(sl_next==(NSL-1)*SLOTB)?0:sl_next+SLOTB;}while(0)
  if(!kvres){DMA_K(2,2*SLOTB);}
  if(RES){ if(!kvres){DMA_V(2,2*SLOTB);DMA_K(3,3*SLOTB);DMA_V(3,3*SLOTB);WAIT_BAR(0);} } else {WAIT_BAR(3);}
  qkt(pA0,pA1,Kbase,qr,negm,r32,hi);asm volatile("s_nop 15\n\ts_nop 7":"+v"(pA0),"+v"(pA1));CMASK(pA0,pA1,0);
  START(pA0,pA1);
  _Pragma("unroll") for(int r=0;r<16;++r)pA1[r]=__builtin_amdgcn_exp2f(pA1[r]);
  if(!RES){ WAIT_BAR(0);
  DMA_K(3,0);DMA_V(1,SLOTB); }
  ROT();
  kload8(kf,kp0+sl_cur);
  if(!RES){WAIT_BAR(2);}
  s16x4 vlo[8],vhi[8]; u32x4 pw0,pw1,pw2,pw3;
  #define PKW(P,B) cvtpk_s(P[B],P[B+1])
  #define PAF(k) __builtin_bit_cast(bf16x8,pw##k)
  #define VFR(i) (bf16x8){vlo[i][0],vlo[i][1],vlo[i][2],vlo[i][3],vhi[i][0],vhi[i][1],vhi[i][2],vhi[i][3]}
  #define PIN(x) asm volatile("":"+v"(x))
  #define MX3(a,b,c) __builtin_fmaxf(__builtin_fmaxf((a),(b)),(c))
  #define GAPA(MF,A0,A1,A2,A3,W0,W1,PW) do{ MF; sacc+=A0; sacc+=A1; sacc+=A2; sacc+=A3; PIN(sacc); W0; W1; PIN(PW); SBAR(); }while(0)
  #define EX(v) __builtin_amdgcn_exp2f(v)
  #define GAPB(MF,X,B) do{ MF; X[B]=EX(X[B]); X[B+1]=EX(X[B+1]); X[B+2]=EX(X[B+2]); X[B+3]=EX(X[B+3]); PIN(X); SBAR(); }while(0)
  #define VRD(i) do{ vlo[i]=vtr(vp_+(((i)>>2)*4096+((i)&3)*1024)); vhi[i]=vtr(vp_+(((i)>>2)*4096+((i)&3)*1024+512)); }while(0)
  #define KRD(G,j) do{ if(G){ kload2(kf,kp0+sl_next,j); SBAR(); } }while(0)
  #define STEP(C0,C1,P0,P1,t,GK,GV,GL) do{ SBAR(); \
    const lds_cptr vp_=vp0+sl_prev; \
    VRD(0); SBAR(); float sacc=(P0[0]+P0[1]); \
    GAPA(C0=__builtin_amdgcn_mfma_f32_32x32x16_bf16(kf[0],qr[0],negm,0,0,0), P0[2],P0[3],P0[4],P0[5],     pw0[0]=PKW(P0,0), pw0[1]=PKW(P0,2), pw0); \
    VRD(4); SBAR(); GAPA(C1=__builtin_amdgcn_mfma_f32_32x32x16_bf16(kf[1],qr[0],negm,0,0,0), P0[6],P0[7],P0[8],P0[9],     pw0[2]=PKW(P0,4), pw0[3]=PKW(P0,6), pw0); \
    VRD(1); SBAR(); GAPA(C0=__builtin_amdgcn_mfma_f32_32x32x16_bf16(kf[2],qr[1],C0,0,0,0),   P0[10],P0[11],P0[12],P0[13], pw1[0]=PKW(P0,8), pw1[1]=PKW(P0,10), pw1); \
    VRD(5); SBAR(); GAPA(C1=__builtin_amdgcn_mfma_f32_32x32x16_bf16(kf[3],qr[1],C1,0,0,0),   P0[14],P0[15],P1[0],P1[1],   pw1[2]=PKW(P0,12),pw1[3]=PKW(P0,14), pw1); \
    VRD(2); SBAR(); GAPA(C0=__builtin_amdgcn_mfma_f32_32x32x16_bf16(kf[4],qr[2],C0,0,0,0),   P1[2],P1[3],P1[4],P1[5],     pw2[0]=PKW(P1,0), pw2[1]=PKW(P1,2), pw2); \
    VRD(6); SBAR(); GAPA(C1=__builtin_amdgcn_mfma_f32_32x32x16_bf16(kf[5],qr[2],C1,0,0,0),   P1[6],P1[7],P1[8],P1[9],     pw2[2]=PKW(P1,4), pw2[3]=PKW(P1,6), pw2); \
    VRD(3); SBAR(); GAPA(C0=__builtin_amdgcn_mfma_f32_32x32x16_bf16(kf[6],qr[3],C0,0,0,0),   P1[10],P1[11],P1[12],P1[13], pw3[0]=PKW(P1,8), pw3[1]=PKW(P1,10), pw3); \
    VRD(7); SBAR(); GAPA(C1=__builtin_amdgcn_mfma_f32_32x32x16_bf16(kf[7],qr[3],C1,0,0,0),   P1[14],P1[15],0.f,0.f,       pw3[2]=PKW(P1,12),pw3[3]=PKW(P1,14), pw3); \
    l_reg+=sacc; \
    if(GK){DMA_K((t)+3,sl_cur);} if(GV){DMA_V((t)+1,sl_next);} \
    CMASK(C0,C1,t); \
    { float a=MX3(C0[0],C0[1],C1[0]),b=MX3(C0[2],C0[3],C1[1]); a=MX3(a,C1[2],C1[3]); \
      _Pragma("unroll") for(int r=4;r<16;r+=4){a=MX3(a,C0[r],C0[r+1]);b=MX3(b,C0[r+2],C0[r+3]);a=MX3(a,C1[r],C1[r+1]);b=MX3(b,C1[r+2],C1[r+3]);} \
      float rm=__builtin_fmaxf(a,b); { auto rr=__builtin_amdgcn_permlane32_swap(__float_as_uint(rm),__float_as_uint(rm),false,false); rm=__builtin_fmaxf(__uint_as_float(rr[0]),__uint_as_float(rr[1])); } \
      resc=false; \
      if(__builtin_expect(__any(rm>(float)THRL),0)){ const float dl=__builtin_fmaxf(rm,0.f); mhat+=dl; \
        _Pragma("unroll") for(int r=0;r<16;++r){C0[r]-=dl;C1[r]-=dl;} \
        const float f=__builtin_amdgcn_exp2f(-dl); l_reg*=f; if(hi==0)wsf[r32]=f; resc=true; } } \
    SBAR(); \
    GAPB(o[0]=__builtin_amdgcn_mfma_f32_32x32x16_bf16(PAF(0),VFR(0),o[0],0,0,0), C0,0); \
    GAPB(o[1]=__builtin_amdgcn_mfma_f32_32x32x16_bf16(PAF(0),VFR(4),o[1],0,0,0), C0,4); \
    KRD(GL,0); GAPB(o[0]=__builtin_amdgcn_mfma_f32_32x32x16_bf16(PAF(1),VFR(1),o[0],0,0,0), C0,8); \
    KRD(GL,1); GAPB(o[1]=__builtin_amdgcn_mfma_f32_32x32x16_bf16(PAF(1),VFR(5),o[1],0,0,0), C0,12); \
    KRD(GL,2); GAPB(o[0]=__builtin_amdgcn_mfma_f32_32x32x16_bf16(PAF(2),VFR(2),o[0],0,0,0), C1,0); \
    KRD(GL,3); GAPB(o[1]=__builtin_amdgcn_mfma_f32_32x32x16_bf16(PAF(2),VFR(6),o[1],0,0,0), C1,4); \
    GAPB(o[0]=__builtin_amdgcn_mfma_f32_32x32x16_bf16(PAF(3),VFR(3),o[0],0,0,0), C1,8); \
    GAPB(o[1]=__builtin_amdgcn_mfma_f32_32x32x16_bf16(PAF(3),VFR(7),o[1],0,0,0), C1,12); \
    }while(0)
  int t=1;
  #undef CMASK
  #define CMASK(P0,P1,t) bias_tile<VAR,false>(P0,P1,(t),-1,qrel,hi,ftab,selm,t0,rowc-mhat)
  for(;t+5<NT;t+=2){
    STEP(pB0,pB1,pA0,pA1,t,true,true,true);     WAIT_BAR(2); RESC(); ROT();
    STEP(pA0,pA1,pB0,pB1,t+1,true,true,true);   WAIT_BAR(2); RESC(); ROT();
  }
  #undef CMASK
  #define CMASK(P0,P1,t) bias_tile<VAR,true>(P0,P1,(t),(t)-(NT-4),qrel,hi,ftab,selm,t0,rowc-mhat)
  #define ENDW(tt) do{ if((tt)+3<NT){WAIT_BAR(2);} else if((tt)+2<NT){WAIT_BAR(1);} else {WAIT_BAR(0);} }while(0)
  for(;t+1<NT;t+=2){
    if(RES){ STEP(pB0,pB1,pA0,pA1,t,false,false,(t+1<NT)); RESC(); ROT(); STEP(pA0,pA1,pB0,pB1,t+1,false,false,(t+2<NT)); RESC(); ROT(); }
    else {
    STEP(pB0,pB1,pA0,pA1,t,(t+3<NT),(t+1<NT),(t+1<NT));       ENDW(t);   RESC(); ROT();
    STEP(pA0,pA1,pB0,pB1,t+1,(t+4<NT),(t+2<NT),(t+2<NT));     ENDW(t+1); RESC(); ROT(); }
  }
  STEP(pB0,pB1,pA0,pA1,NT-1,false,false,false); RESC();
  { float sacc=pB0[0]+pB0[1]; _Pragma("unroll") for(int r=2;r<16;++r)sacc+=pB0[r]; _Pragma("unroll") for(int r=0;r<16;++r)sacc+=pB1[r]; l_reg+=sacc;
    pw0=(u32x4){PKW(pB0,0),PKW(pB0,2),PKW(pB0,4),PKW(pB0,6)};pw1=(u32x4){PKW(pB0,8),PKW(pB0,10),PKW(pB0,12),PKW(pB0,14)};pw2=(u32x4){PKW(pB1,0),PKW(pB1,2),PKW(pB1,4),PKW(pB1,6)};pw3=(u32x4){PKW(pB1,8),PKW(pB1,10),PKW(pB1,12),PKW(pB1,14)};
    SBAR(); pv(o,vb0+sl_cur,PAF(0),PAF(1),PAF(2),PAF(3)); }
  #undef PKW
  #undef PAF
  #undef VFR
  #undef PIN
  #undef MX3
  #undef GAPA
  #undef GAPB
  #undef EX
  #undef VRD
  #undef KRD
  #undef STEP
  #undef ENDW
  {auto rr=__builtin_amdgcn_permlane32_swap(__float_as_uint(l_reg),__float_as_uint(l_reg),false,false);l_reg=__uint_as_float(rr[0])+__uint_as_float(rr[1]);}
  if(VAR==2)l_reg+=__builtin_amdgcn_exp2f(sinkv*1.4426950408889634f-mhat);
  if(VAR==3&&hi==0){ const int slot=__builtin_popcount(selm&((1u<<qb)-1u)); const int dst=gvalid?gpos*3+slot:-1; wsf[64+r32]=__int_as_float(dst);
    if(gvalid)A.LSE[(long)gpos*3+slot]=mhat+__builtin_amdgcn_logf(l_reg); }
  if(VAR==4&&hi==0){ const int ns=__builtin_popcount(selm); const float lo=mhat+__builtin_amdgcn_logf(l_reg);
    const float l0=lse0, l1=lse1, l2=lse2; (void)ns;
    const float mm=__builtin_fmaxf(__builtin_fmaxf(lo,l0),__builtin_fmaxf(l1,l2));
    const float e0=__builtin_amdgcn_exp2f(lo-mm), e1=__builtin_amdgcn_exp2f(l0-mm), e2=__builtin_amdgcn_exp2f(l1-mm), e3=__builtin_amdgcn_exp2f(l2-mm), inv=__builtin_amdgcn_rcpf((e0+e1)+(e2+e3));
    wsf[64+4*r32]=e0*inv; wsf[65+4*r32]=e1*inv; wsf[66+4*r32]=e2*inv; wsf[67+4*r32]=e3*inv; }
  if(hi==0)wsf[32+r32]=l_reg;asm volatile("s_waitcnt lgkmcnt(0)":::"memory");
  float rli[16];
  #pragma unroll
  for(int r=0;r<16;++r)rli[r]=__builtin_amdgcn_rcpf(wsf[32+crow(r,hi)]);
  bf16*Ow=A.O+(rowbase+q0+wid*QBLK)*DMO+A.ocol;
  { bf16*stg=(bf16*)(shm+LOST)+wid*2048;
    #pragma unroll
    for(int r=0;r<16;++r){const int orow=crow(r,hi);
      #pragma unroll
      for(int d0=0;d0<2;++d0)stg[orow*64+d0*32+r32]=__float2bfloat16(o[d0][r]*rli[r]);}
    asm volatile("s_waitcnt lgkmcnt(0)":::"memory");
    #pragma unroll
    for(int once_=0;once_<1;++once_){ u32x4 gl[4]; u32x4 pl[4][3];
    if(VAR==1){
      #pragma unroll
      for(int i=0;i<4;++i)gl[i]=*(const u32x4*)(A.gate+(rowbase+q0+wid*QBLK+i*8+(lane>>3))*512+(lane&7)*8); }
    if(VAR==4){
      #pragma unroll
      for(int i=0;i<4;++i)
        #pragma unroll
        for(int sl=0;sl<3;++sl)pl[i][sl]=*(const u32x4*)(A.PO+((long)(q0+wid*QBLK+i*8+(lane>>3))*3+sl)*64+(lane&7)*8); }
    #pragma unroll
    for(int i=0;i<4;++i){const int row=i*8+(lane>>3),ch=lane&7; u32x4 v=*(const u32x4*)(stg+row*64+ch*8);
      if(VAR==1){ const u32x4 g=gl[i];
        #pragma unroll
        for(int j=0;j<4;++j){ const float vl=__uint_as_float(v[j]<<16)*__uint_as_float(g[j]<<16), vh=__uint_as_float(v[j]&0xffff0000u)*__uint_as_float(g[j]&0xffff0000u); v[j]=cvtpk_s(vl,vh); } }
      if(VAR==3){ const int dst=__float_as_int(wsf[64+row]); if(dst>=0)ATTN_STORE16(A.PO+(long)dst*64+ch*8,v); }
      else if(VAR==4){ const float w0=wsf[64+4*row],w1=wsf[65+4*row],w2=wsf[66+4*row],w3=wsf[67+4*row];
        float acc8[8];
        #pragma unroll
        for(int j=0;j<4;++j){ acc8[2*j]=w0*__uint_as_float(v[j]<<16); acc8[2*j+1]=w0*__uint_as_float(v[j]&0xffff0000u); }
        #pragma unroll
        for(int sl=0;sl<3;++sl){ const float ws_=sl==0?w1:sl==1?w2:w3; const u32x4 p=pl[i][sl];
          #pragma unroll
          for(int j=0;j<4;++j){ acc8[2*j]+=ws_!=0.f?ws_*__uint_as_float(p[j]<<16):0.f; acc8[2*j+1]+=ws_!=0.f?ws_*__uint_as_float(p[j]&0xffff0000u):0.f; } }
        #pragma unroll
        for(int j=0;j<4;++j)v[j]=cvtpk_s(acc8[2*j],acc8[2*j+1]);
        ATTN_STORE16(Ow+(long)row*DMO+ch*8,v); }
      else ATTN_STORE16(Ow+(long)row*DMO+ch*8,v);} } }
  asm volatile("s_waitcnt lgkmcnt(0)\n\ts_barrier":::"memory");
  #undef DMA_K
  #undef DMA_V
  #undef CMASK
  #undef START
  #undef RESC
  #undef ROT
}
constexpr int ATTN_LDS_BYTES=LDS_BYTES;
#undef SBAR
#undef WAIT_BAR
}
#define GAS __attribute__((address_space(1)))
#define LAS __attribute__((address_space(3)))
typedef unsigned short bf16;
typedef unsigned v4u __attribute__((ext_vector_type(4)));
typedef float f32x4 __attribute__((ext_vector_type(4)));
typedef short bf16x8 __attribute__((ext_vector_type(8)));
typedef GAS unsigned gu32;
typedef GAS unsigned long long gu64;
#define RLX_AGENT __ATOMIC_RELAXED, __HIP_MEMORY_SCOPE_AGENT
#define LDS_WAIT() asm volatile("s_waitcnt lgkmcnt(0)" ::: "memory")
#define VM_WAIT() asm volatile("s_waitcnt vmcnt(0)" ::: "memory")
__device__ __forceinline__ unsigned long long rt() { return __builtin_amdgcn_s_memrealtime(); }
__device__ __forceinline__ unsigned f2bf(float f) { unsigned u = __builtin_bit_cast(unsigned, f); return (u + 0x7fffu + ((u >> 16) & 1u)) >> 16; }
__device__ __forceinline__ unsigned pk2(float lo, float hi) { return f2bf(lo) | (f2bf(hi) << 16); }

#define XB_TMO      128
#define XB_XCNT(j)  (256  + 64 * (j))
#define XB_XSUB(j)  (1280 + 64 * (j))
#define XB_XGEN(j)  (2304 + 64 * (j))
#define XB_TOP      3328
#define XB_TOPGEN   3392
#define XCD_BAR_WORDS 3456
#define XB_SPIN_CAP (1u << 18)

__device__ __forceinline__ unsigned xb_ld(unsigned* p)              { return __hip_atomic_load(p, __ATOMIC_RELAXED, __HIP_MEMORY_SCOPE_AGENT); }
__device__ __forceinline__ unsigned xb_add(unsigned* p, unsigned v) { return __hip_atomic_fetch_add(p, v, __ATOMIC_RELAXED, __HIP_MEMORY_SCOPE_AGENT); }
__device__ __forceinline__ unsigned xb_xcc_id() { return (unsigned)__builtin_amdgcn_s_getreg((3 << 11) | 20) & 0xFu; }
#define XB_SPIN(cond, bar) do { unsigned _sp = 0; while (cond) { __builtin_amdgcn_s_sleep(1); \
    if ((++_sp & 255u) == 0u) { if (xb_ld(&(bar)[XB_TMO])) break; if (_sp > XB_SPIN_CAP) { atomicAdd(&(bar)[XB_TMO], 1u); break; } } } } while (0)

struct XcdBarrier {
    unsigned* bar; unsigned x;
    volatile LAS unsigned* st;
};

__device__ __forceinline__ XcdBarrier xcd_barrier_post(unsigned* bar, volatile LAS unsigned* st) {
    XcdBarrier b; b.bar = bar; b.x = xb_xcc_id(); b.st = st;
    if (threadIdx.x == 0) (void)xb_add(&bar[XB_XCNT(b.x)], 1u);
    return b;
}
__device__ __forceinline__ void xcd_barrier_complete(unsigned* bar, unsigned x, unsigned& nloc, unsigned& nx) {
    const unsigned G = gridDim.x * gridDim.y * gridDim.z;
    unsigned sum, cnt, mine, sp = 0u;
    for (;;) {
        sum = 0u; cnt = 0u; mine = 0u;
#pragma unroll
        for (unsigned j = 0; j < 16; ++j) { const unsigned c = xb_ld(&bar[XB_XCNT(j)]); sum += c; cnt += (c > 0u) ? 1u : 0u; mine = (j == x) ? c : mine; }
        if (sum == G) break;
        __builtin_amdgcn_s_sleep(1);
        if ((++sp & 255u) == 0u) { if (xb_ld(&bar[XB_TMO])) break; if (sp > XB_SPIN_CAP) { atomicAdd(&bar[XB_TMO], 1u); break; } }
    }
    nloc = mine > 0u ? mine : 1u; nx = cnt > 0u ? cnt : 1u;
}

__device__ __forceinline__ void xcd_barrier(const XcdBarrier& b) {
    asm volatile("s_waitcnt vmcnt(0)" ::: "memory");
    __syncthreads();
    if (threadIdx.x == 0) {
        unsigned* bar = b.bar;
        __builtin_amdgcn_s_waitcnt(0);
        unsigned nloc = b.st[0], nx = b.st[1];
        if (nloc == 0u) { xcd_barrier_complete(bar, b.x, nloc, nx); b.st[0] = nloc; b.st[1] = nx; }
        const unsigned old = xb_add(&bar[XB_XSUB(b.x)], 1u);
        const unsigned gen = old / nloc;
        if (old + 1u == (gen + 1u) * nloc) {
            __builtin_amdgcn_fence(__ATOMIC_RELEASE, "agent");
            asm volatile("s_waitcnt vmcnt(0)" ::: "memory");
            const unsigned og = xb_add(&bar[XB_TOP], 1u);
            const unsigned tg = og / nx;
            if (og + 1u == (tg + 1u) * nx) xb_add(&bar[XB_TOPGEN], 1u);
            else XB_SPIN(xb_ld(&bar[XB_TOPGEN]) == tg, bar);
            __builtin_amdgcn_fence(__ATOMIC_ACQUIRE, "agent");
            xb_add(&bar[XB_XGEN(b.x)], 1u);
            asm volatile("s_waitcnt vmcnt(0)" ::: "memory");
        } else {
            XB_SPIN(xb_ld(&bar[XB_XGEN(b.x)]) == gen, bar);
            __builtin_amdgcn_fence(__ATOMIC_ACQUIRE, "agent");
            asm volatile("s_waitcnt vmcnt(0)" ::: "memory");
        }
    }
    __syncthreads();
}
constexpr int NWAVES = 8;
constexpr int BATCH = 2, SEQ = 8192, DMODEL = 1024, M = BATCH * SEQ;
constexpr int EV_COLS = 3592, EV_N = 3584, OD_N = 1280;
constexpr int NEXP = 16384;
constexpr float L2E = 1.4426950408889634f;
constexpr float RMS_EPS = 1e-6f;

#ifndef MK_N_LAUNCHES
#define MK_N_LAUNCHES 1
#endif
constexpr int N_PHASES = 14;
constexpr int N_LAUNCHES = MK_N_LAUNCHES;

constexpr size_t MiB = 1u << 20;
constexpr size_t WS_CTL = 0, CTL_ZERO_BYTES = 1 * MiB;
constexpr size_t WS_WIN0 = 2 * MiB, WS_WOUT0 = 9 * MiB, WS_WQ0 = 11 * MiB, WS_WIN1 = 13 * MiB, WS_WOUT1 = 16 * MiB, WS_WQ1 = 18 * MiB;
constexpr size_t WS_SK = 20 * MiB;
constexpr size_t WS_ROPE = 21 * MiB;
constexpr size_t WS_RA0 = 22 * MiB, WS_RA1 = 22 * MiB + 65536;
constexpr size_t WS_LF = 23 * MiB;
constexpr size_t WS_FL2 = 24 * MiB;
constexpr size_t WS_KSUM = 25 * MiB;
constexpr size_t WS_SEL = 26 * MiB;
constexpr size_t WS_GAIN = 28 * MiB;
constexpr size_t WS_TSC = 29 * MiB;
constexpr size_t WS_RSP = 27 * MiB;
constexpr size_t WS_XB = 32 * MiB;
constexpr size_t WS_QKV = 64 * MiB;
constexpr size_t WS_AO = 176 * MiB;
constexpr size_t WS_QP = 208 * MiB;
constexpr size_t WS_TAB = 240 * MiB;
constexpr size_t WS_UL = 368 * MiB;
constexpr size_t WS_LIST = 385 * MiB;
constexpr size_t WS_CNT = 389 * MiB;
constexpr size_t WS_LSE = 390 * MiB;
constexpr size_t WS_PO = 392 * MiB;
constexpr size_t WS_END = 440 * MiB;
constexpr int CW_BAR = 4096;

constexpr int RING_BYTES = 131072;
constexpr int LDS_BYTES = 147456;
constexpr int LDSCTL_OFF = LDS_BYTES - 512, MISC_OFF = LDSCTL_OFF + 64;

typedef unsigned v2u __attribute__((ext_vector_type(2)));
typedef __bf16 bf16x2v __attribute__((ext_vector_type(2)));
__device__ __forceinline__ float bflo(unsigned w) { return __uint_as_float(w << 16); }
__device__ __forceinline__ float bfhi(unsigned w) { return __uint_as_float(w & 0xffff0000u); }
__device__ __forceinline__ float dot2bf(unsigned a, unsigned b, float c) { return __builtin_amdgcn_fdot2_f32_bf16(__builtin_bit_cast(bf16x2v, a), __builtin_bit_cast(bf16x2v, b), c, false); }
#define DPPF(x, ctrl) __builtin_bit_cast(float, __builtin_amdgcn_update_dpp(0, __builtin_bit_cast(int, x), ctrl, 0xf, 0xf, false))
#define RDLF(x, l) __builtin_bit_cast(float, __builtin_amdgcn_readlane(__builtin_bit_cast(int, x), l))
__device__ __forceinline__ float wave_sum(float v) {
    v += DPPF(v, 0xB1); v += DPPF(v, 0x4E); v += DPPF(v, 0x124); v += DPPF(v, 0x128);
    return (RDLF(v, 0) + RDLF(v, 16)) + (RDLF(v, 32) + RDLF(v, 48));
}
__device__ __forceinline__ float wave_max(float v) {
    v = fmaxf(v, DPPF(v, 0xB1)); v = fmaxf(v, DPPF(v, 0x4E)); v = fmaxf(v, DPPF(v, 0x124)); v = fmaxf(v, DPPF(v, 0x128));
    return fmaxf(fmaxf(RDLF(v, 0), RDLF(v, 16)), fmaxf(RDLF(v, 32), RDLF(v, 48)));
}

struct Args { const float* in[19]; float* out; unsigned char* ws; int ph_lo, ph_hi, li, pad; };
struct Ctx { unsigned char* lds; int tid, lane, wave, vcu, G; };

__device__ __forceinline__ int perm_src_col(int c) { const int r = c & 255; return (c & ~255) + 64 * ((r >> 5) & 3) + 16 * ((r >> 3) & 3) + 8 * (r >> 7) + (r & 7); }
__device__ __forceinline__ void p0_transpose_item(const float* W, int Nsrc, const float* gain, bool permc, bf16* WT, LAS float* scr, int item, int nblk, int lane) {
    const int kb = item / nblk, nb = item % nblk, k0 = 64 * kb, n0 = 32 * nb;
    const int sc = permc ? perm_src_col(n0 + (lane & 31)) : n0 + (lane & 31);
    const int c = lane & 7;
    f32x4 ga = {1.f, 1.f, 1.f, 1.f}, gb = ga;
    if (gain) { ga = *(const f32x4*)(gain + k0 + 8 * c); gb = *(const f32x4*)(gain + k0 + 8 * c + 4); }
    { const float* wp = W + (size_t)(k0 + (lane >> 5)) * Nsrc + sc; float wv[32];
#pragma unroll
      for (int i = 0; i < 32; ++i) wv[i] = wp[(size_t)(2 * i) * Nsrc];
#pragma unroll
      for (int i = 0; i < 32; ++i) scr[(2 * i + (lane >> 5)) * 33 + (lane & 31)] = wv[i]; }
    LDS_WAIT(); asm volatile("" ::: "memory");
#pragma unroll
    for (int j = 0; j < 4; ++j) { const int n = (lane >> 3) + 8 * j; const LAS float* s = scr + (8 * c) * 33 + n;
        v4u o; o.x = pk2(s[0 * 33] * ga.x, s[1 * 33] * ga.y); o.y = pk2(s[2 * 33] * ga.z, s[3 * 33] * ga.w); o.z = pk2(s[4 * 33] * gb.x, s[5 * 33] * gb.y); o.w = pk2(s[6 * 33] * gb.z, s[7 * 33] * gb.w);
        *(GAS v4u*)(WT + (size_t)(n0 + n) * 1024 + k0 + 8 * c) = o; }
    LDS_WAIT(); asm volatile("" ::: "memory");
}
__device__ __forceinline__ void sincos_d(float af, float& s, float& c) {
    const double a = (double)af, k = __builtin_rint(a * 0.15915494309189535), r = (a - k * 6.283185307179586) - k * 2.4492935982947064e-16, r2 = r * r;
    double ts = 1.0, tc = 1.0, ss = 1.0, cc = 1.0;
#pragma unroll
    for (int i = 1; i <= 13; ++i) { tc *= r2 * (-1.0 / (double)((2 * i - 1) * (2 * i))); ts *= r2 * (-1.0 / (double)((2 * i) * (2 * i + 1))); cc += tc; ss += ts; }
    s = (float)(r * ss); c = (float)cc;
}
#ifndef CONV_L1_LATE
#define CONV_L1_LATE 2
#endif
constexpr int CW_CONV = 2048;
typedef unsigned v6u __attribute__((ext_vector_type(6)));
typedef unsigned v3u __attribute__((ext_vector_type(3)));
struct UB { v4u a4, b4; v2u a2, b2; };
typedef _Float16 h32 __attribute__((ext_vector_type(32)));
__device__ __forceinline__ void conv_rows4_fp6(const Args& a, unsigned char* ws, int layer, int t, int e0, int lane) {
    const int slot = 2 * layer + t; float* tsc = (float*)(ws + WS_TSC);
    const int sub = lane >> 5, blk = (lane >> 4) & 1, li = lane & 15;
    const f32x4* sp = (const f32x4*)(a.in[17 + t] + ((size_t)layer * NEXP + e0 + sub) * 1024 + 512 * blk + 4 * li);
    f32x4 v[2][8];
#pragma unroll
    for (int r2 = 0; r2 < 2; ++r2)
#pragma unroll
        for (int q = 0; q < 8; ++q) v[r2][q] = __builtin_nontemporal_load(sp + r2 * 512 + 16 * q);
#pragma unroll
    for (int r2 = 0; r2 < 2; ++r2) { float mx = 0.f;
#pragma unroll
        for (int q = 0; q < 8; ++q) mx = fmaxf(mx, fmaxf(fmaxf(fabsf(v[r2][q].x), fabsf(v[r2][q].y)), fmaxf(fabsf(v[r2][q].z), fabsf(v[r2][q].w))));
        mx = fmaxf(mx, __shfl_xor(mx, 1)); mx = fmaxf(mx, __shfl_xor(mx, 2)); mx = fmaxf(mx, __shfl_xor(mx, 4)); mx = fmaxf(mx, __shfl_xor(mx, 8)); mx = fmaxf(mx, __shfl_xor(mx, 16));
        const float step = mx > 0.f ? mx * (1.0f / 7.5f) : 1.0f, inv = 1.0f / step;
        h32 hv;
#pragma unroll
        for (int q = 0; q < 8; ++q) { hv[4 * q] = (_Float16)(v[r2][q].x * inv); hv[4 * q + 1] = (_Float16)(v[r2][q].y * inv); hv[4 * q + 2] = (_Float16)(v[r2][q].z * inv); hv[4 * q + 3] = (_Float16)(v[r2][q].w * inv); }
        const v6u pk = __builtin_amdgcn_cvt_scalef32_pk32_fp6_f16(hv, 1.0f);
        unsigned char* op = ws + WS_TAB + (size_t)slot * 32 * MiB + (size_t)(e0 + 2 * r2 + sub) * 768;
        *(v4u*)(op + 256 * blk + 16 * li) = (v4u){pk[0], pk[1], pk[2], pk[3]}; *(v2u*)(op + 512 + 128 * blk + 8 * li) = (v2u){pk[4], pk[5]};
        if ((lane & 31) == 0) tsc[slot * NEXP + e0 + 2 * r2 + sub] = step; }
}
__device__ __forceinline__ void conv_rows4(const Args& a, unsigned char* ws, int layer, int t, int e0, int lane) {
    if (t) { conv_rows4_fp6(a, ws, layer, t, e0, lane); return; }
    const int slot = 2 * layer + t; float* tsc = (float*)(ws + WS_TSC);
    const f32x4* sp = (const f32x4*)(a.in[17 + t] + ((size_t)layer * NEXP + e0) * 1024) + lane;
    f32x4 v[4][4];
#pragma unroll
    for (int r = 0; r < 4; ++r)
#pragma unroll
        for (int j = 0; j < 4; ++j) v[r][j] = __builtin_nontemporal_load(sp + r * 256 + 64 * j);
#pragma unroll
    for (int r = 0; r < 4; ++r) { float mx = 0.f;
#pragma unroll
        for (int j = 0; j < 4; ++j) mx = fmaxf(mx, fmaxf(fmaxf(fabsf(v[r][j].x), fabsf(v[r][j].y)), fmaxf(fabsf(v[r][j].z), fabsf(v[r][j].w))));
        mx = wave_max(mx); const float step = mx > 0.f ? mx * (t ? 1.0f / 240.0f : 1.0f / 127.0f) : 1.0f, inv = 1.0f / step;
        unsigned* op = (unsigned*)(ws + WS_TAB + (size_t)slot * 32 * MiB + (size_t)(e0 + r) * 1024) + lane;
#pragma unroll
        for (int j = 0; j < 4; ++j) {
            if (t) { int w = 0; w = __builtin_amdgcn_cvt_pk_fp8_f32(v[r][j].x * inv, v[r][j].y * inv, w, false); w = __builtin_amdgcn_cvt_pk_fp8_f32(v[r][j].z * inv, v[r][j].w * inv, w, true); op[64 * j] = (unsigned)w; }
            else { const int q0 = (int)rintf(v[r][j].x * inv), q1 = (int)rintf(v[r][j].y * inv), q2 = (int)rintf(v[r][j].z * inv), q3 = (int)rintf(v[r][j].w * inv);
                op[64 * j] = (unsigned)(q0 & 255) | ((unsigned)(q1 & 255) << 8) | ((unsigned)(q2 & 255) << 16) | ((unsigned)(q3 & 255) << 24); } }
        if (lane == 0) tsc[slot * NEXP + e0 + r] = step; }
}
__device__ __forceinline__ void conv_pull(const Args& a, const Ctx& C, int layer) {
    volatile LAS unsigned* box = (volatile LAS unsigned*)(C.lds + LDSCTL_OFF + 256);
    gu32* cnt = (gu32*)(a.ws + WS_CTL) + CW_CONV + 64 * layer;
    for (;;) {
        if (C.tid == 0) box[0] = __hip_atomic_fetch_add(cnt, 1u, RLX_AGENT);
        __syncthreads();
        const unsigned c = box[0];
        __syncthreads();
        if (c >= 512u) break;
        const int t = (int)(c >> 8), e0 = (int)(c & 255u) * 64 + C.wave * 8;
        conv_rows4(a, a.ws, layer, t, e0, C.lane); conv_rows4(a, a.ws, layer, t, e0 + 4, C.lane);
    }
}
__device__ __forceinline__ void p0_prologue(const Args& a, const Ctx& C) {
    unsigned char* ws = a.ws;
    const int gw = C.vcu * NWAVES + C.wave, NGW = C.G * NWAVES, gt = C.vcu * (NWAVES * 64) + C.tid, NGT = C.G * NWAVES * 64;
    const float* x = a.in[0]; const float* an = a.in[1]; const float* fn = a.in[2]; const float* ev_w_in = a.in[3]; const float* fbias = a.in[4];
    LAS float* wf = (LAS float*)(C.lds + 69632);
    for (int i = C.tid; i < 1024; i += NWAVES * 64) { const float g = an[i];
#pragma unroll
        for (int h = 0; h < 8; ++h) wf[h * 1024 + i] = ev_w_in[(size_t)i * EV_COLS + EV_N + h] * g; }
    __syncthreads();
    for (int stage = 0; stage < 2; ++stage) {
      if ((stage ^ (C.wave & 1)) == 0) {
    LAS float* scr = (LAS float*)(C.lds + C.wave * 8704);
    constexpr int I_IN0 = 16 * (EV_N / 32), I_SQ = 16 * 32, I_IN1 = 16 * (OD_N / 32);
    constexpr int NITEMS = I_IN0 + 2 * I_SQ + I_IN1 + 2 * I_SQ;
#ifndef PROBE_TR_REPS
#define PROBE_TR_REPS 1
#endif
    for (int rep_ = 0; rep_ < PROBE_TR_REPS; ++rep_)
    for (int it = gw; it < NITEMS; it += NGW) {
        int r = it;
        if (r < I_IN0) { p0_transpose_item(ev_w_in, EV_COLS, an, true, (bf16*)(ws + WS_WIN0), scr, r, EV_N / 32, C.lane); continue; } r -= I_IN0;
        if (r < I_SQ) { p0_transpose_item(a.in[9], 1024, nullptr, false, (bf16*)(ws + WS_WOUT0), scr, r, 32, C.lane); continue; } r -= I_SQ;
        if (r < I_SQ) { p0_transpose_item(a.in[15], 1024, fn, false, (bf16*)(ws + WS_WQ0), scr, r, 32, C.lane); continue; } r -= I_SQ;
        if (r < I_IN1) { p0_transpose_item(a.in[10], OD_N, an + 1024, true, (bf16*)(ws + WS_WIN1), scr, r, OD_N / 32, C.lane); continue; } r -= I_IN1;
        if (r < I_SQ) { p0_transpose_item(a.in[14], 1024, nullptr, false, (bf16*)(ws + WS_WOUT1), scr, r, 32, C.lane); continue; } r -= I_SQ;
        p0_transpose_item(a.in[15] + (size_t)1024 * 1024, 1024, fn + 1024, false, (bf16*)(ws + WS_WQ1), scr, r, 32, C.lane);
    }
    { bf16* xb = (bf16*)(ws + WS_XB); float* ra0 = (float*)(ws + WS_RA0); float* lf = (float*)(ws + WS_LF);
#ifndef PROBE_ROW_REPS
#define PROBE_ROW_REPS 1
#endif
      for (int rep_ = 0; rep_ < PROBE_ROW_REPS; ++rep_) {
      f32x4 vn[4];
      if (gw < M) { const GAS f32x4* xr0 = (const GAS f32x4*)(x + (size_t)gw * DMODEL) + C.lane;
#pragma unroll
          for (int j = 0; j < 4; ++j) vn[j] = xr0[64 * j]; }
      for (int m = gw; m < M; m += NGW) {
        f32x4 v[4]; float s = 0.f; float fa[8];
#pragma unroll
        for (int j = 0; j < 4; ++j) v[j] = vn[j];
        if (m + NGW < M) { const GAS f32x4* xr1 = (const GAS f32x4*)(x + (size_t)(m + NGW) * DMODEL) + C.lane;
#pragma unroll
            for (int j = 0; j < 4; ++j) vn[j] = xr1[64 * j]; }
#pragma unroll
        for (int h = 0; h < 8; ++h) fa[h] = 0.f;
#pragma unroll
        for (int j = 0; j < 4; ++j) { s += (v[j].x * v[j].x + v[j].y * v[j].y) + (v[j].z * v[j].z + v[j].w * v[j].w);
#pragma unroll
            for (int h = 0; h < 8; ++h) { const f32x4 w = *(const LAS f32x4*)(wf + h * 1024 + 256 * j + 4 * C.lane); fa[h] += (v[j].x * w.x + v[j].y * w.y) + (v[j].z * w.z + v[j].w * w.w); } }
        const float r = 1.0f / sqrtf(wave_sum(s) * (1.0f / DMODEL) + RMS_EPS);
        GAS unsigned long long* o8 = (GAS unsigned long long*)(xb + (size_t)m * DMODEL) + C.lane;
#pragma unroll
        for (int j = 0; j < 4; ++j) o8[64 * j] = (unsigned long long)pk2(v[j].x, v[j].y) | ((unsigned long long)pk2(v[j].z, v[j].w) << 32);
        float mine = 0.f;
#pragma unroll
        for (int h = 0; h < 8; ++h) { const float t = wave_sum(fa[h]); if (C.lane == h) mine = t; }
        if (C.lane < 8) { const float z = r * mine + fbias[C.lane]; lf[(size_t)m * 8 + C.lane] = z >= 0.f ? -log1pf(expf(-z)) : z - log1pf(expf(z)); }
        if (C.lane == 0) ra0[m] = r;
      } } }
      } else {
#ifndef PROBE_CONV_REPS
#define PROBE_CONV_REPS 1
#endif
      for (int rep_ = 0; rep_ < PROBE_CONV_REPS; ++rep_) for (int r4 = gw; r4 < NEXP / CONV_L1_LATE; r4 += NGW) { const int tl = r4 / (NEXP / 4), e0 = (r4 % (NEXP / 4)) * 4; conv_rows4(a, ws, tl >> 1, tl & 1, e0, C.lane); }
      }
    }
    {
      const float* sk = a.in[16];
      for (size_t i = gt; i < (size_t)262144 / 8; i += NGT) { const f32x4 p = *((const f32x4*)sk + 2 * i), q = *((const f32x4*)sk + 2 * i + 1);
            v4u o; o.x = pk2(p.x, p.y); o.y = pk2(p.z, p.w); o.z = pk2(q.x, q.y); o.w = pk2(q.z, q.w); *((v4u*)(ws + WS_SK) + i) = o; } }
    if (gt < 384) { const int g = gt >> 6, d = gt & 63; const float* src = g == 0 ? a.in[5] : g == 1 ? a.in[6] : g == 2 ? a.in[7] : g == 3 ? a.in[8] : g == 4 ? a.in[11] : a.in[12]; ((float*)(ws + WS_GAIN))[gt] = src[d]; }
    { float* cs = (float*)(ws + WS_ROPE);
      for (int i = gt; i < SEQ * 8; i += NGT) { const int pos = i >> 3, f = i & 7; const float inv = powf(500000.0f, -0.125f * (float)f), ang = (float)pos * inv; float s, c; sincos_d(ang, s, c);
          cs[pos * 16 + f] = c; cs[pos * 16 + 8 + f] = s; } }
}

__device__ __forceinline__ void p2_route(const Args& a, const Ctx& C, int rid, int nr) {
    unsigned char* ws = a.ws;
    for (int sq = rid; sq < 16; sq += nr) { const int b = sq >> 3, h = sq & 7; const float* lf = (const float*)(ws + WS_LF); float* fl2 = (float*)(ws + WS_FL2) + (size_t)sq * SEQ;
        LAS double* wtot = (LAS double*)(C.lds + 32768);
        double loc[16]; double run = 0.0;
#pragma unroll
        for (int i = 0; i < 16; ++i) { run += (double)lf[((size_t)b * SEQ + 16 * C.tid + i) * 8 + h]; loc[i] = run; }
        double inc = run;
#pragma unroll
        for (int o = 1; o < 64; o <<= 1) { const double y = __shfl_up(inc, o); if (C.lane >= o) inc += y; }
        if (C.lane == 63) wtot[C.wave] = inc;
        __syncthreads();
        double base = inc - run;
        for (int w = 0; w < C.wave; ++w) base += wtot[w];
#pragma unroll
        for (int i = 0; i < 16; ++i) fl2[16 * C.tid + i] = (float)((base + loc[i]) * 1.4426950408889634);
    }
    __syncthreads();
    for (int u0 = 2 * rid; u0 < 512; u0 += 2 * nr) { const int unit = u0 + (C.tid >> 8), qi = C.tid & 255, half = C.tid >> 8; const int b = unit >> 8, h = (unit >> 5) & 7, qb = unit & 31;
      __syncthreads();
      if (unit < 512) {
        LAS float* km = (LAS float*)(C.lds) + half * 2048;
        const float* ksum = (const float*)(ws + WS_KSUM);
        for (int i = qi; i < qb * 64; i += 256) { const int j = i >> 6, d = i & 63; const size_t p0 = ((size_t)(((b * 32 + j) * 2 + 0) * 8 + h)) * 64 + d, p1 = ((size_t)(((b * 32 + j) * 2 + 1) * 8 + h)) * 64 + d;
            km[i] = (ksum[p0] + ksum[p1]) * (1.0f / 256.0f); }
      }
      __syncthreads();
      if (unit < 512) {
        const LAS float* km = (const LAS float*)(C.lds) + half * 2048;
        const bf16* qa = (const bf16*)(ws + WS_QKV);
        const v4u* qp = (const v4u*)(qa + ((size_t)b * SEQ + 256 * qb + qi) * 512 + h * 64);
        float q[64];
#pragma unroll
        for (int c = 0; c < 8; ++c) { const v4u w = qp[c];
#pragma unroll
            for (int j = 0; j < 4; ++j) { q[8 * c + 2 * j] = bflo(w[j]); q[8 * c + 2 * j + 1] = bfhi(w[j]); } }
        float v0 = -INFINITY, v1 = -INFINITY, v2 = -INFINITY; int i0 = -1, i1 = -1, i2 = -1;
        for (int j = 0; j < qb; ++j) { float g0 = 0.f, g1 = 0.f, g2 = 0.f, g3 = 0.f;
#pragma unroll
            for (int d = 0; d < 64; d += 4) { const f32x4 k = *(const LAS f32x4*)(km + j * 64 + d); g0 += q[d] * k.x; g1 += q[d + 1] * k.y; g2 += q[d + 2] * k.z; g3 += q[d + 3] * k.w; }
            const float g = (g0 + g1) + (g2 + g3);
            if (g > v0) { v2 = v1; i2 = i1; v1 = v0; i1 = i0; v0 = g; i0 = j; } else if (g > v1) { v2 = v1; i2 = i1; v1 = g; i1 = j; } else if (g > v2) { v2 = g; i2 = j; } }
        unsigned msk = 0u; if (i0 >= 0) msk |= 1u << i0; if (i1 >= 0) msk |= 1u << i1; if (i2 >= 0) msk |= 1u << i2;
        ((unsigned*)(ws + WS_SEL))[((size_t)(b * 8 + h)) * SEQ + 256 * qb + qi] = msk;
      }
    }
}

__device__ __forceinline__ void p3_lists_item(const Args& a, const Ctx& C, int bh, int j) {
    unsigned char* ws = a.ws; LAS unsigned* wc = (LAS unsigned*)(C.lds);
    const unsigned* sel = (const unsigned*)(ws + WS_SEL) + (size_t)bh * SEQ;
    unsigned short* out = (unsigned short*)(ws + WS_LIST) + (size_t)bh * 126976 + (8192 * j - 128 * j * (j + 1));
    unsigned sv[16];
#pragma unroll
    for (int it = 0; it < 16; ++it) { const int q = 256 * (j + 1) + NWAVES * 64 * it + C.tid; sv[it] = q < SEQ ? sel[q] : 0u; }
    unsigned fm = 0u; unsigned short below[16];
#pragma unroll
    for (int it = 0; it < 16; ++it) { const int q = 256 * (j + 1) + NWAVES * 64 * it + C.tid; const bool f = q < SEQ && ((sv[it] >> j) & 1u);
        const unsigned long long m = __ballot(f); below[it] = (unsigned short)__builtin_popcountll(m & ((1ull << C.lane) - 1ull)); fm |= f ? (1u << it) : 0u;
        if (C.lane == 0) wc[it * NWAVES + C.wave] = (unsigned)__builtin_popcountll(m); }
    __syncthreads();
    unsigned base = 0u;
#pragma unroll
    for (int it = 0; it < 16; ++it) { unsigned off = base, tot = 0u;
#pragma unroll
        for (int w = 0; w < NWAVES; ++w) { const unsigned c = wc[it * NWAVES + w]; if (w < C.wave) off += c; tot += c; }
        if ((fm >> it) & 1u) out[off + below[it]] = (unsigned short)(256 * (j + 1) + NWAVES * 64 * it + C.tid);
        base += tot; }
    if (C.tid == 0) ((int*)(ws + WS_CNT))[bh * 32 + j] = (int)base;
    __syncthreads();
}
__device__ __forceinline__ void p3_lists(const Args& a, const Ctx& C) {
    for (int item = C.vcu; item < 16 * 31; item += C.G) p3_lists_item(a, C, item / 31, item % 31);
}

__device__ __forceinline__ void p4_attn_l0a(const Args& a, const Ctx& C) {
    unsigned char* ws = a.ws; const attn_body::bf16* qkv = (const attn_body::bf16*)(ws + WS_QKV); const size_t BUF = (size_t)M * 512;
    char* shm = (char*)C.lds;
    LAS int* upref = (LAS int*)(C.lds + 124928);
    const int* cnt = (const int*)(ws + WS_CNT);
    { int v = 0; if (C.tid < 496) v = (cnt[(C.tid / 31) * 32 + (C.tid % 31)] + 255) >> 8;
      int inc = v;
#pragma unroll
      for (int o = 1; o < 64; o <<= 1) { const int y = __shfl_up(inc, o); if (C.lane >= o) inc += y; }
      LAS int* wtot = (LAS int*)(C.lds + 127232 + 2048);
      if (C.lane == 63) wtot[C.wave] = inc;
      __syncthreads();
      int base = 0;
      for (int w2 = 0; w2 < C.wave; ++w2) base += wtot[w2];
      if (C.tid < 496) upref[C.tid] = base + inc - v;
      if (C.tid == 495) upref[496] = base + inc; }
    __syncthreads();
    const int U = upref[496];
    LAS int* bnd = (LAS int*)(C.lds + 127232);
    if (C.wave == 0) {
        constexpr float CG = 11.0f, CT = 1.3f, CFO = 4.0f;
        const float gq_ = wave_max(fabsf(a.in[7][C.lane])), gk_ = wave_max(fabsf(a.in[8][C.lane]));
        const float bl_ = 2.0f * (64.0f * gq_ * gk_ * attn_body::C2 * 1.02f + 1.0f);
        float cfv[4], s4 = 0.f, f4 = 0.f;
#pragma unroll
        for (int k = 0; k < 4; ++k) { const int c = 4 * C.lane + k; cfv[k] = 0.f;
            if (c < C.G && c < 256) { const int bh = c >> 4, sq = c & 15; const float fend = ((const float*)(ws + WS_FL2))[(size_t)bh * SEQ + SEQ - 1];
                const float slope = fmaxf(-fend * (1.0f / (float)(SEQ - 1)), 1e-6f); const float wtf = (160.0f + bl_) / (slope * 64.0f) + 3.0f; const int wt = wtf < 128.f ? (int)wtf : 128;
                const int ta = 4 * sq + 4 < wt + 4 ? 4 * sq + 4 : wt + 4, tb = 4 * (31 - sq) + 4 < wt + 4 ? 4 * (31 - sq) + 4 : wt + 4;
                cfv[k] = CT * (float)(ta + tb) + 2.0f * CFO; }
            f4 += cfv[k]; }
        const float target = ((float)U * CG + wave_sum(f4)) / (float)C.G;
        float sh[4];
#pragma unroll
        for (int k = 0; k < 4; ++k) { sh[k] = (4 * C.lane + k < C.G) ? fmaxf(0.f, (target - cfv[k]) * (1.0f / CG)) : 0.f; s4 += sh[k]; }
        float inc = s4;
#pragma unroll
        for (int o = 1; o < 64; o <<= 1) { const float y = __shfl_up(inc, o); if (C.lane >= o) inc += y; }
        const float tots = __shfl(inc, 63), scale = tots > 0.f ? (float)U / tots : 0.f;
        float run = inc - s4;
#pragma unroll
        for (int k = 0; k < 4; ++k) { run += sh[k]; int e = (int)(run * scale + 0.5f); e = e < U ? e : U; if (4 * C.lane + k >= C.G - 1) e = U; if (4 * C.lane + k < 256) bnd[4 * C.lane + k] = e; }
    }
    __syncthreads();
    const int u0 = C.vcu ? bnd[C.vcu - 1] : 0, u1 = bnd[C.vcu];
#ifndef PROBE_GREP
#define PROBE_GREP 1
#endif
    for (int grep_ = 0; grep_ < PROBE_GREP; ++grep_)
    for (int u = u0; u < u1; ++u) {
        int lo = 0, hi = 496;
        while (hi - lo > 1) { const int mid = (lo + hi) >> 1; if (upref[mid] <= u) lo = mid; else hi = mid; }
        const int item = lo, c = u - upref[lo], bh = item / 31, j = item % 31, b = bh >> 3, h = bh & 7, n = cnt[bh * 32 + j] - 256 * c;
        attn_body::UnitArgs um; um.Q = qkv; um.K = qkv + BUF; um.V = qkv + 2 * BUF; um.O = nullptr; um.qcol = h * 64; um.kcol = h * 64; um.ocol = 0;
        um.Fl2 = nullptr; um.gate = nullptr; um.sel = (const unsigned*)(ws + WS_SEL) + (size_t)bh * SEQ; um.sinkp = nullptr; um.bl2x2 = 0.f;
        um.glist = (const unsigned short*)(ws + WS_LIST) + (size_t)bh * 126976 + (8192 * j - 128 * j * (j + 1)) + 256 * c; um.gn = n < 256 ? n : 256;
        um.PO = (attn_body::bf16*)(ws + WS_PO) + (size_t)bh * SEQ * 192; um.LSE = (float*)(ws + WS_LSE) + (size_t)bh * SEQ * 3;
        um.kvres = (u > u0 && c > 0) ? 1 : 0;
        attn_body::attn_unit<3, 8, 512, 512, 1024>(b, j, um, shm);
    }
    { const int bh = C.vcu >> 4, s = C.vcu & 15, b = bh >> 3, h = bh & 7;
      const float gq = wave_max(fabsf(a.in[7][C.lane])), gk = wave_max(fabsf(a.in[8][C.lane]));
      const float bl2x2 = 2.0f * (64.0f * gq * gk * attn_body::C2 * 1.02f + 1.0f);
      attn_body::UnitArgs uf; uf.Q = qkv + 3 * BUF; uf.K = qkv + 4 * BUF; uf.V = qkv + 5 * BUF; uf.O = (attn_body::bf16*)(ws + WS_AO); uf.qcol = h * 64; uf.kcol = h * 64; uf.ocol = 512 + h * 64;
      uf.Fl2 = (const float*)(ws + WS_FL2) + (size_t)bh * SEQ; uf.gate = qkv + 6 * BUF + h * 64; uf.sel = nullptr; uf.sinkp = nullptr; uf.bl2x2 = bl2x2;
      uf.glist = nullptr; uf.gn = 0; uf.PO = nullptr; uf.LSE = nullptr; uf.kvres = 0;
      if (C.vcu < 256)
#ifndef PROBE_FREP
#define PROBE_FREP 1
#endif
          for (int i = 0; i < 2 * PROBE_FREP; ++i) attn_body::attn_unit<1, 8, 512, 512, 1024>(b, (i & 1) ? s : 31 - s, uf, shm); }
}
__device__ __forceinline__ void p5_attn_l0b(const Args& a, const Ctx& C) {
    unsigned char* ws = a.ws; const attn_body::bf16* qkv = (const attn_body::bf16*)(ws + WS_QKV); const size_t BUF = (size_t)M * 512;
    for (int pmb = C.vcu >> 2; pmb < M / 256; pmb += C.G >> 2)
    for (int i = 0; i < 2; ++i) {
    const int b = pmb >> 5, qbk = pmb & 31, h = (C.vcu & 3) * 2 + i, bh = b * 8 + h;
    attn_body::UnitArgs um; um.Q = qkv; um.K = qkv + BUF; um.V = qkv + 2 * BUF; um.O = (attn_body::bf16*)(ws + WS_AO); um.qcol = h * 64; um.kcol = h * 64; um.ocol = h * 64;
    um.Fl2 = nullptr; um.gate = nullptr; um.sel = (const unsigned*)(ws + WS_SEL) + (size_t)bh * SEQ; um.sinkp = nullptr; um.bl2x2 = 0.f;
    um.glist = nullptr; um.gn = 0; um.PO = (attn_body::bf16*)(ws + WS_PO) + (size_t)bh * SEQ * 192; um.LSE = (float*)(ws + WS_LSE) + (size_t)bh * SEQ * 3; um.kvres = 0;
    char* shm = (char*)C.lds;
    attn_body::attn_unit<4, 8, 512, 512, 1024>(b, qbk, um, shm); }
}
__device__ __forceinline__ void p8_attn_l1(const Args& a, const Ctx& C) {
    unsigned char* ws = a.ws;
    char* shm = (char*)C.lds;
    for (int pmb = C.vcu >> 2; pmb < M / 256; pmb += C.G >> 2)
    for (int i = 0; i < 4; ++i) {
    const int b = pmb >> 5, qbk = pmb & 31, hq = (C.vcu & 3) * 4 + i;
    attn_body::UnitArgs u; u.Q = (const attn_body::bf16*)(ws + WS_QKV); u.K = (const attn_body::bf16*)(ws + WS_QKV + 32 * MiB); u.V = (const attn_body::bf16*)(ws + WS_QKV + 36 * MiB); u.O = (attn_body::bf16*)(ws + WS_AO);
    u.qcol = hq * 64; u.kcol = (hq >> 3) * 64; u.ocol = hq * 64; u.Fl2 = nullptr; u.gate = nullptr; u.sel = nullptr; u.sinkp = a.in[13] + hq; u.bl2x2 = 0.f; u.glist = nullptr; u.gn = 0; u.PO = nullptr; u.LSE = nullptr; u.kvres = 0;
    attn_body::attn_unit<2, 8, 1024, 128, 1024>(b, qbk, u, shm); }
}

constexpr int SC_LD = 129;
constexpr int PL_TOPIDX = 256 * SC_LD * 4;
constexpr int PL_ALDS = PL_TOPIDX + 4096;
constexpr int PL_END = PL_ALDS + 4096;
static_assert(PL_END <= LDSCTL_OFF, "PEER LDS map");
__device__ __forceinline__ float gelu_erf(float v) { return 0.5f * v * (1.0f + erff(v * 0.70710678118654752f)); }

__device__ const unsigned char PEER_CAND[52] = {0,1,2,3,4,5,6,7,8,9,10,11,12,13,14,15,16,17,18,19,20,21,22,23,32,33,34,35,36,48,49,50,51,64,65,66,80,81,96,97,112,113,128,144,160,176,192,208,224,240,255,255};
template <int XM> __device__ __forceinline__ void merge16(float (&L)[16]) {
    float R[16];
#pragma unroll
    for (int i = 0; i < 16; ++i) R[i] = __shfl_xor(L[15 - i], XM);
#pragma unroll
    for (int i = 0; i < 16; ++i) L[i] = fmaxf(L[i], R[i]);
#pragma unroll
    for (int d = 8; d >= 1; d >>= 1)
#pragma unroll
        for (int i = 0; i < 16; ++i) if ((i & d) == 0) { const float hi = fmaxf(L[i], L[i + d]), lo = fminf(L[i], L[i + d]); L[i] = hi; L[i + d] = lo; }
}
constexpr int PL_SEQ = 32768, PL_HIST = 98304, PL_AL = 102400;
template <bool LAST> __device__ __forceinline__ void peer_phase(const Args& a, const Ctx& C, int layer) {
    unsigned char* ws = a.ws;
    const bf16* qp = (const bf16*)(ws + WS_QP);
    const bf16* skb = (const bf16*)(ws + WS_SK) + (size_t)layer * 131072;
    const unsigned char* Dt = ws + WS_TAB + (size_t)(2 * layer) * 32 * MiB;
    const unsigned char* Ut = ws + WS_TAB + (size_t)(2 * layer + 1) * 32 * MiB;
    const float* tsc = (const float*)(ws + WS_TSC) + (size_t)(2 * layer) * NEXP;
    const float* rsp = (const float*)(ws + WS_RSP);
    const float* gffn = a.in[2] + layer * 1024;
    float* xio = a.out;
    v2u* UL = (v2u*)(ws + WS_UL);
    LAS float* sc = (LAS float*)C.lds;
    LAS unsigned char* topidx = (LAS unsigned char*)(C.lds + PL_TOPIDX);
    const int w = C.wave;
    LAS unsigned char* candl = (LAS unsigned char*)(C.lds + PL_TOPIDX + 4096);
    if (C.tid < 52) candl[C.tid] = PEER_CAND[C.tid];
    __syncthreads();
    for (int grp = C.vcu; grp < M / 64; grp += C.G) {
#ifndef PROBE_ROUTE_REPS
#define PROBE_ROUTE_REPS 1
#endif
      bf16x8 kf0[2][8], kf1[2][8];
      { int tk_ = C.tid; asm volatile("" : "+v"(tk_)); const int lane0 = tk_ & 63, l15k = lane0 & 15, lgk = lane0 >> 4;
#pragma unroll
        for (int p = 0; p < 2; ++p) { const bf16* kb = skb + ((size_t)(w * 2 + p) * 128 + l15k) * 64 + 8 * lgk;
#pragma unroll
            for (int nt = 0; nt < 8; ++nt) { kf0[p][nt] = *(const bf16x8*)(kb + (size_t)nt * 16 * 64); kf1[p][nt] = *(const bf16x8*)(kb + (size_t)nt * 16 * 64 + 32); } } }
      for (int tl_ = 0; tl_ < 4 * PROBE_ROUTE_REPS; ++tl_) { const int tl = tl_ & 3;
        const int tok0 = grp * 64 + tl * 16;
        int tid_ = C.tid; asm volatile("" : "+v"(tid_));
        const int tid = tid_, lane = tid & 63, l15 = lane & 15, lg = lane >> 4;
#ifndef PROBE_RA
#define PROBE_RA 1
#define PROBE_RB 1
#define PROBE_RC 1
#endif
        for (int ra_ = 0; ra_ < PROBE_RA; ++ra_) {
            typedef float f32x4v __attribute__((ext_vector_type(4)));
#pragma unroll
            for (int p = 0; p < 2; ++p) {
                const bf16* qrow = qp + (size_t)(tok0 + l15) * 1024 + 128 * w + 64 * p + 8 * lg;
                const bf16x8 a0 = *(const bf16x8*)(qrow), a1 = *(const bf16x8*)(qrow + 32);
#pragma unroll
                for (int nt = 0; nt < 8; ++nt) {
                    const bf16x8 b0 = kf0[p][nt], b1 = kf1[p][nt];
                    f32x4v acc = {0.f, 0.f, 0.f, 0.f};
                    acc = __builtin_amdgcn_mfma_f32_16x16x32_bf16(a0, b0, acc, 0, 0, 0);
                    acc = __builtin_amdgcn_mfma_f32_16x16x32_bf16(a1, b1, acc, 0, 0, 0);
#pragma unroll
                    for (int r = 0; r < 4; ++r) sc[((w * 2 + p) * 16 + 4 * lg + r) * SC_LD + 16 * nt + l15] = acc[r];
                }
            }
        }
        LDS_WAIT(); asm volatile("" ::: "memory");
        for (int rb_ = 0; rb_ < PROBE_RB; ++rb_) { const int prob = lane >> 1, kh = lane & 1, P = w * 32 + prob;
            const LAS float* row = sc + P * SC_LD + 64 * kh;
            float L[16];
#pragma unroll
            for (int i = 0; i < 16; ++i) L[i] = -INFINITY;
            for (int k0 = 0; k0 < 64; k0 += 8) {
#pragma unroll
                for (int kk = 0; kk < 8; ++kk) { const int k = k0 + kk;
                    const float v = __uint_as_float((__float_as_uint(row[k]) & 0xffffff80u) | (unsigned)(127 - (64 * kh + k)));
#pragma unroll
                    for (int i = 15; i >= 1; --i) L[i] = __builtin_amdgcn_fmed3f(L[i - 1], v, L[i]);
                    L[0] = fmaxf(L[0], v); }
            }
            merge16<1>(L);
            if (kh == 0) { unsigned pk[4];
#pragma unroll
                for (int i = 0; i < 4; ++i) pk[i] = (127u - (__float_as_uint(L[4 * i]) & 127u)) | ((127u - (__float_as_uint(L[4 * i + 1]) & 127u)) << 8) | ((127u - (__float_as_uint(L[4 * i + 2]) & 127u)) << 16) | ((127u - (__float_as_uint(L[4 * i + 3]) & 127u)) << 24);
                *(LAS v4u*)(topidx + P * 16) = (v4u){pk[0], pk[1], pk[2], pk[3]}; }
        }
        LDS_WAIT(); asm volatile("" ::: "memory");
        for (int rc_ = 0; rc_ < PROBE_RC; ++rc_) {
            const int token = lane >> 2, sub = lane & 3, P1 = (w * 2) * 16 + token, P2 = P1 + 16;
            float L[16];
#pragma unroll
            for (int i = 0; i < 16; ++i) L[i] = -INFINITY;
#pragma unroll
            for (int n = 0; n < 13; ++n) { const unsigned code = candl[4 * n + sub]; const unsigned aa = (code >> 4) & 15u, bb = code & 15u;
                const unsigned k1 = topidx[P1 * 16 + aa], k2 = topidx[P2 * 16 + bb];
                const float sm = sc[P1 * SC_LD + k1] + sc[P2 * SC_LD + k2];
                const float v = code == 255u ? -INFINITY : __uint_as_float((__float_as_uint(sm) & 0xffffff00u) | (255u - code));
#pragma unroll
                for (int i = 15; i >= 1; --i) L[i] = __builtin_amdgcn_fmed3f(L[i - 1], v, L[i]);
                L[0] = fmaxf(L[0], v); }
            merge16<1>(L); merge16<2>(L);
            float ts[4]; unsigned myidx[4]; float mx = -INFINITY;
#pragma unroll
            for (int j = 0; j < 4; ++j) { const float lv = sub == 0 ? L[j] : sub == 1 ? L[4 + j] : sub == 2 ? L[8 + j] : L[12 + j];
                const unsigned code = 255u - (__float_as_uint(lv) & 255u), aa = code >> 4, bb = code & 15u;
                const unsigned k1 = topidx[P1 * 16 + aa], k2 = topidx[P2 * 16 + bb];
                ts[j] = sc[P1 * SC_LD + k1] + sc[P2 * SC_LD + k2]; myidx[j] = k1 * 128u + k2; mx = fmaxf(mx, ts[j]); }
            mx = fmaxf(mx, __shfl_xor(mx, 1)); mx = fmaxf(mx, __shfl_xor(mx, 2));
            float sum = 0.f;
#pragma unroll
            for (int j = 0; j < 4; ++j) { ts[j] = __expf(ts[j] - mx); sum += ts[j]; }
            sum += __shfl_xor(sum, 1); sum += __shfl_xor(sum, 2);
            const float inv = 1.0f / sum;
#pragma unroll
            for (int j = 0; j < 4; ++j) UL[(size_t)(tok0 + token) * 128 + w * 16 + 4 * sub + j] = (v2u){myidx[j], __float_as_uint(ts[j] * inv)};
        }
        LDS_WAIT(); asm volatile("" ::: "memory");
      }
      __syncthreads();
#define SW_LOAD(buf, T, sq_, i) do { const unsigned e_ = sq_[128 * g + (i)].x; const unsigned char* rp_ = (T) + (size_t)e_ * 1024 + 16 * li; \
            _Pragma("unroll") for (int c = 0; c < 4; ++c) buf[c] = *(const v4u*)(rp_ + 256 * c); } while (0)
      {
        int ln_ = C.tid; asm volatile("" : "+v"(ln_)); const int lane = ln_ & 63, g = lane >> 4, li = lane & 15;
        LAS v2u* seq0 = (LAS v2u*)(C.lds + PL_SEQ) + (w * 2 + 0) * 512;
        LAS v2u* seq1 = (LAS v2u*)(C.lds + PL_SEQ) + (w * 2 + 1) * 512;
        LAS unsigned* hist = (LAS unsigned*)(C.lds + PL_HIST) + w * 128;
        LAS int* al0 = (LAS int*)(C.lds + PL_AL) + (w * 2 + 0) * 512;
        LAS int* al1 = (LAS int*)(C.lds + PL_AL) + (w * 2 + 1) * 512;
        v4u xq[2][4]; float sxp[2];
#pragma unroll 1
        for (int pass = 0; pass < 2; ++pass) { v4u xqt[4]; float sxt;
          const int tokb = grp * 64 + 32 * pass + 4 * w, row = tokb + g;
          LAS v2u* seq = pass ? seq1 : seq0;
          hist[lane] = 0u; hist[64 + lane] = 0u;
          const float* xr = xio + (size_t)row * 1024 + 16 * li;
          { float rn; { const f32x4 ra = *(const f32x4*)(rsp + (size_t)row * 16), rb = *(const f32x4*)(rsp + (size_t)row * 16 + 4), rc = *(const f32x4*)(rsp + (size_t)row * 16 + 8), rd = *(const f32x4*)(rsp + (size_t)row * 16 + 12);
                const float ss = ((ra[0] + ra[1]) + (ra[2] + ra[3])) + ((rb[0] + rb[1]) + (rb[2] + rb[3])) + ((rc[0] + rc[1]) + (rc[2] + rc[3])) + ((rd[0] + rd[1]) + (rd[2] + rd[3]));
                rn = 1.0f / sqrtf(ss * (1.0f / 1024.0f) + RMS_EPS); }
            f32x4 n[4][4]; float mx = 0.f;
#pragma unroll
            for (int c = 0; c < 4; ++c)
#pragma unroll
                for (int j = 0; j < 4; ++j) { n[c][j] = *(const f32x4*)(xr + 256 * c + 4 * j) * rn * *(const f32x4*)(gffn + 256 * c + 16 * li + 4 * j);
                    mx = fmaxf(mx, fmaxf(fmaxf(fabsf(n[c][j].x), fabsf(n[c][j].y)), fmaxf(fabsf(n[c][j].z), fabsf(n[c][j].w)))); }
            mx = fmaxf(mx, __shfl_xor(mx, 8)); mx = fmaxf(mx, __shfl_xor(mx, 4)); mx = fmaxf(mx, __shfl_xor(mx, 2)); mx = fmaxf(mx, __shfl_xor(mx, 1));
            const float sx = mx > 0.f ? mx * (1.0f / 127.0f) : 1.0f, inv = 1.0f / sx; sxt = sx;
#pragma unroll
            for (int c = 0; c < 4; ++c)
#pragma unroll
                for (int j = 0; j < 4; ++j) { const int q0 = (int)rintf(n[c][j].x * inv), q1 = (int)rintf(n[c][j].y * inv), q2 = (int)rintf(n[c][j].z * inv), q3 = (int)rintf(n[c][j].w * inv);
                    xqt[c][j] = (unsigned)(q0 & 255) | ((unsigned)(q1 & 255) << 8) | ((unsigned)(q2 & 255) << 16) | ((unsigned)(q3 & 255) << 24); } }
          if (pass == 0) { sxp[0] = sxt;
#pragma unroll
              for (int c = 0; c < 4; ++c) xq[0][c] = xqt[c]; }
          else { sxp[1] = sxt;
#pragma unroll
              for (int c = 0; c < 4; ++c) xq[1][c] = xqt[c]; }
          { unsigned pe[8], pgb[8], prank[8];
            LDS_WAIT();
#pragma unroll
            for (int s8 = 0; s8 < 8; ++s8) { const v2u u = UL[(size_t)(tokb + (s8 >> 1)) * 128 + 64 * (s8 & 1) + lane]; pe[s8] = u.x; pgb[s8] = u.y;
                prank[s8] = __hip_atomic_fetch_add(hist + 32 * (s8 >> 1) + ((u.x >> 9) & 31u), 1u, __ATOMIC_RELAXED, __HIP_MEMORY_SCOPE_WAVEFRONT); }
            LDS_WAIT();
            unsigned c0 = hist[lane], c1 = hist[64 + lane], i0 = c0, i1 = c1;
#pragma unroll
            for (int o = 1; o < 32; o <<= 1) { const unsigned y0 = __shfl_up(i0, o), y1 = __shfl_up(i1, o); if ((lane & 31) >= o) { i0 += y0; i1 += y1; } }
            LDS_WAIT();
            hist[lane] = i0 - c0; hist[64 + lane] = i1 - c1;
            LDS_WAIT();
#pragma unroll
            for (int s8 = 0; s8 < 8; ++s8) seq[128 * (s8 >> 1) + hist[32 * (s8 >> 1) + ((pe[s8] >> 9) & 31u)] + prank[s8]] = (v2u){pe[s8], pgb[s8]};
            LDS_WAIT(); }
        }
#define SW_DOWN(buf, xqp, alp, i) do { int sacc = 0; _Pragma("unroll") for (int c = 0; c < 4; ++c) { sacc = __builtin_amdgcn_sdot4((int)buf[c].x, (int)xqp[c].x, sacc, false); sacc = __builtin_amdgcn_sdot4((int)buf[c].y, (int)xqp[c].y, sacc, false); \
                sacc = __builtin_amdgcn_sdot4((int)buf[c].z, (int)xqp[c].z, sacc, false); sacc = __builtin_amdgcn_sdot4((int)buf[c].w, (int)xqp[c].w, sacc, false); } \
            sacc += __shfl_xor(sacc, 8); sacc += __shfl_xor(sacc, 4); sacc += __shfl_xor(sacc, 2); sacc += __shfl_xor(sacc, 1); \
            if (li == 0) alp[128 * g + (i)] = sacc; } while (0)
        {
#define DLD(buf, k, par) do { if ((k) < 256) { if (par) SW_LOAD(buf, Dt, seq1, (k) >> 1); else SW_LOAD(buf, Dt, seq0, (k) >> 1); } } while (0)
#define DCP(buf, k, par) do { if ((k) < 256) { if (par) SW_DOWN(buf, xq[1], al1, (k) >> 1); else SW_DOWN(buf, xq[0], al0, (k) >> 1); } } while (0)
v4u b0[4], b1[4], b2[4], b3[4], b4[4];
          DLD(b0, 0, 0); DLD(b1, 1, 1); DLD(b2, 2, 0); DLD(b3, 3, 1);
#pragma unroll 1
          for (int kb = 0; kb < 256; kb += 10) {
              DLD(b4, kb + 4, 0); DCP(b0, kb + 0, 0);
              DLD(b0, kb + 5, 1); DCP(b1, kb + 1, 1);
              DLD(b1, kb + 6, 0); DCP(b2, kb + 2, 0);
              DLD(b2, kb + 7, 1); DCP(b3, kb + 3, 1);
              DLD(b3, kb + 8, 0); DCP(b4, kb + 4, 0);
              DLD(b4, kb + 9, 1); DCP(b0, kb + 5, 1);
              DLD(b0, kb + 10, 0); DCP(b1, kb + 6, 0);
              DLD(b1, kb + 11, 1); DCP(b2, kb + 7, 1);
              DLD(b2, kb + 12, 0); DCP(b3, kb + 8, 0);
              DLD(b3, kb + 13, 1); DCP(b4, kb + 9, 1);
          }
#undef DLD
#undef DCP
        }
#undef SW_DOWN
        LDS_WAIT();
        float tsinv[2];
#pragma unroll
        for (int pass = 0; pass < 2; ++pass) { LAS int* al = pass ? al1 : al0; LAS float* cl = (LAS float*)al; LAS v2u* seq = pass ? seq1 : seq0; const float sx = sxp[pass];
          const float sx0 = __uint_as_float(__builtin_amdgcn_readlane(__float_as_uint(sx), 0)), sx1 = __uint_as_float(__builtin_amdgcn_readlane(__float_as_uint(sx), 16)),
                      sx2 = __uint_as_float(__builtin_amdgcn_readlane(__float_as_uint(sx), 32)), sx3 = __uint_as_float(__builtin_amdgcn_readlane(__float_as_uint(sx), 48));
          float cv[8];
#pragma unroll
          for (int s8 = 0; s8 < 8; ++s8) { const int idx = 64 * s8 + lane; const v2u ent = seq[idx]; const unsigned ee = ent.x;
              const float sd = tsc[ee], su = tsc[NEXP + ee]; const float sxl = (s8 >> 1) == 0 ? sx0 : (s8 >> 1) == 1 ? sx1 : (s8 >> 1) == 2 ? sx2 : sx3;
              const float av = (float)al[idx]; cv[s8] = __uint_as_float(ent.y) * su * gelu_erf(av * (sd * sxl)); }
          float tsl = 1.f;
#pragma unroll
          for (int t4 = 0; t4 < 4; ++t4) { const float m = wave_max(fmaxf(fabsf(cv[2 * t4]), fabsf(cv[2 * t4 + 1])));
              const float sc = m > 0.f ? exp2f(-ceilf(log2f(m))) : 1.f;
              cl[128 * t4 + lane] = cv[2 * t4] * sc; cl[128 * t4 + 64 + lane] = cv[2 * t4 + 1] * sc; if (g == t4) tsl = sc; }
          tsinv[pass] = 1.0f / tsl; }
        LDS_WAIT();
        { const LAS float* cl0 = (const LAS float*)al0; const LAS float* cl1 = (const LAS float*)al1;
          typedef _Float16 h2 __attribute__((ext_vector_type(2)));
          h2 acc0[2][16], acc1[2][16];
#pragma unroll
          for (int c = 0; c < 2; ++c)
#pragma unroll
              for (int i = 0; i < 16; ++i) { acc0[c][i] = (h2){(_Float16)0.f, (_Float16)0.f}; acc1[c][i] = (h2){(_Float16)0.f, (_Float16)0.f}; }
#define SW_LOADU(buf, sq_, i) do { const unsigned e_ = sq_[128 * g + (i)].x; const unsigned char* rp_ = Ut + (size_t)e_ * 768; \
            buf[0].a4 = *(const v4u*)(rp_ + 16 * li); buf[0].b4 = *(const v4u*)(rp_ + 256 + 16 * li); buf[0].a2 = *(const v2u*)(rp_ + 512 + 8 * li); buf[0].b2 = *(const v2u*)(rp_ + 640 + 8 * li); } while (0)
#define SW_UP(buf, accp, clp, i) do { const _Float16 ch_ = (_Float16)clp[128 * g + (i)]; const h2 cc_ = {ch_, ch_}; \
            _Pragma("unroll") for (int c = 0; c < 2; ++c) { const v6u s6_ = c ? (v6u){buf[0].b4.x, buf[0].b4.y, buf[0].b4.z, buf[0].b4.w, buf[0].b2.x, buf[0].b2.y} : (v6u){buf[0].a4.x, buf[0].a4.y, buf[0].a4.z, buf[0].a4.w, buf[0].a2.x, buf[0].a2.y}; \
                const h32 r_ = __builtin_amdgcn_cvt_scalef32_pk32_f16_fp6(s6_, 1.0f); \
                _Pragma("unroll") for (int q = 0; q < 16; ++q) { const h2 t_ = {r_[2 * q], r_[2 * q + 1]}; accp[c][q] = t_ * cc_ + accp[c][q]; } \
                asm volatile("" : "+v"(accp[c][0]), "+v"(accp[c][1]), "+v"(accp[c][2]), "+v"(accp[c][3]), "+v"(accp[c][4]), "+v"(accp[c][5]), "+v"(accp[c][6]), "+v"(accp[c][7]), \
                                  "+v"(accp[c][8]), "+v"(accp[c][9]), "+v"(accp[c][10]), "+v"(accp[c][11]), "+v"(accp[c][12]), "+v"(accp[c][13]), "+v"(accp[c][14]), "+v"(accp[c][15])); } } while (0)
          {
#define ULD(buf, k, par) do { if ((k) < 256) { if (par) SW_LOADU(buf, seq1, (k) >> 1); else SW_LOADU(buf, seq0, (k) >> 1); } } while (0)
#define UCP(buf, k, par) do { if ((k) < 256) { if (par) SW_UP(buf, acc1, cl1, (k) >> 1); else SW_UP(buf, acc0, cl0, (k) >> 1); } } while (0)
UB b0[4], b1[4], b2[4], b3[4], b4[4], b5[4], b6[4], b7[4];
          ULD(b0, 0, 0); ULD(b1, 1, 1); ULD(b2, 2, 0); ULD(b3, 3, 1); ULD(b4, 4, 0); ULD(b5, 5, 1); ULD(b6, 6, 0);
#pragma unroll 1
          for (int kb = 0; kb < 256; kb += 8) {
              ULD(b7, kb + 7, 1); UCP(b0, kb + 0, 0);
              ULD(b0, kb + 8, 0); UCP(b1, kb + 1, 1);
              ULD(b1, kb + 9, 1); UCP(b2, kb + 2, 0);
              ULD(b2, kb + 10, 0); UCP(b3, kb + 3, 1);
              ULD(b3, kb + 11, 1); UCP(b4, kb + 4, 0);
              ULD(b4, kb + 12, 0); UCP(b5, kb + 5, 1);
              ULD(b5, kb + 13, 1); UCP(b6, kb + 6, 0);
              ULD(b6, kb + 14, 0); UCP(b7, kb + 7, 1);
          }
#undef ULD
#undef UCP
          }
#undef SW_UP
#undef SW_LOADU
#define SW_OUT(accp, pass) do { const int row = grp * 64 + 32 * (pass) + 4 * w + g; float* xr = xio + (size_t)row * 1024 + 4 * li; float ss = 0.f; const float ti_ = tsinv[pass]; \
            _Pragma("unroll") for (int c = 0; c < 2; ++c) { \
                _Pragma("unroll") for (int q = 0; q < 8; ++q) { float* xp_ = xr + 512 * c + 64 * q; \
                    const f32x4 y = *(const f32x4*)xp_ + (f32x4){(float)accp[c][2 * q].x, (float)accp[c][2 * q].y, (float)accp[c][2 * q + 1].x, (float)accp[c][2 * q + 1].y} * ti_; *(f32x4*)xp_ = y; \
                    ss += (y.x * y.x + y.y * y.y) + (y.z * y.z + y.w * y.w); \
                    if (!LAST) { bf16* xb = (bf16*)(ws + WS_XB) + (size_t)row * 1024 + 512 * c + 64 * q + 4 * li; *(v2u*)xb = (v2u){pk2(y.x, y.y), pk2(y.z, y.w)}; } } } \
            if (!LAST) { ss += __shfl_xor(ss, 8); ss += __shfl_xor(ss, 4); ss += __shfl_xor(ss, 2); ss += __shfl_xor(ss, 1); \
                if (li == 0) ((float*)(ws + WS_RA1))[row] = 1.0f / sqrtf(ss * (1.0f / 1024.0f) + RMS_EPS); } } while (0)
          SW_OUT(acc0, 0); SW_OUT(acc1, 1);
#undef SW_OUT
        }
      }
#undef SW_LOAD
      __syncthreads();
    }
}

constexpr int CW_GRP = 8192, CW_XID = 16384;
struct GroupOrder {
    int nN, c, G4, nM;
    __device__ bool next(int i, pg8::Unit& u) const {
        const bool five = nN == 5 && (c & 3) == 0; const int j = five ? (i >> 1) : i, pm = (c >> 2) + j * G4; if (pm >= nM) return false;
        u.pm = pm; u.pn = (five && (i & 1)) ? 4 : (c & 3); return true; }
    __device__ __forceinline__ void a_ready(const pg8::Unit&) const {}
    __device__ __forceinline__ void done(const pg8::Unit&) const {}
};
__device__ __forceinline__ void sub_barrier(gu32* ctl, int cword, unsigned target, volatile LAS unsigned* same_xcd) {
    asm volatile("s_waitcnt vmcnt(0)" ::: "memory");
    __syncthreads();
    if (threadIdx.x == 0) {
        unsigned* cnt = (unsigned*)ctl + cword; unsigned* bar = (unsigned*)ctl + CW_BAR;
        if (same_xcd[0] != 1u) { __builtin_amdgcn_fence(__ATOMIC_RELEASE, "agent"); asm volatile("s_waitcnt vmcnt(0)" ::: "memory"); }
        (void)xb_add(cnt, 1u);
        XB_SPIN(xb_ld(cnt) < target, bar);
        __builtin_amdgcn_fence(__ATOMIC_ACQUIRE, "agent");
        asm volatile("s_waitcnt vmcnt(0)" ::: "memory");
    }
    __syncthreads();
}

__device__ __forceinline__ void grp_barrier(gu32* ctl, int vcu, unsigned target, volatile LAS unsigned* same_xcd) { sub_barrier(ctl, CW_GRP + 64 * (vcu >> 2), target, same_xcd); }
constexpr int CW_GRP16 = 12288;
struct PairOrder { int c; __device__ bool next(int i, pg8::Unit& u) const { if (i) return false; u.pm = c >> 1; u.pn = c & 1; return true; }
    __device__ __forceinline__ void a_ready(const pg8::Unit&) const {} __device__ __forceinline__ void done(const pg8::Unit&) const {} };

__global__ void __launch_bounds__(NWAVES * 64, 2) mk_fwd(Args args) {
    extern __shared__ __attribute__((aligned(16))) unsigned char lds[];
    Ctx C; C.lds = lds; C.tid = threadIdx.x; C.lane = C.tid & 63; C.wave = __builtin_amdgcn_readfirstlane(C.tid >> 6);
    C.G = gridDim.x; { const int bx = blockIdx.x; C.vcu = (C.G % 8 == 0) ? (bx % 8) * (C.G / 8) + bx / 8 : bx; }
    LAS unsigned char* lds3 = (LAS unsigned char*)lds;
    volatile LAS unsigned* MISC = (volatile LAS unsigned*)(lds3 + MISC_OFF);
    for (int u = C.tid; u < (LDS_BYTES - LDSCTL_OFF) / 4; u += NWAVES * 64) ((LAS unsigned*)(lds3 + LDSCTL_OFF))[u] = 0u;
    __syncthreads();
    unsigned char* ws = args.ws;
    gu32* ctl = (gu32*)(ws + WS_CTL);
    XcdBarrier bar; bar.bar = (unsigned*)(ctl + CW_BAR); bar.x = 0; bar.st = nullptr;
    if (N_LAUNCHES == 1) bar = xcd_barrier_post((unsigned*)(ctl + CW_BAR), MISC + 8);
    const bool merged23 = (N_LAUNCHES == 1) && C.G == 256;
    const bool grouped = (N_LAUNCHES == 1);
    if (grouped && C.tid == 0) __hip_atomic_store((unsigned*)ctl + CW_XID + C.vcu, xb_xcc_id() + 1u, RLX_AGENT);
    const int lo = args.ph_lo, hi = args.ph_hi;
#ifdef ONLY_PHASE
#define IN(k) ((k) == ONLY_PHASE && lo <= (k) && (k) < hi)
#else
#define IN(k) (lo <= (k) && (k) < hi)
#endif
#ifndef PROBE_XBAR
#define PROBE_XBAR 0
#endif
#define SEAM(k) do { if (IN(k) && IN((k) + 1)) { xcd_barrier(bar); if ((k) == 6) for (int xb_ = 0; xb_ < PROBE_XBAR; ++xb_) xcd_barrier(bar); } } while (0)
#define GSEAM(k, n) do { if (IN(k) && IN((k) + 1)) { if (grouped) grp_barrier(ctl, C.vcu, 4u * (n), MISC + 10); else xcd_barrier(bar); } } while (0)
#ifndef PROBE_MASK
#define PROBE_MASK 0
#endif
#define REPS(k) ((((PROBE_MASK) >> (k)) & 1) ? 2 : 1)
    bf16* xb = (bf16*)(ws + WS_XB);
    if (IN(0)) { for (int rep = 0; rep < REPS(0); ++rep) { p0_prologue(args, C); __syncthreads(); } SEAM(0); }
    if (grouped) { if (C.tid == 0) { const unsigned* xi = (const unsigned*)ctl + CW_XID + (C.vcu & ~3); const unsigned a0 = xb_ld((unsigned*)xi), a1 = xb_ld((unsigned*)xi + 1), a2 = xb_ld((unsigned*)xi + 2), a3 = xb_ld((unsigned*)xi + 3);
          MISC[10] = (a0 != 0u && a0 == a1 && a0 == a2 && a0 == a3) ? 1u : 2u;
          const unsigned* xj = (const unsigned*)ctl + CW_XID + (C.vcu & ~15); bool same16 = a0 != 0u;
          for (int i = 0; i < 16; ++i) same16 = same16 && (xb_ld((unsigned*)xj + i) == a0);
          MISC[11] = same16 ? 1u : 2u; }
        __syncthreads(); }
    if (IN(1)) for (int rep = 0; rep < REPS(1); ++rep) {
        pg8::Gemm g{xb, (const bf16*)(ws + WS_WIN0), M, EV_N - 512, DMODEL}; pg8::StaticOrder S; S.init(M, EV_N - 512, C.G, (int)blockIdx.x);
        pg8::EpiProj<0> E{(const float*)(ws + WS_RA0), (const float*)(ws + WS_ROPE), (bf16*)(ws + WS_QKV), nullptr, nullptr, (const float*)(ws + WS_GAIN), (float*)(ws + WS_KSUM), 0};
        pg8::gemm_phase<pg8::EpiProj<0>, pg8::StaticOrder, true, true>(lds3, g, S, E);
        if (rep + 1 == REPS(1)) SEAM(1); }
    if (IN(2)) {
        const int nr = C.G / 2;
        if (C.vcu < nr) { p2_route(args, C, C.vcu, nr);
            if (merged23) { sub_barrier(ctl, CW_GRP16 + 64 * (C.vcu >> 4), 16u, MISC + 11); const int hh = C.vcu >> 4;
                for (int idx = C.vcu & 15; idx < 62; idx += 16) p3_lists_item(args, C, hh + 8 * (idx / 31), idx % 31); } }
        else { pg8::Gemm g{xb, (const bf16*)(ws + WS_WIN0) + (size_t)(EV_N - 512) * DMODEL, M, 512, DMODEL}; PairOrder S{C.vcu - nr};
            pg8::EpiProj<0> E{(const float*)(ws + WS_RA0), (const float*)(ws + WS_ROPE), (bf16*)(ws + WS_QKV), nullptr, nullptr, (const float*)(ws + WS_GAIN), (float*)(ws + WS_KSUM), 12};
            pg8::gemm_phase<pg8::EpiProj<0>, PairOrder, true, true>(lds3, g, S, E); }
        SEAM(2); }
    if (IN(3) && !merged23) { for (int rep = 0; rep < REPS(3); ++rep) p3_lists(args, C); SEAM(3); }
    if (IN(4)) { for (int rep = 0; rep < REPS(4); ++rep) p4_attn_l0a(args, C); SEAM(4); }
    if (IN(5)) { for (int rep = 0; rep < REPS(5); ++rep) p5_attn_l0b(args, C); GSEAM(5, 1); }
    if (IN(6)) {
        pg8::Gemm g{(const bf16*)(ws + WS_AO), (const bf16*)(ws + WS_WOUT0), M, DMODEL, DMODEL};
        pg8::EpiResid E{args.in[0], args.out, xb, (float*)(ws + WS_RSP)};
        { GroupOrder S{4, C.vcu, C.G >> 2, M / 256}; pg8::gemm_phase<pg8::EpiResid, GroupOrder, true, true>(lds3, g, S, E); }
        GSEAM(6, 2); }
    if (IN(7)) for (int rep = 0; rep < REPS(7); ++rep) {
        pg8::Gemm g{xb, (const bf16*)(ws + WS_WQ0), M, DMODEL, DMODEL};
        pg8::EpiPeerQ E{(const float*)(ws + WS_RSP), (bf16*)(ws + WS_QP)};
        { GroupOrder S{4, C.vcu, C.G >> 2, M / 256}; pg8::gemm_phase<pg8::EpiPeerQ, GroupOrder, true, true>(lds3, g, S, E); }
        if (rep + 1 == REPS(7)) GSEAM(7, 3); }
    if (IN(8)) { peer_phase<false>(args, C, 0); GSEAM(8, 4); }
    if (IN(9)) for (int rep = 0; rep < REPS(9); ++rep) {
        pg8::Gemm g{xb, (const bf16*)(ws + WS_WIN1), M, OD_N, DMODEL};
        pg8::EpiProj<1> E{(const float*)(ws + WS_RA1), (const float*)(ws + WS_ROPE), (bf16*)(ws + WS_QKV), (bf16*)(ws + WS_QKV + 32 * MiB), (bf16*)(ws + WS_QKV + 36 * MiB), (const float*)(ws + WS_GAIN) + 256, nullptr, 0};
        { GroupOrder S{5, C.vcu, C.G >> 2, M / 256}; pg8::gemm_phase<pg8::EpiProj<1>, GroupOrder, true, true>(lds3, g, S, E); }
        if (CONV_L1_LATE == 2 && rep == 0) conv_pull(args, C, 1);
        if (rep + 1 == REPS(9)) SEAM(9); }
    if (IN(10)) { for (int rep = 0; rep < REPS(10); ++rep) p8_attn_l1(args, C); GSEAM(10, 5); }
    if (IN(11)) {
        pg8::Gemm g{(const bf16*)(ws + WS_AO), (const bf16*)(ws + WS_WOUT1), M, DMODEL, DMODEL};
        pg8::EpiResid E{args.out, args.out, xb, (float*)(ws + WS_RSP)};
        { GroupOrder S{4, C.vcu, C.G >> 2, M / 256}; pg8::gemm_phase<pg8::EpiResid, GroupOrder, true, true>(lds3, g, S, E); }
        GSEAM(11, 6); }
    if (IN(12)) for (int rep = 0; rep < REPS(12); ++rep) {
        pg8::Gemm g{xb, (const bf16*)(ws + WS_WQ1), M, DMODEL, DMODEL};
        pg8::EpiPeerQ E{(const float*)(ws + WS_RSP), (bf16*)(ws + WS_QP)};
        { GroupOrder S{4, C.vcu, C.G >> 2, M / 256}; pg8::gemm_phase<pg8::EpiPeerQ, GroupOrder, true, true>(lds3, g, S, E); }
        if (rep + 1 == REPS(12)) GSEAM(12, 7); }
    if (IN(13)) { peer_phase<true>(args, C, 1); }
#undef IN
#undef SEAM
}

extern "C" void kernel_launch(void* const* d_in, const int* in_sizes, int n_in, void* d_out, int out_size, void* d_ws, size_t ws_size, hipStream_t stream) {
    static int grid = 0;
    if (grid == 0) {
        if (n_in != 19 || in_sizes[0] != M * DMODEL || out_size != M * DMODEL || ws_size < WS_END) { fprintf(stderr, "kernel_launch: unexpected shapes (n_in %d, in0 %d, out %d, ws %zu); nothing launched\n", n_in, n_in > 0 ? in_sizes[0] : -1, out_size, ws_size); grid = -1; return; }
        int dev = 0, cus = 0, per_cu = 0;
        if (hipGetDevice(&dev) != hipSuccess || hipDeviceGetAttribute(&cus, hipDeviceAttributeMultiprocessorCount, dev) != hipSuccess) { grid = -1; return; }
        if (hipFuncSetAttribute((const void*)mk_fwd, hipFuncAttributeMaxDynamicSharedMemorySize, LDS_BYTES) != hipSuccess) { fprintf(stderr, "kernel_launch: hipFuncSetAttribute failed\n"); grid = -1; return; }
        if (hipOccupancyMaxActiveBlocksPerMultiprocessor(&per_cu, (const void*)mk_fwd, NWAVES * 64, LDS_BYTES) != hipSuccess || per_cu < 1) { fprintf(stderr, "kernel_launch: occupancy query reports %d workgroups per CU\n", per_cu); }
        (void)hipGetLastError();
        grid = cus > 256 ? 256 : (cus / 8) * 8;
        if (grid != 256) fprintf(stderr, "kernel_launch: %d CUs; the phase schedules assume 256\n", grid);
    }
    if (grid < 0) return;
    if (hipMemsetAsync((char*)d_ws + WS_CTL, 0, CTL_ZERO_BYTES, stream) != hipSuccess) { fprintf(stderr, "kernel_launch: hipMemsetAsync failed\n"); return; }
    Args a{};
    for (int i = 0; i < 19; ++i) a.in[i] = (const float*)d_in[i];
    a.out = (float*)d_out; a.ws = (unsigned char*)d_ws;
    for (int li = 0; li < N_LAUNCHES; ++li) {
        a.ph_lo = (N_LAUNCHES == 1) ? 0 : li; a.ph_hi = (N_LAUNCHES == 1) ? N_PHASES : li + 1; a.li = li;
        hipLaunchKernelGGL(mk_fwd, dim3(grid), dim3(NWAVES * 64), LDS_BYTES, stream, a);
        const hipError_t le = hipPeekAtLastError();
        if (le != hipSuccess) { fprintf(stderr, "kernel_launch: launch %d failed: %s\n", li, hipGetErrorName(le)); break; }
    }
}
```

```cpp
#define MK_N_LAUNCHES 1
#include <hip/hip_runtime.h>
#include <cstdio>
#include <cstdint>
namespace pg8 {
#define PG8_LAS __attribute__((address_space(3)))
typedef unsigned short bf16_t;
typedef short bf16x8 __attribute__((ext_vector_type(8)));
typedef float f32x4 __attribute__((ext_vector_type(4)));
typedef unsigned u32x4 __attribute__((ext_vector_type(4)));
constexpr int BM = 256, BK = 64, HALF = 128, HTB = HALF * BK * 2  , STAGE_BYTES = 8 * HTB, NXCD = 8, WGM = 8;

__host__ __device__ __forceinline__ int lds_byte(int r, int c) { const int st = (r >> 4) * 2 + (c >> 5), rr = r & 15, cc = c & 31, ob = rr * 64 + cc * 2; return st * 1024 + (ob ^ (((ob >> 9) & 1) << 5)); }
__host__ __device__ __forceinline__ void stage_rc(int b, int& R, int& C) { const int st = b / 1024, sb = b % 1024, swz = sb ^ (((sb >> 9) & 1) << 5); R = (st >> 1) * 16 + swz / 64; C = (st & 1) * 32 + (swz % 64) / 2; }
__host__ __device__ __forceinline__ int perm32(int rho) { const int n = rho >> 4, i = rho & 15; return 8 * (i >> 2) + 4 * n + (i & 3); }

struct Unit { int pm, pn; };
struct Gemm { const bf16_t* A; const bf16_t* Bt; int M, N, K; };

struct StaticOrder {
    int nM, nN, nwg, G, c;
    __host__ __device__ void init(int M, int N, int G_, int c_) { nM = M / BM; nN = N / BM; nwg = nM * nN; G = G_; c = c_; }
    __host__ __device__ bool next(int i, Unit& u) const {
        const long L = (long)i * G + c; if (L >= nwg) return false;
        int wgid = (int)L; { const int q = nwg / NXCD, r = nwg % NXCD, xcd = wgid % NXCD, off = wgid / NXCD; wgid = (xcd < r ? xcd * (q + 1) : r * (q + 1) + (xcd - r) * q) + off; }
        const int nig = WGM * nN, gid = wgid / nig, fm = gid * WGM, gsz = (nM - fm) < WGM ? (nM - fm) : WGM;
        u.pm = fm + ((wgid % nig) % gsz); u.pn = (wgid % nig) / gsz; return true;
    }
    __device__ __forceinline__ void a_ready(const Unit&) const {}
    __device__ __forceinline__ void done(const Unit&) const {}
};

__device__ __forceinline__ unsigned cvt_pk_bf16(float lo, float hi) { unsigned r; asm volatile("v_cvt_pk_bf16_f32 %0, %1, %2" : "=v"(r) : "v"(lo), "v"(hi)); return r; }
typedef float f32x2 __attribute__((ext_vector_type(2)));
__device__ __forceinline__ f32x2 gelu_pk(f32x2 v) {
    const f32x2 av = __builtin_elementwise_abs(v), d = av * 0.2316418882f + 1.0f;
    f32x2 t; t.x = __builtin_amdgcn_rcpf(d.x); t.y = __builtin_amdgcn_rcpf(d.y);
    f32x2 q = t * 0.5307027145f + (-0.7265760135f); q = q * t + 0.7107068705f; q = q * t + (-0.142248368f); q = q * t + 0.127414796f; q = q * t;
    const f32x2 s = (v * v) * (-0.72134752044f);
    f32x2 e; e.x = __builtin_amdgcn_exp2f(s.x); e.y = __builtin_amdgcn_exp2f(s.y);
    const f32x2 m = v * (q * e), r = v - m;
    f32x2 o; o.x = v.x < 0.f ? m.x : r.x; o.y = v.y < 0.f ? m.y : r.y; return o;
}

template <int ACT  > struct EpiBf16 {
    static constexpr bool PERM = true, AFTER_DRAIN = false; static_assert(ACT == 0 || ACT == 1, "EpiBf16: ACT is 0 (none) or 1 (gelu_pk)");
    bf16_t* O; int ldc; const float* bias; int split_cols; size_t split_stride; float scale0;
    __device__ __forceinline__ void operator()(const f32x4 (&acc)[2][2][4][2], const Unit& u, int wr, int wc, int fr, int fq) const {
        const int row0 = u.pm * BM + wr * 64 + fr; int colt = u.pn * BM; bf16_t* base = O;
        float sc = 1.f; if (split_cols) { const int t = colt / split_cols; base += (size_t)t * split_stride; colt -= t * split_cols; if (t == 0) sc = scale0; }
        const int col0 = colt + wc * 32 + 8 * fq, bcol0 = u.pn * BM + wc * 32 + 8 * fq;
        f32x4 bv[2][2];
#pragma unroll
        for (int bj = 0; bj < 2; ++bj)
#pragma unroll
            for (int n = 0; n < 2; ++n) bv[bj][n] = bias ? *(const f32x4*)(bias + bcol0 + bj * HALF + 4 * n) : (f32x4){0.f, 0.f, 0.f, 0.f};
#pragma unroll
        for (int ai = 0; ai < 2; ++ai)
#pragma unroll
            for (int m = 0; m < 4; ++m) { bf16_t* rowp = base + (size_t)(row0 + ai * HALF + m * 16) * ldc + col0;
#pragma unroll
                for (int bj = 0; bj < 2; ++bj) { f32x4 v0 = acc[ai][bj][m][0] + bv[bj][0], v1 = acc[ai][bj][m][1] + bv[bj][1];
                    if (ACT == 1) { f32x2 a = gelu_pk((f32x2){v0[0], v0[1]}), b = gelu_pk((f32x2){v0[2], v0[3]}), c = gelu_pk((f32x2){v1[0], v1[1]}), d = gelu_pk((f32x2){v1[2], v1[3]});
                        v0 = (f32x4){a.x, a.y, b.x, b.y}; v1 = (f32x4){c.x, c.y, d.x, d.y}; }
                    v0 = v0 * sc; v1 = v1 * sc; u32x4 w; w.x = cvt_pk_bf16(v0[0], v0[1]); w.y = cvt_pk_bf16(v0[2], v0[3]); w.z = cvt_pk_bf16(v1[0], v1[1]); w.w = cvt_pk_bf16(v1[2], v1[3]);
                    *(u32x4*)(rowp + bj * HALF) = w; } }
    }
};

template <class Epi, class Sched, bool ALIGN_EPI = false, bool SP2 = false>
__device__ __forceinline__ void gemm_phase(PG8_LAS unsigned char* lds, const Gemm g, const Sched& S, const Epi& E) {
    const int tid = threadIdx.x, wid = __builtin_amdgcn_readfirstlane(tid >> 6), lane = tid & 63, wr = wid >> 2, wc = wid & 3, fr = lane & 15, fq = lane >> 4;
    const int K = g.K, nt = K / BK;
    unsigned voffA[2], voffB[2];
#pragma unroll
    for (int i = 0; i < 2; ++i) { int R, C; stage_rc(tid * 16 + i * 8192, R, C); const int Rb = Epi::PERM ? ((R & ~31) + perm32(R & 31)) : R;
        voffA[i] = (unsigned)(R * K + C) * 2u; voffB[i] = (unsigned)(Rb * K + C) * 2u; }
    const size_t kstep = (size_t)(BK * 2);
    const size_t hstep = (size_t)HALF * K * 2;
    const size_t tstep = 2 * hstep;
    const unsigned ldsw = (unsigned)wid * 1024u;
    const int aoff = lds_byte(wr * 64 + fr, fq * 8), boff = lds_byte(wc * 32 + fr, fq * 8);
#define PG8_SA(b, h) (((b) * 2 + (h)) * HTB)
#define PG8_SB(b, h) ((4 + (b) * 2 + (h)) * HTB)
#define PG8_STAGE(bufoff, gbase, voff) do { _Pragma("unroll") for (int _i = 0; _i < 2; ++_i) \
        __builtin_amdgcn_global_load_lds((const unsigned*)((const char*)(gbase) + (voff)[_i]), (PG8_LAS unsigned*)(lds + (bufoff) + ldsw + _i * 8192), 16, 0, 0); } while (0)
#define PG8_LDA(dst, b, h) do { _Pragma("unroll") for (int m = 0; m < 4; ++m) _Pragma("unroll") for (int k = 0; k < 2; ++k) dst[m][k] = *(const PG8_LAS bf16x8*)(lds + PG8_SA(b, h) + aoff + m * 2048 + k * 1024); } while (0)
#define PG8_LDB(dst, b, h) do { _Pragma("unroll") for (int n = 0; n < 2; ++n) _Pragma("unroll") for (int k = 0; k < 2; ++k) dst[n][k] = *(const PG8_LAS bf16x8*)(lds + PG8_SB(b, h) + boff + n * 2048 + k * 1024); } while (0)
#define PG8_MMA(ai, bj, At, Bt) do { __builtin_amdgcn_s_setprio(1); _Pragma("unroll") for (int m = 0; m < 4; ++m) _Pragma("unroll") for (int n = 0; n < 2; ++n) _Pragma("unroll") for (int k = 0; k < 2; ++k) \
        acc[ai][bj][m][n] = __builtin_amdgcn_mfma_f32_16x16x32_bf16(Bt[n][k], At[m][k], acc[ai][bj][m][n], 0, 0, 0); __builtin_amdgcn_s_setprio(0); } while (0)
#define PG8_WAIT_V(n) asm volatile("s_waitcnt vmcnt(" #n ")" ::: "memory")
#define PG8_WAIT_L(n) asm volatile("s_waitcnt lgkmcnt(" #n ")" ::: "memory")
#define PG8_BAR __builtin_amdgcn_s_barrier()
#define PG8_SCHED __builtin_amdgcn_sched_barrier(0)
    Unit cur, nxt; int ui = 0;
    if (!S.next(0, cur)) return;
    f32x4 acc[2][2][4][2];
#pragma unroll
    for (int a = 0; a < 2; ++a)
#pragma unroll
        for (int b = 0; b < 2; ++b)
#pragma unroll
            for (int m = 0; m < 4; ++m)
#pragma unroll
                for (int n = 0; n < 2; ++n) acc[a][b][m][n] = (f32x4){0.f, 0.f, 0.f, 0.f};
    bf16x8 At[4][2], B0[2][2], B1[2][2];
    const char* cA = (const char*)g.A + (size_t)cur.pm * tstep; const char* cB = (const char*)g.Bt + (size_t)cur.pn * tstep;
    S.a_ready(cur);
    if constexpr (SP2) {
        PG8_STAGE(PG8_SB(0, 0), cB, voffB); PG8_STAGE(PG8_SB(0, 1), cB + hstep, voffB); PG8_STAGE(PG8_SA(0, 0), cA, voffA); PG8_STAGE(PG8_SA(0, 1), cA + hstep, voffA);
        if (wr == 1) PG8_BAR;
        PG8_WAIT_V(2); PG8_BAR;
        PG8_STAGE(PG8_SB(1, 0), cB + kstep, voffB); PG8_STAGE(PG8_SA(1, 0), cA + kstep, voffA); PG8_STAGE(PG8_SB(1, 1), cB + hstep + kstep, voffB);
        PG8_WAIT_V(6); PG8_BAR;
    } else {
        PG8_STAGE(PG8_SB(0, 0), cB, voffB); PG8_STAGE(PG8_SA(0, 0), cA, voffA); PG8_STAGE(PG8_SB(0, 1), cB + hstep, voffB); PG8_STAGE(PG8_SA(0, 1), cA + hstep, voffA);
        if (wr == 1) PG8_BAR;
        PG8_WAIT_V(4); PG8_BAR;
        PG8_STAGE(PG8_SB(1, 0), cB + kstep, voffB); PG8_STAGE(PG8_SA(1, 0), cA + kstep, voffA); PG8_STAGE(PG8_SB(1, 1), cB + hstep + kstep, voffB);
        PG8_WAIT_V(6); PG8_BAR;
    }
    for (;;) {
        const bool has_next = S.next(ui + 1, nxt);
        const char* nA = has_next ? (const char*)g.A + (size_t)nxt.pm * tstep : cA; const char* nB = has_next ? (const char*)g.Bt + (size_t)nxt.pn * tstep : cB;
        for (int t = 0; t < nt; t += 2) {
            const bool last = (t == nt - 2);
            const char* a1 = cA + (size_t)(t + 1) * kstep;
            const char* a2 = last ? nA : cA + (size_t)(t + 2) * kstep; const char* b2 = last ? nB : cB + (size_t)(t + 2) * kstep;
            const char* a3 = a2 + kstep; const char* b3 = b2 + kstep;
            if (last && has_next) S.a_ready(nxt);
            if constexpr (SP2) {
            PG8_LDB(B0, 0, 0); PG8_LDB(B1, 0, 1); PG8_SCHED; PG8_LDA(At, 0, 0); PG8_STAGE(PG8_SA(1, 1), a1 + hstep, voffA);
            PG8_WAIT_V(8); PG8_WAIT_L(0); PG8_BAR; PG8_MMA(0, 0, At, B0); PG8_MMA(0, 1, At, B1); PG8_BAR; PG8_SCHED;
            PG8_LDA(At, 0, 1); PG8_STAGE(PG8_SB(0, 0), b2, voffB); PG8_STAGE(PG8_SB(0, 1), b2 + hstep, voffB); PG8_STAGE(PG8_SA(0, 0), a2, voffA);
            PG8_WAIT_V(8); PG8_WAIT_L(0); PG8_BAR; PG8_MMA(1, 0, At, B0); PG8_MMA(1, 1, At, B1); PG8_BAR; PG8_SCHED;
            PG8_LDB(B0, 1, 0); PG8_LDB(B1, 1, 1); PG8_SCHED; PG8_LDA(At, 1, 0); PG8_STAGE(PG8_SA(0, 1), a2 + hstep, voffA);
            PG8_WAIT_V(8); PG8_WAIT_L(0); PG8_BAR; PG8_MMA(0, 0, At, B0); PG8_MMA(0, 1, At, B1); PG8_BAR; PG8_SCHED;
            PG8_LDA(At, 1, 1); PG8_STAGE(PG8_SB(1, 0), b3, voffB); PG8_STAGE(PG8_SB(1, 1), b3 + hstep, voffB); PG8_STAGE(PG8_SA(1, 0), a3, voffA);
            PG8_WAIT_V(8); PG8_WAIT_L(0); PG8_BAR; PG8_MMA(1, 0, At, B0); PG8_MMA(1, 1, At, B1); PG8_BAR; PG8_SCHED;
            } else {
            PG8_LDB(B0, 0, 0); PG8_SCHED; PG8_LDA(At, 0, 0); PG8_STAGE(PG8_SA(1, 1), a1 + hstep, voffA);
            PG8_WAIT_L(8); PG8_BAR; PG8_WAIT_L(0); PG8_MMA(0, 0, At, B0); PG8_BAR; PG8_SCHED;
            PG8_LDB(B1, 0, 1); PG8_STAGE(PG8_SB(0, 0), b2, voffB);
            PG8_BAR; PG8_WAIT_L(0); PG8_MMA(0, 1, At, B1); PG8_BAR;
            PG8_LDA(At, 0, 1); PG8_STAGE(PG8_SA(0, 0), a2, voffA);
            PG8_BAR; PG8_WAIT_L(0); PG8_MMA(1, 0, At, B0); PG8_BAR; PG8_SCHED;
            PG8_STAGE(PG8_SB(0, 1), b2 + hstep, voffB);
            PG8_WAIT_V(6); PG8_BAR; PG8_MMA(1, 1, At, B1); PG8_BAR;
            PG8_LDB(B0, 1, 0); PG8_SCHED; PG8_LDA(At, 1, 0); PG8_STAGE(PG8_SA(0, 1), a2 + hstep, voffA);
            PG8_WAIT_L(8); PG8_BAR; PG8_WAIT_L(0); PG8_MMA(0, 0, At, B0); PG8_BAR; PG8_SCHED;
            PG8_LDB(B1, 1, 1); PG8_STAGE(PG8_SB(1, 0), b3, voffB);
            PG8_BAR; PG8_WAIT_L(0); PG8_MMA(0, 1, At, B1); PG8_BAR;
            PG8_LDA(At, 1, 1); PG8_STAGE(PG8_SA(1, 0), a3, voffA);
            PG8_BAR; PG8_WAIT_L(0); PG8_MMA(1, 0, At, B0); PG8_BAR; PG8_SCHED;
            PG8_STAGE(PG8_SB(1, 1), b3 + hstep, voffB);
            PG8_WAIT_V(6); PG8_BAR; PG8_MMA(1, 1, At, B1); PG8_BAR;
            }
        }
        if constexpr (ALIGN_EPI) { if (wr == 0) PG8_BAR; }
        if constexpr (!Epi::AFTER_DRAIN) { E(acc, cur, wr, wc, fr, fq); S.done(cur); }
        if (!has_next) break;
#pragma unroll
        for (int a = 0; a < 2; ++a)
#pragma unroll
            for (int b = 0; b < 2; ++b)
#pragma unroll
                for (int m = 0; m < 4; ++m)
#pragma unroll
                    for (int n = 0; n < 2; ++n) acc[a][b][m][n] = (f32x4){0.f, 0.f, 0.f, 0.f};
        cur = nxt; cA = nA; cB = nB; ++ui;
        if constexpr (ALIGN_EPI) { if (wr == 1) PG8_BAR; }
    }
    PG8_WAIT_V(0);
    if constexpr (!ALIGN_EPI) { if (wr == 0) PG8_BAR; }
    PG8_BAR;
    if constexpr (Epi::AFTER_DRAIN) { E.fused(acc, cur, wr, wc, fr, fq, lds, wid, lane); S.done(cur); }
#undef PG8_SA
#undef PG8_SB
#undef PG8_STAGE
#undef PG8_LDA
#undef PG8_LDB
#undef PG8_MMA
#undef PG8_WAIT_V
#undef PG8_WAIT_L
#undef PG8_BAR
#undef PG8_SCHED
}
}
namespace pg8 {
typedef unsigned u32x2 __attribute__((ext_vector_type(2)));
constexpr float RMS_EPS = 1e-6f;
constexpr float QC2 = 0.125f * 1.4426950408889634f;
constexpr int MROWS = 16384;

template <int LAYER> struct EpiProj {
    static constexpr bool PERM = true, AFTER_DRAIN = false;
    const float* rrow; const float* cs; bf16_t* base; bf16_t* k1; bf16_t* v1; const float* gains; float* ksum; int pn_off;
    __device__ __forceinline__ void operator()(const f32x4 (&acc)[2][2][4][2], const Unit& u, int wr, int wc, int fr, int fq) const {
        int kind; bf16_t* dst; int pitch, col, head = 0; const float* gain;
        if (LAYER == 0) { const int pnx = u.pn + pn_off; const int grp = pnx >> 1; head = (pnx & 1) * 4 + wc; dst = base + (size_t)grp * ((size_t)MROWS * 512); pitch = 512; col = head * 64 + 16 * fq;
            kind = grp == 0 ? (1 | 2 | 4) : grp == 1 ? (1 | 2 | 16) : grp == 3 ? (1 | 4) : grp == 4 ? 1 : grp == 6 ? 8 : 0;
            gain = gains + 64 * (grp == 0 ? 0 : grp == 1 ? 1 : grp == 3 ? 2 : 3); }
        else { if (u.pn < 4) { dst = base; pitch = 1024; col = (u.pn * 4 + wc) * 64 + 16 * fq; kind = 1 | 2 | 4; gain = gains; }
               else if (wc < 2) { dst = k1; pitch = 128; col = wc * 64 + 16 * fq; kind = 1 | 2; gain = gains + 64; }
               else { dst = v1; pitch = 128; col = (wc - 2) * 64 + 16 * fq; kind = 0; gain = gains + 64; } }
        f32x4 gv[2][2];
#pragma unroll
        for (int bj = 0; bj < 2; ++bj)
#pragma unroll
            for (int n = 0; n < 2; ++n) gv[bj][n] = *(const f32x4*)(gain + 16 * fq + 8 * bj + 4 * n);
        f32x4 ks[2][2];
#pragma unroll
        for (int bj = 0; bj < 2; ++bj)
#pragma unroll
            for (int n = 0; n < 2; ++n) ks[bj][n] = (f32x4){0.f, 0.f, 0.f, 0.f};
#pragma unroll
        for (int ai = 0; ai < 2; ++ai)
#pragma unroll
            for (int m = 0; m < 4; ++m) {
                const int row = u.pm * BM + ai * HALF + wr * 64 + m * 16 + fr; const float rs = rrow[row];
                f32x4 v[2][2];
#pragma unroll
                for (int bj = 0; bj < 2; ++bj)
#pragma unroll
                    for (int n = 0; n < 2; ++n) v[bj][n] = acc[ai][bj][m][n] * rs;
                if (kind & 1) { float ss = 0.f;
#pragma unroll
                    for (int bj = 0; bj < 2; ++bj)
#pragma unroll
                        for (int n = 0; n < 2; ++n) { const f32x4 x = v[bj][n]; ss += (x[0] * x[0] + x[1] * x[1]) + (x[2] * x[2] + x[3] * x[3]); }
                    ss += __shfl_xor(ss, 16); ss += __shfl_xor(ss, 32);
                    const float ri = 1.0f / sqrtf(ss * (1.0f / 64.0f) + RMS_EPS);
#pragma unroll
                    for (int bj = 0; bj < 2; ++bj)
#pragma unroll
                        for (int n = 0; n < 2; ++n) v[bj][n] = (v[bj][n] * ri) * gv[bj][n]; }
                if ((kind & 2) && fq == 0) { const float* cp = cs + (size_t)(row & 8191) * 16;
#pragma unroll
                    for (int n = 0; n < 2; ++n) { const f32x4 c = *(const f32x4*)(cp + 4 * n), s = *(const f32x4*)(cp + 8 + 4 * n); const f32x4 x1 = v[0][n], x2 = v[1][n];
                        v[0][n] = x1 * c - x2 * s; v[1][n] = x2 * c + x1 * s; } }
                if (kind & 16) {
#pragma unroll
                    for (int bj = 0; bj < 2; ++bj)
#pragma unroll
                        for (int n = 0; n < 2; ++n) ks[bj][n] += v[bj][n]; }
                if (kind & 4) {
#pragma unroll
                    for (int bj = 0; bj < 2; ++bj)
#pragma unroll
                        for (int n = 0; n < 2; ++n) v[bj][n] = v[bj][n] * QC2; }
                if (kind & 8) {
#pragma unroll
                    for (int bj = 0; bj < 2; ++bj)
#pragma unroll
                        for (int n = 0; n < 2; ++n)
#pragma unroll
                            for (int j = 0; j < 4; ++j) v[bj][n][j] = 1.0f / (1.0f + __expf(-v[bj][n][j])); }
                bf16_t* rp = dst + (size_t)row * pitch + col;
#pragma unroll
                for (int bj = 0; bj < 2; ++bj) { u32x4 w; w.x = cvt_pk_bf16(v[bj][0][0], v[bj][0][1]); w.y = cvt_pk_bf16(v[bj][0][2], v[bj][0][3]); w.z = cvt_pk_bf16(v[bj][1][0], v[bj][1][1]); w.w = cvt_pk_bf16(v[bj][1][2], v[bj][1][3]);
                    *(u32x4*)(rp + 8 * bj) = w; }
            }
        if (LAYER == 0 && (kind & 16)) {
#pragma unroll
            for (int bj = 0; bj < 2; ++bj)
#pragma unroll
                for (int n = 0; n < 2; ++n)
#pragma unroll
                    for (int j = 0; j < 4; ++j) { float s = ks[bj][n][j]; s += __shfl_xor(s, 1); s += __shfl_xor(s, 2); s += __shfl_xor(s, 4); s += __shfl_xor(s, 8); ks[bj][n][j] = s; }
            if (fr == 0) { float* kp = ksum + ((size_t)((u.pm * 2 + wr) * 8 + head)) * 64 + 16 * fq;
#pragma unroll
                for (int bj = 0; bj < 2; ++bj)
#pragma unroll
                    for (int n = 0; n < 2; ++n) *(f32x4*)(kp + 8 * bj + 4 * n) = ks[bj][n]; }
        }
    }
};

struct EpiResid {
    static constexpr bool PERM = false, AFTER_DRAIN = false;
    const float* xin; float* xout; bf16_t* xb; float* rsp;
    __device__ __forceinline__ void operator()(const f32x4 (&acc)[2][2][4][2], const Unit& u, int wr, int wc, int fr, int fq) const {
        const int col0 = u.pn * BM + wc * 32 + 4 * fq;
#pragma unroll
        for (int ai = 0; ai < 2; ++ai)
#pragma unroll
            for (int m = 0; m < 4; ++m) { const int row = u.pm * BM + ai * HALF + wr * 64 + m * 16 + fr; float ss = 0.f;
#pragma unroll
                for (int bj = 0; bj < 2; ++bj)
#pragma unroll
                    for (int n = 0; n < 2; ++n) { const size_t off = (size_t)row * 1024 + col0 + bj * HALF + n * 16;
                        const f32x4 o = *(const f32x4*)(xin + off) + acc[ai][bj][m][n]; *(f32x4*)(xout + off) = o;
                        ss += (o[0] * o[0] + o[1] * o[1]) + (o[2] * o[2] + o[3] * o[3]);
                        u32x2 w; w.x = cvt_pk_bf16(o[0], o[1]); w.y = cvt_pk_bf16(o[2], o[3]); *(u32x2*)(xb + off) = w; }
                ss += __shfl_xor(ss, 16); ss += __shfl_xor(ss, 32);
                if (fq == 0) rsp[(size_t)row * 16 + u.pn * 4 + wc] = ss; }
    }
};

struct EpiPeerQ {
    static constexpr bool PERM = true, AFTER_DRAIN = false;
    const float* rsp; bf16_t* qp;
    __device__ __forceinline__ void operator()(const f32x4 (&acc)[2][2][4][2], const Unit& u, int wr, int wc, int fr, int fq) const {
        const int col0 = u.pn * BM + wc * 32 + 8 * fq;
#pragma unroll
        for (int ai = 0; ai < 2; ++ai)
#pragma unroll
            for (int m = 0; m < 4; ++m) { const int row = u.pm * BM + ai * HALF + wr * 64 + m * 16 + fr;
                const f32x4 a = *(const f32x4*)(rsp + (size_t)row * 16), b = *(const f32x4*)(rsp + (size_t)row * 16 + 4), c = *(const f32x4*)(rsp + (size_t)row * 16 + 8), d = *(const f32x4*)(rsp + (size_t)row * 16 + 12);
                const float ss = ((a[0] + a[1]) + (a[2] + a[3])) + ((b[0] + b[1]) + (b[2] + b[3])) + ((c[0] + c[1]) + (c[2] + c[3])) + ((d[0] + d[1]) + (d[2] + d[3]));
                const float rs = 1.0f / sqrtf(ss * (1.0f / 1024.0f) + RMS_EPS);
                bf16_t* rp = qp + (size_t)row * 1024 + col0;
#pragma unroll
                for (int bj = 0; bj < 2; ++bj) { const f32x4 v0 = acc[ai][bj][m][0] * rs, v1 = acc[ai][bj][m][1] * rs; u32x4 w; w.x = cvt_pk_bf16(v0[0], v0[1]); w.y = cvt_pk_bf16(v0[2], v0[3]); w.z = cvt_pk_bf16(v1[0], v1[1]); w.w = cvt_pk_bf16(v1[2], v1[3]);
                    *(u32x4*)(rp + bj * HALF) = w; } }
    }
};
}
#include <hip/hip_bf16.h>
#include <cmath>
namespace attn_body {
using bf16=__hip_bfloat16;
using bf16x8=__attribute__((ext_vector_type(8)))short;
using s16x4=__attribute__((ext_vector_type(4)))short;
using f32x16=__attribute__((ext_vector_type(16)))float;
using u32x4=__attribute__((ext_vector_type(4)))unsigned;
constexpr int BATCH=2,SEQ=8192,D=64;
constexpr int NW=8,QBLK=32,QB=QBLK*NW,KVBLK=64,NQB=SEQ/QB;
constexpr int ATTN_UNIT_ROWS=QB;
__device__ __forceinline__ int crow(int r,int hi){return (r&3)+8*(r>>2)+4*hi;}
#define SBAR() __builtin_amdgcn_sched_barrier(0)
typedef __attribute__((address_space(3))) const float* lds_cfptr;
typedef float f32x4a __attribute__((ext_vector_type(4)));
__device__ __forceinline__ float badd_s(float a,float b){float r;asm("v_add_f32_e32 %0, %1, %2":"=v"(r):"v"(a),"v"(b));return r;}
template<int VAR,bool BAND> __device__ __forceinline__ void bias_tile(f32x16&p0,f32x16&p1,int t,int jb,int qrel,int hi,lds_cfptr ftab,unsigned selm,int t0,float negs){
  const float NEG=-INFINITY;
  if(VAR==1){ const lds_cfptr f=ftab+64*t+4*hi;
    #pragma unroll
    for(int g=0;g<4;++g){ const f32x4a a=*(const __attribute__((address_space(3))) f32x4a*)(f+8*g); const f32x4a c=*(const __attribute__((address_space(3))) f32x4a*)(f+32+8*g);
      #pragma unroll
      for(int j=0;j<4;++j){p0[4*g+j]+=negs-a[j];p1[4*g+j]+=negs-c[j];} } }
  else { float s=negs;
    if(VAR==0){ if(!BAND||jb<0){ const bool ok=((selm>>((t0+t)>>2))&1u)!=0u; s=ok?negs:NEG; } }
    #pragma unroll
    for(int r=0;r<16;++r){p0[r]+=s;p1[r]+=s;} }
  if(BAND){
    if(VAR==2){ const int kb=64*jb+4*hi;
      #pragma unroll
      for(int r=0;r<16;++r){const int kv=kb+(r&3)+8*(r>>2); if(kv>qrel||kv<=qrel-128)p0[r]=NEG; if(kv+32>qrel||kv+32<=qrel-128)p1[r]=NEG;} }
    else if(jb>=0&&VAR!=3){ const int kb=64*jb+4*hi;
      #pragma unroll
      for(int r=0;r<16;++r){const int kv=kb+(r&3)+8*(r>>2); if(kv>qrel)p0[r]=NEG; if(kv+32>qrel)p1[r]=NEG;} }
  }
}
struct UnitArgs { const bf16*Q; const bf16*K; const bf16*V; bf16*O; int qcol,kcol,ocol; const float*Fl2; const bf16*gate; const unsigned*sel; const float*sinkp; float bl2x2; const unsigned short*glist; int gn; bf16*PO; float*LSE; int kvres; };

constexpr int NSLOT=3, SLOTB=8192;
constexpr int LDS_K=0, LDS_V=NSLOT*SLOTB, LDS_WS=2*NSLOT*SLOTB, LDS_OST=LDS_WS+NW*256*4, LDS_F=90112, LDS_BYTES=LDS_F+SEQ*4;
constexpr float C2=0.125f*1.4426950408889634f;
__device__ __forceinline__ void glds16(const void*gsrc,unsigned lds_dst){unsigned keep;
  asm volatile("s_mov_b32 %0, m0\n\ts_mov_b32 m0, %2\n\ts_nop 0\n\tglobal_load_lds_dwordx4 %1, off\n\ts_mov_b32 m0, %0":"=&s"(keep):"v"(gsrc),"s"(lds_dst):"memory");}
__device__ __forceinline__ float max3f(float a,float b,float c){float r;asm("v_max3_f32 %0, %1, %2, %3":"=v"(r):"v"(a),"v"(b),"v"(c));return r;}
__device__ __forceinline__ float max2f(float a,float b){float r;asm("v_max_f32_e32 %0, %1, %2":"=v"(r):"v"(a),"v"(b));return r;}
__device__ __forceinline__ float fadd_s(float a,float b){float r;asm("v_add_f32_e32 %0, %1, %2":"=v"(r):"v"(a),"v"(b));return r;}
__device__ __forceinline__ float fsub_s(float a,float b){float r;asm("v_sub_f32_e32 %0, %1, %2":"=v"(r):"v"(a),"v"(b));return r;}
typedef float f32x2_t __attribute__((ext_vector_type(2))); typedef __bf16 bf16x2_t __attribute__((ext_vector_type(2)));
__device__ __forceinline__ unsigned cvtpk_s(float lo,float hi){f32x2_t v={lo,hi};bf16x2_t b=__builtin_convertvector(v,bf16x2_t);return __builtin_bit_cast(unsigned,b);}
#define WAIT_BAR(N) asm volatile("s_waitcnt vmcnt(" #N ") lgkmcnt(0)\n\ts_barrier":::"memory")

__device__ __forceinline__ void qkt(f32x16&p0,f32x16&p1,const char*Kslot,const bf16x8*qr,const f32x16&negm,int r32,int hi){
  const char*kb=Kslot+hi*1024+r32*16;
  #pragma unroll
  for(int d0=0;d0<4;++d0){
    const bf16x8 b0=*reinterpret_cast<const bf16x8*>(kb+d0*2048);
    const bf16x8 b1=*reinterpret_cast<const bf16x8*>(kb+d0*2048+512);
    if(d0==0){p0=__builtin_amdgcn_mfma_f32_32x32x16_bf16(b0,qr[0],negm,0,0,0);p1=__builtin_amdgcn_mfma_f32_32x32x16_bf16(b1,qr[0],negm,0,0,0);}
    else{p0=__builtin_amdgcn_mfma_f32_32x32x16_bf16(b0,qr[d0],p0,0,0,0);p1=__builtin_amdgcn_mfma_f32_32x32x16_bf16(b1,qr[d0],p1,0,0,0);}}
}
typedef __attribute__((address_space(3))) const char* lds_cptr;
typedef short v4i16_t __attribute__((ext_vector_type(4)));
__device__ __forceinline__ void kload8(bf16x8*kf,lds_cptr kp){
  kf[0]=*(const __attribute__((address_space(3))) bf16x8*)(kp);      kf[1]=*(const __attribute__((address_space(3))) bf16x8*)(kp+512);
  kf[2]=*(const __attribute__((address_space(3))) bf16x8*)(kp+2048); kf[3]=*(const __attribute__((address_space(3))) bf16x8*)(kp+2560);
  kf[4]=*(const __attribute__((address_space(3))) bf16x8*)(kp+4096); kf[5]=*(const __attribute__((address_space(3))) bf16x8*)(kp+4608);
  kf[6]=*(const __attribute__((address_space(3))) bf16x8*)(kp+6144); kf[7]=*(const __attribute__((address_space(3))) bf16x8*)(kp+6656);
}
__device__ __forceinline__ void kload2(bf16x8*kf,lds_cptr kp,int j){ kf[2*j]=*(const __attribute__((address_space(3))) bf16x8*)(kp+j*2048); kf[2*j+1]=*(const __attribute__((address_space(3))) bf16x8*)(kp+j*2048+512); }
__device__ __forceinline__ s16x4 vtr(lds_cptr p){ return __builtin_bit_cast(s16x4,__builtin_amdgcn_ds_read_tr16_b64_v4i16((__attribute__((address_space(3))) v4i16_t*)p)); }
__device__ __forceinline__ float rowmax(const f32x16&p0,const f32x16&p1){
  float a=max3f(p0[0],p0[1],p1[0]),b=max3f(p0[2],p0[3],p1[1]);a=max3f(a,p1[2],p1[3]);
  #pragma unroll
  for(int r=4;r<16;r+=4){a=max3f(a,p0[r],p0[r+1]);b=max3f(b,p0[r+2],p0[r+3]);a=max3f(a,p1[r],p1[r+1]);b=max3f(b,p1[r+2],p1[r+3]);}
  const float m=max2f(a,b);
  auto rr=__builtin_amdgcn_permlane32_swap(__float_as_uint(m),__float_as_uint(m),false,false);
  return max2f(__uint_as_float(rr[0]),__uint_as_float(rr[1]));
}
__device__ __forceinline__ void pv(f32x16*o,int vb,bf16x8 pa0,bf16x8 pa1,bf16x8 pa2,bf16x8 pa3){
  #pragma unroll
  for(int d0=0;d0<2;++d0){s16x4 lo[4],hi[4];
    #pragma unroll
    for(int ks=0;ks<4;++ks){
      asm volatile("ds_read_b64_tr_b16 %0,%1 offset:%c2":"=&v"(lo[ks]):"v"(vb),"i"(d0*4096+ks*1024):"memory");
      asm volatile("ds_read_b64_tr_b16 %0,%1 offset:%c2":"=&v"(hi[ks]):"v"(vb),"i"(d0*4096+ks*1024+512):"memory");}
    asm volatile("s_waitcnt lgkmcnt(0)":::"memory");SBAR();
    #define PK(k) (bf16x8){lo[k][0],lo[k][1],lo[k][2],lo[k][3],hi[k][0],hi[k][1],hi[k][2],hi[k][3]}
    o[d0]=__builtin_amdgcn_mfma_f32_32x32x16_bf16(pa0,PK(0),o[d0],0,0,0);
    o[d0]=__builtin_amdgcn_mfma_f32_32x32x16_bf16(pa1,PK(1),o[d0],0,0,0);
    o[d0]=__builtin_amdgcn_mfma_f32_32x32x16_bf16(pa2,PK(2),o[d0],0,0,0);
    o[d0]=__builtin_amdgcn_mfma_f32_32x32x16_bf16(pa3,PK(3),o[d0],0,0,0);
    #undef PK
  }
}

#ifndef ATTN_STORE16
#define ATTN_STORE16(p,v) (*(u32x4*)(p)=(v))
#endif
template<int VAR,int THRL,int DMQ,int DMK,int DMO> __device__ __forceinline__ void attn_unit(int b,int qb,const UnitArgs&A,char*shm){
  int tid_=threadIdx.x; asm volatile("":"+v"(tid_)); const int tid=tid_,lane=tid&63,r32=lane&31,hi=lane>>5; const int wid=__builtin_amdgcn_readfirstlane(tid>>6);
  const long rowbase=(long)b*SEQ; const int q0=qb*QB;
  const lds_cptr shm3=(lds_cptr)shm;
  int t0=0, NT=4*qb+4; float rowc=0.f; unsigned selm=0u;
  if(VAR==2){ t0=qb?4*qb-2:0; NT=qb?6:4; }
  if(VAR==3||VAR==4){ t0=4*qb; NT=4; }
  int gpos=q0+wid*QBLK+r32; bool gvalid=true;
  if(VAR==3){ const int gi=wid*QBLK+r32; gvalid=gi<A.gn; gpos=(int)A.glist[gvalid?gi:0]; }
  if(VAR==4){ selm=A.sel[gpos]; }
  if(VAR==0){ selm=A.sel[q0+wid*QBLK+r32]; asm volatile("":"+s"(NT)); }
  if(VAR==1){ const float fq0=A.Fl2[q0]; const int ntile=4*qb+4;
    const bool k0=(lane<ntile)?(A.bl2x2+fq0-A.Fl2[64*lane+63]>=-160.f):true;
    const bool k1=(lane+64<ntile)?(A.bl2x2+fq0-A.Fl2[64*(lane+64)+63]>=-160.f):true;
    const unsigned long long m0=__ballot(k0), m1=__ballot(k1);
    int first=m0?(int)__builtin_ctzll(m0):64+(int)__builtin_ctzll(m1|(1ull<<63));
    first&=~1; if(first>4*qb)first=4*qb;
    t0=__builtin_amdgcn_readfirstlane(first); NT=4*qb+4-t0;
    __attribute__((address_space(3))) float*ft=(__attribute__((address_space(3))) float*)(shm3+LDS_F);
    for(int i=tid;i<64*NT;i+=NW*64)ft[i]=A.Fl2[64*t0+i]-fq0;
    rowc=A.Fl2[q0+wid*QBLK+r32]-fq0;
    asm volatile("s_waitcnt vmcnt(0) lgkmcnt(0)\n\ts_barrier":::"memory");
  }
  const lds_cfptr ftab=(lds_cfptr)(shm3+LDS_F);
  const bf16*Qrow=A.Q+(rowbase+gpos)*DMQ+A.qcol;
  const bf16*Kh=A.K+(rowbase+(long)t0*KVBLK)*DMK+A.kcol,*Vh=A.V+(rowbase+(long)t0*KVBLK)*DMK+A.kcol;
  const unsigned lds0=(unsigned)(uintptr_t)shm;
  constexpr bool RES=(VAR>=3); constexpr int NSL=RES?4:3, LV=NSL*SLOTB, LWS=2*NSL*SLOTB, LOST=LWS+NW*256*4;
  float*wsf=(float*)(shm+LWS)+wid*256;
  const bf16*ksrc=Kh+(long)lane*DMK+wid*8;
  const bf16*vsrc=Vh+(long)(16*(wid&3)+(lane>>2))*DMK+(wid>>2)*32+(lane&3)*8;
  const unsigned kdst=lds0+LDS_K+wid*1024, vdst=lds0+LV+wid*1024;
  #define DMA_K(t,slot) glds16(ksrc+(long)(t)*KVBLK*DMK,(unsigned)__builtin_amdgcn_readfirstlane(kdst+(slot)))
  #define DMA_V(t,slot) glds16(vsrc+(long)(t)*KVBLK*DMK,(unsigned)__builtin_amdgcn_readfirstlane(vdst+(slot)))
  const int vb0=(int)(lds0+LV)+((lane>>4)&1)*32+(lane&3)*8+(4*hi+((lane&15)>>2))*64;
  const char*Kbase=shm+LDS_K; bf16x8 kf[8];
  const lds_cptr kp0=shm3+LDS_K+hi*1024+r32*16; const lds_cptr vp0=shm3+LV+((lane>>4)&1)*32+(lane&3)*8+(4*hi+((lane&15)>>2))*64;
  const bool kvres=(VAR==3)&&A.kvres;
  if(!kvres){DMA_K(0,0);DMA_V(0,0);DMA_K(1,SLOTB); if(RES){DMA_V(1,SLOTB);}}
  bf16x8 qr[4];
  #pragma unroll
  for(int d0=0;d0<4;++d0)qr[d0]=*reinterpret_cast<const bf16x8*>(&Qrow[d0*16+hi*8]);
  float lse0=-INFINITY,lse1=-INFINITY,lse2=-INFINITY,sinkv=0.f;
  if(VAR==3){ selm=A.sel[gpos]; }
  if(VAR==4){ const int ns=__builtin_popcount(selm); if(ns>0)lse0=A.LSE[(long)gpos*3+0]; if(ns>1)lse1=A.LSE[(long)gpos*3+1]; if(ns>2)lse2=A.LSE[(long)gpos*3+2]; }
  if(VAR==2){ sinkv=A.sinkp[0]; }
  float mhat=0.f,l_reg=0.f;f32x16 o[2];o[0]=f32x16{};o[1]=f32x16{};const f32x16 negm=f32x16{};
  const int qrel=wid*QBLK+r32;
  #define CMASK(P0,P1,t) bias_tile<VAR,true>(P0,P1,(t),(t)-(NT-4),qrel,hi,ftab,selm,t0,rowc-mhat)
  bool resc=false;
  #define START(P0,P1) do{ const float rm=rowmax(P0,P1); resc=false; \
    { const float dl=max2f(rm,-30.f); mhat=fadd_s(mhat,dl); \
      _Pragma("unroll") for(int r=0;r<16;++r){P0[r]=fsub_s(P0[r],dl);P1[r]=fsub_s(P1[r],dl);} \
      } \
    _Pragma("unroll") for(int r=0;r<16;++r)P0[r]=__builtin_amdgcn_exp2f(P0[r]); }while(0)
  #define RESC() do{ if(resc){ asm volatile("s_waitcnt lgkmcnt(0)":::"memory"); \
      _Pragma("unroll") for(int d_=0;d_<2;++d_) _Pragma("unroll") for(int r=0;r<16;++r)o[d_][r]*=wsf[crow(r,hi)]; } }while(0)
  f32x16 pA0,pA1,pB0,pB1;
  int sl_prev=0,sl_cur=0,sl_next=SLOTB;
  #define ROT() do{sl_prev=sl_cur;sl_cur=sl_next;sl_next=(sl_next==(NSL-1)*SLOTB)?0:sl_next+SLOTB;}while(0)
  if(!kvres){DMA_K(2,2*SLOTB);}
  if(RES){ if(!kvres){DMA_V(2,2*SLOTB);DMA_K(3,3*SLOTB);DMA_V(3,3*SLOTB);WAIT_BAR(0);} } else {WAIT_BAR(3);}
  qkt(pA0,pA1,Kbase,qr,negm,r32,hi);asm volatile("s_nop 15\n\ts_nop 7":"+v"(pA0),"+v"(pA1));CMASK(pA0,pA1,0);
  START(pA0,pA1);
  _Pragma("unroll") for(int r=0;r<16;++r)pA1[r]=__builtin_amdgcn_exp2f(pA1[r]);
  if(!RES){ WAIT_BAR(0);
  DMA_K(3,0);DMA_V(1,SLOTB); }
  ROT();
  kload8(kf,kp0+sl_cur);
  if(!RES){WAIT_BAR(2);}
  s16x4 vlo[8],vhi[8]; u32x4 pw0,pw1,pw2,pw3;
  #define PKW(P,B) cvtpk_s(P[B],P[B+1])
  #define PAF(k) __builtin_bit_cast(bf16x8,pw##k)
  #define VFR(i) (bf16x8){vlo[i][0],vlo[i][1],vlo[i][2],vlo[i][3],vhi[i][0],vhi[i][1],vhi[i][2],vhi[i][3]}
  #define PIN(x) asm volatile("":"+v"(x))
  #define MX3(a,b,c) __builtin_fmaxf(__builtin_fmaxf((a),(b)),(c))
  #define GAPA(MF,A0,A1,A2,A3,W0,W1,PW) do{ MF; sacc+=A0; sacc+=A1; sacc+=A2; sacc+=A3; PIN(sacc); W0; W1; PIN(PW); SBAR(); }while(0)
  #define EX(v) __builtin_amdgcn_exp2f(v)
  #define GAPB(MF,X,B) do{ MF; X[B]=EX(X[B]); X[B+1]=EX(X[B+1]); X[B+2]=EX(X[B+2]); X[B+3]=EX(X[B+3]); PIN(X); SBAR(); }while(0)
  #define VRD(i) do{ vlo[i]=vtr(vp_+(((i)>>2)*4096+((i)&3)*1024)); vhi[i]=vtr(vp_+(((i)>>2)*4096+((i)&3)*1024+512)); }while(0)
  #define KRD(G,j) do{ if(G){ kload2(kf,kp0+sl_next,j); SBAR(); } }while(0)
  #define STEP(C0,C1,P0,P1,t,GK,GV,GL) do{ SBAR(); \
    const lds_cptr vp_=vp0+sl_prev; \
    VRD(0); SBAR(); float sacc=(P0[0]+P0[1]); \
    GAPA(C0=__builtin_amdgcn_mfma_f32_32x32x16_bf16(kf[0],qr[0],negm,0,0,0), P0[2],P0[3],P0[4],P0[5],     pw0[0]=PKW(P0,0), pw0[1]=PKW(P0,2), pw0); \
    VRD(4); SBAR(); GAPA(C1=__builtin_amdgcn_mfma_f32_32x32x16_bf16(kf[1],qr[0],negm,0,0,0), P0[6],P0[7],P0[8],P0[9],     pw0[2]=PKW(P0,4), pw0[3]=PKW(P0,6), pw0); \
    VRD(1); SBAR(); GAPA(C0=__builtin_amdgcn_mfma_f32_32x32x16_bf16(kf[2],qr[1],C0,0,0,0),   P0[10],P0[11],P0[12],P0[13], pw1[0]=PKW(P0,8), pw1[1]=PKW(P0,10), pw1); \
    VRD(5); SBAR(); GAPA(C1=__builtin_amdgcn_mfma_f32_32x32x16_bf16(kf[3],qr[1],C1,0,0,0),   P0[14],P0[15],P1[0],P1[1],   pw1[2]=PKW(P0,12),pw1[3]=PKW(P0,14), pw1); \
    VRD(2); SBAR(); GAPA(C0=__builtin_amdgcn_mfma_f32_32x32x16_bf16(kf[4],qr[2],C0,0,0,0),   P1[2],P1[3],P1[4],P1[5],     pw2[0]=PKW(P1,0), pw2[1]=PKW(P1,2), pw2); \
    VRD(6); SBAR(); GAPA(C1=__builtin_amdgcn_mfma_f32_32x32x16_bf16(kf[5],qr[2],C1,0,0,0),   P1[6],P1[7],P1[8],P1[9],     pw2[2]=PKW(P1,4), pw2[3]=PKW(P1,6), pw2); \
    VRD(3); SBAR(); GAPA(C0=__builtin_amdgcn_mfma_f32_32x32x16_bf16(kf[6],qr[3],C0,0,0,0),   P1[10],P1[11],P1[12],P1[13], pw3[0]=PKW(P1,8), pw3[1]=PKW(P1,10), pw3); \
    VRD(7); SBAR(); GAPA(C1=__builtin_amdgcn_mfma_f32_32x32x16_bf16(kf[7],qr[3],C1,0,0,0),   P1[14],P1[15],0.f,0.f,       pw3[2]=PKW(P1,12),pw3[3]=PKW(P1,14), pw3); \
    l_reg+=sacc; \
    if(GK){DMA_K((t)+3,sl_cur);} if(GV){DMA_V((t)+1,sl_next);} \
    CMASK(C0,C1,t); \
    { float a=MX3(C0[0],C0[1],C1[0]),b=MX3(C0[2],C0[3],C1[1]); a=MX3(a,C1[2],C1[3]); \
      _Pragma("unroll") for(int r=4;r<16;r+=4){a=MX3(a,C0[r],C0[r+1]);b=MX3(b,C0[r+2],C0[r+3]);a=MX3(a,C1[r],C1[r+1]);b=MX3(b,C1[r+2],C1[r+3]);} \
      float rm=__builtin_fmaxf(a,b); { auto rr=__builtin_amdgcn_permlane32_swap(__float_as_uint(rm),__float_as_uint(rm),false,false); rm=__builtin_fmaxf(__uint_as_float(rr[0]),__uint_as_float(rr[1])); } \
      resc=false; \
      if(__builtin_expect(__any(rm>(float)THRL),0)){ const float dl=__builtin_fmaxf(rm,0.f); mhat+=dl; \
        _Pragma("unroll") for(int r=0;r<16;++r){C0[r]-=dl;C1[r]-=dl;} \
        const float f=__builtin_amdgcn_exp2f(-dl); l_reg*=f; if(hi==0)wsf[r32]=f; resc=true; } } \
    SBAR(); \
    GAPB(o[0]=__builtin_amdgcn_mfma_f32_32x32x16_bf16(PAF(0),VFR(0),o[0],0,0,0), C0,0); \
    GAPB(o[1]=__builtin_amdgcn_mfma_f32_32x32x16_bf16(PAF(0),VFR(4),o[1],0,0,0), C0,4); \
    KRD(GL,0); GAPB(o[0]=__builtin_amdgcn_mfma_f32_32x32x16_bf16(PAF(1),VFR(1),o[0],0,0,0), C0,8); \
    KRD(GL,1); GAPB(o[1]=__builtin_amdgcn_mfma_f32_32x32x16_bf16(PAF(1),VFR(5),o[1],0,0,0), C0,12); \
    KRD(GL,2); GAPB(o[0]=__builtin_amdgcn_mfma_f32_32x32x16_bf16(PAF(2),VFR(2),o[0],0,0,0), C1,0); \
    KRD(GL,3); GAPB(o[1]=__builtin_amdgcn_mfma_f32_32x32x16_bf16(PAF(2),VFR(6),o[1],0,0,0), C1,4); \
    GAPB(o[0]=__builtin_amdgcn_mfma_f32_32x32x16_bf16(PAF(3),VFR(3),o[0],0,0,0), C1,8); \
    GAPB(o[1]=__builtin_amdgcn_mfma_f32_32x32x16_bf16(PAF(3),VFR(7),o[1],0,0,0), C1,12); \
    }while(0)
  int t=1;
  #undef CMASK
  #define CMASK(P0,P1,t) bias_tile<VAR,false>(P0,P1,(t),-1,qrel,hi,ftab,selm,t0,rowc-mhat)
  for(;t+5<NT;t+=2){
    STEP(pB0,pB1,pA0,pA1,t,true,true,true);     WAIT_BAR(2); RESC(); ROT();
    STEP(pA0,pA1,pB0,pB1,t+1,true,true,true);   WAIT_BAR(2); RESC(); ROT();
  }
  #undef CMASK
  #define CMASK(P0,P1,t) bias_tile<VAR,true>(P0,P1,(t),(t)-(NT-4),qrel,hi,ftab,selm,t0,rowc-mhat)
  #define ENDW(tt) do{ if((tt)+3<NT){WAIT_BAR(2);} else if((tt)+2<NT){WAIT_BAR(1);} else {WAIT_BAR(0);} }while(0)
  for(;t+1<NT;t+=2){
    if(RES){ STEP(pB0,pB1,pA0,pA1,t,false,false,(t+1<NT)); RESC(); ROT(); STEP(pA0,pA1,pB0,pB1,t+1,false,false,(t+2<NT)); RESC(); ROT(); }
    else {
    STEP(pB0,pB1,pA0,pA1,t,(t+3<NT),(t+1<NT),(t+1<NT));       ENDW(t);   RESC(); ROT();
    STEP(pA0,pA1,pB0,pB1,t+1,(t+4<NT),(t+2<NT),(t+2<NT));     ENDW(t+1); RESC(); ROT(); }
  }
  STEP(pB0,pB1,pA0,pA1,NT-1,false,false,false); RESC();
  { float sacc=pB0[0]+pB0[1]; _Pragma("unroll") for(int r=2;r<16;++r)sacc+=pB0[r]; _Pragma("unroll") for(int r=0;r<16;++r)sacc+=pB1[r]; l_reg+=sacc;
    pw0=(u32x4){PKW(pB0,0),PKW(pB0,2),PKW(pB0,4),PKW(pB0,6)};pw1=(u32x4){PKW(pB0,8),PKW(pB0,10),PKW(pB0,12),PKW(pB0,14)};pw2=(u32x4){PKW(pB1,0),PKW(pB1,2),PKW(pB1,4),PKW(pB1,6)};pw3=(u32x4){PKW(pB1,8),PKW(pB1,10),PKW(pB1,12),PKW(pB1,14)};
    SBAR(); pv(o,vb0+sl_cur,PAF(0),PAF(1),PAF(2),PAF(3)); }
  #undef PKW
  #undef PAF
  #undef VFR
  #undef PIN
  #undef MX3
  #undef GAPA
  #undef GAPB
  #undef EX
  #undef VRD
  #undef KRD
  #undef STEP
  #undef ENDW
  {auto rr=__builtin_amdgcn_permlane32_swap(__float_as_uint(l_reg),__float_as_uint(l_reg),false,false);l_reg=__uint_as_float(rr[0])+__uint_as_float(rr[1]);}
  if(VAR==2)l_reg+=__builtin_amdgcn_exp2f(sinkv*1.4426950408889634f-mhat);
  if(VAR==3&&hi==0){ const int slot=__builtin_popcount(selm&((1u<<qb)-1u)); const int dst=gvalid?gpos*3+slot:-1; wsf[64+r32]=__int_as_float(dst);
    if(gvalid)A.LSE[(long)gpos*3+slot]=mhat+__builtin_amdgcn_logf(l_reg); }
  if(VAR==4&&hi==0){ const int ns=__builtin_popcount(selm); const float lo=mhat+__builtin_amdgcn_logf(l_reg);
    const float l0=lse0, l1=lse1, l2=lse2; (void)ns;
    const float mm=__builtin_fmaxf(__builtin_fmaxf(lo,l0),__builtin_fmaxf(l1,l2));
    const float e0=__builtin_amdgcn_exp2f(lo-mm), e1=__builtin_amdgcn_exp2f(l0-mm), e2=__builtin_amdgcn_exp2f(l1-mm), e3=__builtin_amdgcn_exp2f(l2-mm), inv=__builtin_amdgcn_rcpf((e0+e1)+(e2+e3));
    wsf[64+4*r32]=e0*inv; wsf[65+4*r32]=e1*inv; wsf[66+4*r32]=e2*inv; wsf[67+4*r32]=e3*inv; }
  if(hi==0)wsf[32+r32]=l_reg;asm volatile("s_waitcnt lgkmcnt(0)":::"memory");
  float rli[16];
  #pragma unroll
  for(int r=0;r<16;++r)rli[r]=__builtin_amdgcn_rcpf(wsf[32+crow(r,hi)]);
  bf16*Ow=A.O+(rowbase+q0+wid*QBLK)*DMO+A.ocol;
  { bf16*stg=(bf16*)(shm+LOST)+wid*2048;
    #pragma unroll
    for(int r=0;r<16;++r){const int orow=crow(r,hi);
      #pragma unroll
      for(int d0=0;d0<2;++d0)stg[orow*64+d0*32+r32]=__float2bfloat16(o[d0][r]*rli[r]);}
    asm volatile("s_waitcnt lgkmcnt(0)":::"memory");
    #pragma unroll
    for(int once_=0;once_<1;++once_){ u32x4 gl[4]; u32x4 pl[4][3];
    if(VAR==1){
      #pragma unroll
      for(int i=0;i<4;++i)gl[i]=*(const u32x4*)(A.gate+(rowbase+q0+wid*QBLK+i*8+(lane>>3))*512+(lane&7)*8); }
    if(VAR==4){
      #pragma unroll
      for(int i=0;i<4;++i)
        #pragma unroll
        for(int sl=0;sl<3;++sl)pl[i][sl]=*(const u32x4*)(A.PO+((long)(q0+wid*QBLK+i*8+(lane>>3))*3+sl)*64+(lane&7)*8); }
    #pragma unroll
    for(int i=0;i<4;++i){const int row=i*8+(lane>>3),ch=lane&7; u32x4 v=*(const u32x4*)(stg+row*64+ch*8);
      if(VAR==1){ const u32x4 g=gl[i];
        #pragma unroll
        for(int j=0;j<4;++j){ const float vl=__uint_as_float(v[j]<<16)*__uint_as_float(g[j]<<16), vh=__uint_as_float(v[j]&0xffff0000u)*__uint_as_float(g[j]&0xffff0000u); v[j]=cvtpk_s(vl,vh); } }
      if(VAR==3){ const int dst=__float_as_int(wsf[64+row]); if(dst>=0)ATTN_STORE16(A.PO+(long)dst*64+ch*8,v); }
      else if(VAR==4){ const float w0=wsf[64+4*row],w1=wsf[65+4*row],w2=wsf[66+4*row],w3=wsf[67+4*row];
        float acc8[8];
        #pragma unroll
        for(int j=0;j<4;++j){ acc8[2*j]=w0*__uint_as_float(v[j]<<16); acc8[2*j+1]=w0*__uint_as_float(v[j]&0xffff0000u); }
        #pragma unroll
        for(int sl=0;sl<3;++sl){ const float ws_=sl==0?w1:sl==1?w2:w3; const u32x4 p=pl[i][sl];
          #pragma unroll
          for(int j=0;j<4;++j){ acc8[2*j]+=ws_!=0.f?ws_*__uint_as_float(p[j]<<16):0.f; acc8[2*j+1]+=ws_!=0.f?ws_*__uint_as_float(p[j]&0xffff0000u):0.f; } }
        #pragma unroll
        for(int j=0;j<4;++j)v[j]=cvtpk_s(acc8[2*j],acc8[2*j+1]);
        ATTN_STORE16(Ow+(long)row*DMO+ch*8,v); }
      else ATTN_STORE16(Ow+(long)row*DMO+ch*8,v);} } }
  asm volatile("s_waitcnt lgkmcnt(0)\n\ts_barrier":::"memory");
  #undef DMA_K
  #undef DMA_V
  #undef CMASK
  #undef START
  #undef RESC
  #undef ROT
}
constexpr int ATTN_LDS_BYTES=LDS_BYTES;
#undef SBAR
#undef WAIT_BAR
}
#define GAS __attribute__((address_space(1)))
#define LAS __attribute__((address_space(3)))
typedef unsigned short bf16;
typedef unsigned v4u __attribute__((ext_vector_type(4)));
typedef float f32x4 __attribute__((ext_vector_type(4)));
typedef short bf16x8 __attribute__((ext_vector_type(8)));
typedef GAS unsigned gu32;
typedef GAS unsigned long long gu64;
#define RLX_AGENT __ATOMIC_RELAXED, __HIP_MEMORY_SCOPE_AGENT
#define LDS_WAIT() asm volatile("s_waitcnt lgkmcnt(0)" ::: "memory")
#define VM_WAIT() asm volatile("s_waitcnt vmcnt(0)" ::: "memory")
__device__ __forceinline__ unsigned long long rt() { return __builtin_amdgcn_s_memrealtime(); }
__device__ __forceinline__ unsigned f2bf(float f) { unsigned u = __builtin_bit_cast(unsigned, f); return (u + 0x7fffu + ((u >> 16) & 1u)) >> 16; }
__device__ __forceinline__ unsigned pk2(float lo, float hi) { return f2bf(lo) | (f2bf(hi) << 16); }

#define XB_TMO      128
#define XB_XCNT(j)  (256  + 64 * (j))
#define XB_XSUB(j)  (1280 + 64 * (j))
#define XB_XGEN(j)  (2304 + 64 * (j))
#define XB_TOP      3328
#define XB_TOPGEN   3392
#define XCD_BAR_WORDS 3456
#define XB_SPIN_CAP (1u << 18)

__device__ __forceinline__ unsigned xb_ld(unsigned* p)              { return __hip_atomic_load(p, __ATOMIC_RELAXED, __HIP_MEMORY_SCOPE_AGENT); }
__device__ __forceinline__ unsigned xb_add(unsigned* p, unsigned v) { return __hip_atomic_fetch_add(p, v, __ATOMIC_RELAXED, __HIP_MEMORY_SCOPE_AGENT); }
__device__ __forceinline__ unsigned xb_xcc_id() { return (unsigned)__builtin_amdgcn_s_getreg((3 << 11) | 20) & 0xFu; }
#define XB_SPIN(cond, bar) do { unsigned _sp = 0; while (cond) { __builtin_amdgcn_s_sleep(1); \
    if ((++_sp & 255u) == 0u) { if (xb_ld(&(bar)[XB_TMO])) break; if (_sp > XB_SPIN_CAP) { atomicAdd(&(bar)[XB_TMO], 1u); break; } } } } while (0)

struct XcdBarrier {
    unsigned* bar; unsigned x;
    volatile LAS unsigned* st;
};

__device__ __forceinline__ XcdBarrier xcd_barrier_post(unsigned* bar, volatile LAS unsigned* st) {
    XcdBarrier b; b.bar = bar; b.x = xb_xcc_id(); b.st = st;
    if (threadIdx.x == 0) (void)xb_add(&bar[XB_XCNT(b.x)], 1u);
    return b;
}
__device__ __forceinline__ void xcd_barrier_complete(unsigned* bar, unsigned x, unsigned& nloc, unsigned& nx) {
    const unsigned G = gridDim.x * gridDim.y * gridDim.z;
    unsigned sum, cnt, mine, sp = 0u;
    for (;;) {
        sum = 0u; cnt = 0u; mine = 0u;
#pragma unroll
        for (unsigned j = 0; j < 16; ++j) { const unsigned c = xb_ld(&bar[XB_XCNT(j)]); sum += c; cnt += (c > 0u) ? 1u : 0u; mine = (j == x) ? c : mine; }
        if (sum == G) break;
        __builtin_amdgcn_s_sleep(1);
        if ((++sp & 255u) == 0u) { if (xb_ld(&bar[XB_TMO])) break; if (sp > XB_SPIN_CAP) { atomicAdd(&bar[XB_TMO], 1u); break; } }
    }
    nloc = mine > 0u ? mine : 1u; nx = cnt > 0u ? cnt : 1u;
}

__device__ __forceinline__ void xcd_barrier(const XcdBarrier& b) {
    asm volatile("s_waitcnt vmcnt(0)" ::: "memory");
    __syncthreads();
    if (threadIdx.x == 0) {
        unsigned* bar = b.bar;
        __builtin_amdgcn_s_waitcnt(0);
        unsigned nloc = b.st[0], nx = b.st[1];
        if (nloc == 0u) { xcd_barrier_complete(bar, b.x, nloc, nx); b.st[0] = nloc; b.st[1] = nx; }
        const unsigned old = xb_add(&bar[XB_XSUB(b.x)], 1u);
        const unsigned gen = old / nloc;
        if (old + 1u == (gen + 1u) * nloc) {
            __builtin_amdgcn_fence(__ATOMIC_RELEASE, "agent");
            asm volatile("s_waitcnt vmcnt(0)" ::: "memory");
            const unsigned og = xb_add(&bar[XB_TOP], 1u);
            const unsigned tg = og / nx;
            if (og + 1u == (tg + 1u) * nx) xb_add(&bar[XB_TOPGEN], 1u);
            else XB_SPIN(xb_ld(&bar[XB_TOPGEN]) == tg, bar);
            __builtin_amdgcn_fence(__ATOMIC_ACQUIRE, "agent");
            xb_add(&bar[XB_XGEN(b.x)], 1u);
            asm volatile("s_waitcnt vmcnt(0)" ::: "memory");
        } else {
            XB_SPIN(xb_ld(&bar[XB_XGEN(b.x)]) == gen, bar);
            __builtin_amdgcn_fence(__ATOMIC_ACQUIRE, "agent");
            asm volatile("s_waitcnt vmcnt(0)" ::: "memory");
        }
    }
    __syncthreads();
}
constexpr int NWAVES = 8;
constexpr int BATCH = 2, SEQ = 8192, DMODEL = 1024, M = BATCH * SEQ;
constexpr int EV_COLS = 3592, EV_N = 3584, OD_N = 1280;
constexpr int NEXP = 16384;
constexpr float L2E = 1.4426950408889634f;
constexpr float RMS_EPS = 1e-6f;

#ifndef MK_N_LAUNCHES
#define MK_N_LAUNCHES 1
#endif
constexpr int N_PHASES = 14;
constexpr int N_LAUNCHES = MK_N_LAUNCHES;

constexpr size_t MiB = 1u << 20;
constexpr size_t WS_CTL = 0, CTL_ZERO_BYTES = 1 * MiB;
constexpr size_t WS_WIN0 = 2 * MiB, WS_WOUT0 = 9 * MiB, WS_WQ0 = 11 * MiB, WS_WIN1 = 13 * MiB, WS_WOUT1 = 16 * MiB, WS_WQ1 = 18 * MiB;
constexpr size_t WS_SK = 20 * MiB;
constexpr size_t WS_ROPE = 21 * MiB;
constexpr size_t WS_RA0 = 22 * MiB, WS_RA1 = 22 * MiB + 65536;
constexpr size_t WS_LF = 23 * MiB;
constexpr size_t WS_FL2 = 24 * MiB;
constexpr size_t WS_KSUM = 25 * MiB;
constexpr size_t WS_SEL = 26 * MiB;
constexpr size_t WS_GAIN = 28 * MiB;
constexpr size_t WS_TSC = 29 * MiB;
constexpr size_t WS_RSP = 27 * MiB;
constexpr size_t WS_XB = 32 * MiB;
constexpr size_t WS_QKV = 64 * MiB;
constexpr size_t WS_AO = 176 * MiB;
constexpr size_t WS_QP = 208 * MiB;
constexpr size_t WS_TAB = 240 * MiB;
constexpr size_t WS_UL = 368 * MiB;
constexpr size_t WS_LIST = 385 * MiB;
constexpr size_t WS_CNT = 389 * MiB;
constexpr size_t WS_LSE = 390 * MiB;
constexpr size_t WS_PO = 392 * MiB;
constexpr size_t WS_END = 440 * MiB;
constexpr int CW_BAR = 4096;

constexpr int RING_BYTES = 131072;
constexpr int LDS_BYTES = 147456;
constexpr int LDSCTL_OFF = LDS_BYTES - 512, MISC_OFF = LDSCTL_OFF + 64;

typedef unsigned v2u __attribute__((ext_vector_type(2)));
typedef __bf16 bf16x2v __attribute__((ext_vector_type(2)));
__device__ __forceinline__ float bflo(unsigned w) { return __uint_as_float(w << 16); }
__device__ __forceinline__ float bfhi(unsigned w) { return __uint_as_float(w & 0xffff0000u); }
__device__ __forceinline__ float dot2bf(unsigned a, unsigned b, float c) { return __builtin_amdgcn_fdot2_f32_bf16(__builtin_bit_cast(bf16x2v, a), __builtin_bit_cast(bf16x2v, b), c, false); }
#define DPPF(x, ctrl) __builtin_bit_cast(float, __builtin_amdgcn_update_dpp(0, __builtin_bit_cast(int, x), ctrl, 0xf, 0xf, false))
#define RDLF(x, l) __builtin_bit_cast(float, __builtin_amdgcn_readlane(__builtin_bit_cast(int, x), l))
__device__ __forceinline__ float wave_sum(float v) {
    v += DPPF(v, 0xB1); v += DPPF(v, 0x4E); v += DPPF(v, 0x124); v += DPPF(v, 0x128);
    return (RDLF(v, 0) + RDLF(v, 16)) + (RDLF(v, 32) + RDLF(v, 48));
}
__device__ __forceinline__ float wave_max(float v) {
    v = fmaxf(v, DPPF(v, 0xB1)); v = fmaxf(v, DPPF(v, 0x4E)); v = fmaxf(v, DPPF(v, 0x124)); v = fmaxf(v, DPPF(v, 0x128));
    return fmaxf(fmaxf(RDLF(v, 0), RDLF(v, 16)), fmaxf(RDLF(v, 32), RDLF(v, 48)));
}

struct Args { const float* in[19]; float* out; unsigned char* ws; int ph_lo, ph_hi, li, pad; };
struct Ctx { unsigned char* lds; int tid, lane, wave, vcu, G; };

__device__ __forceinline__ int perm_src_col(int c) { const int r = c & 255; return (c & ~255) + 64 * ((r >> 5) & 3) + 16 * ((r >> 3) & 3) + 8 * (r >> 7) + (r & 7); }
__device__ __forceinline__ void p0_transpose_item(const float* W, int Nsrc, const float* gain, bool permc, bf16* WT, LAS float* scr, int item, int nblk, int lane) {
    const int kb = item / nblk, nb = item % nblk, k0 = 64 * kb, n0 = 32 * nb;
    const int sc = permc ? perm_src_col(n0 + (lane & 31)) : n0 + (lane & 31);
    const int c = lane & 7;
    f32x4 ga = {1.f, 1.f, 1.f, 1.f}, gb = ga;
    if (gain) { ga = *(const f32x4*)(gain + k0 + 8 * c); gb = *(const f32x4*)(gain + k0 + 8 * c + 4); }
    { const float* wp = W + (size_t)(k0 + (lane >> 5)) * Nsrc + sc; float wv[32];
#pragma unroll
      for (int i = 0; i < 32; ++i) wv[i] = wp[(size_t)(2 * i) * Nsrc];
#pragma unroll
      for (int i = 0; i < 32; ++i) scr[(2 * i + (lane >> 5)) * 33 + (lane & 31)] = wv[i]; }
    LDS_WAIT(); asm volatile("" ::: "memory");
#pragma unroll
    for (int j = 0; j < 4; ++j) { const int n = (lane >> 3) + 8 * j; const LAS float* s = scr + (8 * c) * 33 + n;
        v4u o; o.x = pk2(s[0 * 33] * ga.x, s[1 * 33] * ga.y); o.y = pk2(s[2 * 33] * ga.z, s[3 * 33] * ga.w); o.z = pk2(s[4 * 33] * gb.x, s[5 * 33] * gb.y); o.w = pk2(s[6 * 33] * gb.z, s[7 * 33] * gb.w);
        *(GAS v4u*)(WT + (size_t)(n0 + n) * 1024 + k0 + 8 * c) = o; }
    LDS_WAIT(); asm volatile("" ::: "memory");
}
__device__ __forceinline__ void sincos_d(float af, float& s, float& c) {
    const double a = (double)af, k = __builtin_rint(a * 0.15915494309189535), r = (a - k * 6.283185307179586) - k * 2.4492935982947064e-16, r2 = r * r;
    double ts = 1.0, tc = 1.0, ss = 1.0, cc = 1.0;
#pragma unroll
    for (int i = 1; i <= 13; ++i) { tc *= r2 * (-1.0 / (double)((2 * i - 1) * (2 * i))); ts *= r2 * (-1.0 / (double)((2 * i) * (2 * i + 1))); cc += tc; ss += ts; }
    s = (float)(r * ss); c = (float)cc;
}
#ifndef CONV_L1_LATE
#define CONV_L1_LATE 2
#endif
constexpr int CW_CONV = 2048;
typedef unsigned v6u __attribute__((ext_vector_type(6)));
typedef unsigned v3u __attribute__((ext_vector_type(3)));
struct UB { v4u a4, b4; v2u a2, b2; };
typedef _Float16 h32 __attribute__((ext_vector_type(32)));
__device__ __forceinline__ void conv_rows4_fp6(const Args& a, unsigned char* ws, int layer, int t, int e0, int lane) {
    const int slot = 2 * layer + t; float* tsc = (float*)(ws + WS_TSC);
    const int sub = lane >> 5, blk = (lane >> 4) & 1, li = lane & 15;
    const f32x4* sp = (const f32x4*)(a.in[17 + t] + ((size_t)layer * NEXP + e0 + sub) * 1024 + 512 * blk + 4 * li);
    f32x4 v[2][8];
#pragma unroll
    for (int r2 = 0; r2 < 2; ++r2)
#pragma unroll
        for (int q = 0; q < 8; ++q) v[r2][q] = __builtin_nontemporal_load(sp + r2 * 512 + 16 * q);
#pragma unroll
    for (int r2 = 0; r2 < 2; ++r2) { float mx = 0.f;
#pragma unroll
        for (int q = 0; q < 8; ++q) mx = fmaxf(mx, fmaxf(fmaxf(fabsf(v[r2][q].x), fabsf(v[r2][q].y)), fmaxf(fabsf(v[r2][q].z), fabsf(v[r2][q].w))));
        mx = fmaxf(mx, __shfl_xor(mx, 1)); mx = fmaxf(mx, __shfl_xor(mx, 2)); mx = fmaxf(mx, __shfl_xor(mx, 4)); mx = fmaxf(mx, __shfl_xor(mx, 8)); mx = fmaxf(mx, __shfl_xor(mx, 16));
        const float step = mx > 0.f ? mx * (1.0f / 7.5f) : 1.0f, inv = 1.0f / step;
        h32 hv;
#pragma unroll
        for (int q = 0; q < 8; ++q) { hv[4 * q] = (_Float16)(v[r2][q].x * inv); hv[4 * q + 1] = (_Float16)(v[r2][q].y * inv); hv[4 * q + 2] = (_Float16)(v[r2][q].z * inv); hv[4 * q + 3] = (_Float16)(v[r2][q].w * inv); }
        const v6u pk = __builtin_amdgcn_cvt_scalef32_pk32_fp6_f16(hv, 1.0f);
        unsigned char* op = ws + WS_TAB + (size_t)slot * 32 * MiB + (size_t)(e0 + 2 * r2 + sub) * 768;
        *(v4u*)(op + 256 * blk + 16 * li) = (v4u){pk[0], pk[1], pk[2], pk[3]}; *(v2u*)(op + 512 + 128 * blk + 8 * li) = (v2u){pk[4], pk[5]};
        if ((lane & 31) == 0) tsc[slot * NEXP + e0 + 2 * r2 + sub] = step; }
}
__device__ __forceinline__ void conv_rows4(const Args& a, unsigned char* ws, int layer, int t, int e0, int lane) {
    if (t) { conv_rows4_fp6(a, ws, layer, t, e0, lane); return; }
    const int slot = 2 * layer + t; float* tsc = (float*)(ws + WS_TSC);
    const f32x4* sp = (const f32x4*)(a.in[17 + t] + ((size_t)layer * NEXP + e0) * 1024) + lane;
    f32x4 v[4][4];
#pragma unroll
    for (int r = 0; r < 4; ++r)
#pragma unroll
        for (int j = 0; j < 4; ++j) v[r][j] = __builtin_nontemporal_load(sp + r * 256 + 64 * j);
#pragma unroll
    for (int r = 0; r < 4; ++r) { float mx = 0.f;
#pragma unroll
        for (int j = 0; j < 4; ++j) mx = fmaxf(mx, fmaxf(fmaxf(fabsf(v[r][j].x), fabsf(v[r][j].y)), fmaxf(fabsf(v[r][j].z), fabsf(v[r][j].w))));
        mx = wave_max(mx); const float step = mx > 0.f ? mx * (t ? 1.0f / 240.0f : 1.0f / 127.0f) : 1.0f, inv = 1.0f / step;
        unsigned* op = (unsigned*)(ws + WS_TAB + (size_t)slot * 32 * MiB + (size_t)(e0 + r) * 1024) + lane;
#pragma unroll
        for (int j = 0; j < 4; ++j) {
            if (t) { int w = 0; w = __builtin_amdgcn_cvt_pk_fp8_f32(v[r][j].x * inv, v[r][j].y * inv, w, false); w = __builtin_amdgcn_cvt_pk_fp8_f32(v[r][j].z * inv, v[r][j].w * inv, w, true); op[64 * j] = (unsigned)w; }
            else { const int q0 = (int)rintf(v[r][j].x * inv), q1 = (int)rintf(v[r][j].y * inv), q2 = (int)rintf(v[r][j].z * inv), q3 = (int)rintf(v[r][j].w * inv);
                op[64 * j] = (unsigned)(q0 & 255) | ((unsigned)(q1 & 255) << 8) | ((unsigned)(q2 & 255) << 16) | ((unsigned)(q3 & 255) << 24); } }
        if (lane == 0) tsc[slot * NEXP + e0 + r] = step; }
}
__device__ __forceinline__ void conv_pull(const Args& a, const Ctx& C, int layer) {
    volatile LAS unsigned* box = (volatile LAS unsigned*)(C.lds + LDSCTL_OFF + 256);
    gu32* cnt = (gu32*)(a.ws + WS_CTL) + CW_CONV + 64 * layer;
    for (;;) {
        if (C.tid == 0) box[0] = __hip_atomic_fetch_add(cnt, 1u, RLX_AGENT);
        __syncthreads();
        const unsigned c = box[0];
        __syncthreads();
        if (c >= 512u) break;
        const int t = (int)(c >> 8), e0 = (int)(c & 255u) * 64 + C.wave * 8;
        conv_rows4(a, a.ws, layer, t, e0, C.lane); conv_rows4(a, a.ws, layer, t, e0 + 4, C.lane);
    }
}
__device__ __forceinline__ void p0_prologue(const Args& a, const Ctx& C) {
    unsigned char* ws = a.ws;
    const int gw = C.vcu * NWAVES + C.wave, NGW = C.G * NWAVES, gt = C.vcu * (NWAVES * 64) + C.tid, NGT = C.G * NWAVES * 64;
    const float* x = a.in[0]; const float* an = a.in[1]; const float* fn = a.in[2]; const float* ev_w_in = a.in[3]; const float* fbias = a.in[4];
    LAS float* wf = (LAS float*)(C.lds + 69632);
    for (int i = C.tid; i < 1024; i += NWAVES * 64) { const float g = an[i];
#pragma unroll
        for (int h = 0; h < 8; ++h) wf[h * 1024 + i] = ev_w_in[(size_t)i * EV_COLS + EV_N + h] * g; }
    __syncthreads();
    for (int stage = 0; stage < 2; ++stage) {
      if ((stage ^ (C.wave & 1)) == 0) {
    LAS float* scr = (LAS float*)(C.lds + C.wave * 8704);
    constexpr int I_IN0 = 16 * (EV_N / 32), I_SQ = 16 * 32, I_IN1 = 16 * (OD_N / 32);
    constexpr int NITEMS = I_IN0 + 2 * I_SQ + I_IN1 + 2 * I_SQ;
#ifndef PROBE_TR_REPS
#define PROBE_TR_REPS 1
#endif
    for (int rep_ = 0; rep_ < PROBE_TR_REPS; ++rep_)
    for (int it = gw; it < NITEMS; it += NGW) {
        int r = it;
        if (r < I_IN0) { p0_transpose_item(ev_w_in, EV_COLS, an, true, (bf16*)(ws + WS_WIN0), scr, r, EV_N / 32, C.lane); continue; } r -= I_IN0;
        if (r < I_SQ) { p0_transpose_item(a.in[9], 1024, nullptr, false, (bf16*)(ws + WS_WOUT0), scr, r, 32, C.lane); continue; } r -= I_SQ;
        if (r < I_SQ) { p0_transpose_item(a.in[15], 1024, fn, false, (bf16*)(ws + WS_WQ0), scr, r, 32, C.lane); continue; } r -= I_SQ;
        if (r < I_IN1) { p0_transpose_item(a.in[10], OD_N, an + 1024, true, (bf16*)(ws + WS_WIN1), scr, r, OD_N / 32, C.lane); continue; } r -= I_IN1;
        if (r < I_SQ) { p0_transpose_item(a.in[14], 1024, nullptr, false, (bf16*)(ws + WS_WOUT1), scr, r, 32, C.lane); continue; } r -= I_SQ;
        p0_transpose_item(a.in[15] + (size_t)1024 * 1024, 1024, fn + 1024, false, (bf16*)(ws + WS_WQ1), scr, r, 32, C.lane);
    }
    { bf16* xb = (bf16*)(ws + WS_XB); float* ra0 = (float*)(ws + WS_RA0); float* lf = (float*)(ws + WS_LF);
#ifndef PROBE_ROW_REPS
#define PROBE_ROW_REPS 1
#endif
      for (int rep_ = 0; rep_ < PROBE_ROW_REPS; ++rep_) {
      f32x4 vn[4];
      if (gw < M) { const GAS f32x4* xr0 = (const GAS f32x4*)(x + (size_t)gw * DMODEL) + C.lane;
#pragma unroll
          for (int j = 0; j < 4; ++j) vn[j] = xr0[64 * j]; }
      for (int m = gw; m < M; m += NGW) {
        f32x4 v[4]; float s = 0.f; float fa[8];
#pragma unroll
        for (int j = 0; j < 4; ++j) v[j] = vn[j];
        if (m + NGW < M) { const GAS f32x4* xr1 = (const GAS f32x4*)(x + (size_t)(m + NGW) * DMODEL) + C.lane;
#pragma unroll
            for (int j = 0; j < 4; ++j) vn[j] = xr1[64 * j]; }
#pragma unroll
        for (int h = 0; h < 8; ++h) fa[h] = 0.f;
#pragma unroll
        for (int j = 0; j < 4; ++j) { s += (v[j].x * v[j].x + v[j].y * v[j].y) + (v[j].z * v[j].z + v[j].w * v[j].w);
#pragma unroll
            for (int h = 0; h < 8; ++h) { const f32x4 w = *(const LAS f32x4*)(wf + h * 1024 + 256 * j + 4 * C.lane); fa[h] += (v[j].x * w.x + v[j].y * w.y) + (v[j].z * w.z + v[j].w * w.w); } }
        const float r = 1.0f / sqrtf(wave_sum(s) * (1.0f / DMODEL) + RMS_EPS);
        GAS unsigned long long* o8 = (GAS unsigned long long*)(xb + (size_t)m * DMODEL) + C.lane;
#pragma unroll
        for (int j = 0; j < 4; ++j) o8[64 * j] = (unsigned long long)pk2(v[j].x, v[j].y) | ((unsigned long long)pk2(v[j].z, v[j].w) << 32);
        float mine = 0.f;
#pragma unroll
        for (int h = 0; h < 8; ++h) { const float t = wave_sum(fa[h]); if (C.lane == h) mine = t; }
        if (C.lane < 8) { const float z = r * mine + fbias[C.lane]; lf[(size_t)m * 8 + C.lane] = z >= 0.f ? -log1pf(expf(-z)) : z - log1pf(expf(z)); }
        if (C.lane == 0) ra0[m] = r;
      } } }
      } else {
#ifndef PROBE_CONV_REPS
#define PROBE_CONV_REPS 1
#endif
      for (int rep_ = 0; rep_ < PROBE_CONV_REPS; ++rep_) for (int r4 = gw; r4 < NEXP / CONV_L1_LATE; r4 += NGW) { const int tl = r4 / (NEXP / 4), e0 = (r4 % (NEXP / 4)) * 4; conv_rows4(a, ws, tl >> 1, tl & 1, e0, C.lane); }
      }
    }
    {
      const float* sk = a.in[16];
      for (size_t i = gt; i < (size_t)262144 / 8; i += NGT) { const f32x4 p = *((const f32x4*)sk + 2 * i), q = *((const f32x4*)sk + 2 * i + 1);
            v4u o; o.x = pk2(p.x, p.y); o.y = pk2(p.z, p.w); o.z = pk2(q.x, q.y); o.w = pk2(q.z, q.w); *((v4u*)(ws + WS_SK) + i) = o; } }
    if (gt < 384) { const int g = gt >> 6, d = gt & 63; const float* src = g == 0 ? a.in[5] : g == 1 ? a.in[6] : g == 2 ? a.in[7] : g == 3 ? a.in[8] : g == 4 ? a.in[11] : a.in[12]; ((float*)(ws + WS_GAIN))[gt] = src[d]; }
    { float* cs = (float*)(ws + WS_ROPE);
      for (int i = gt; i < SEQ * 8; i += NGT) { const int pos = i >> 3, f = i & 7; const float inv = powf(500000.0f, -0.125f * (float)f), ang = (float)pos * inv; float s, c; sincos_d(ang, s, c);
          cs[pos * 16 + f] = c; cs[pos * 16 + 8 + f] = s; } }
}

__device__ __forceinline__ void p2_route(const Args& a, const Ctx& C, int rid, int nr) {
    unsigned char* ws = a.ws;
    for (int sq = rid; sq < 16; sq += nr) { const int b = sq >> 3, h = sq & 7; const float* lf = (const float*)(ws + WS_LF); float* fl2 = (float*)(ws + WS_FL2) + (size_t)sq * SEQ;
        LAS double* wtot = (LAS double*)(C.lds + 32768);
        double loc[16]; double run = 0.0;
#pragma unroll
        for (int i = 0; i < 16; ++i) { run += (double)lf[((size_t)b * SEQ + 16 * C.tid + i) * 8 + h]; loc[i] = run; }
        double inc = run;
#pragma unroll
        for (int o = 1; o < 64; o <<= 1) { const double y = __shfl_up(inc, o); if (C.lane >= o) inc += y; }
        if (C.lane == 63) wtot[C.wave] = inc;
        __syncthreads();
        double base = inc - run;
        for (int w = 0; w < C.wave; ++w) base += wtot[w];
#pragma unroll
        for (int i = 0; i < 16; ++i) fl2[16 * C.tid + i] = (float)((base + loc[i]) * 1.4426950408889634);
    }
    __syncthreads();
    for (int u0 = 2 * rid; u0 < 512; u0 += 2 * nr) { const int unit = u0 + (C.tid >> 8), qi = C.tid & 255, half = C.tid >> 8; const int b = unit >> 8, h = (unit >> 5) & 7, qb = unit & 31;
      __syncthreads();
      if (unit < 512) {
        LAS float* km = (LAS float*)(C.lds) + half * 2048;
        const float* ksum = (const float*)(ws + WS_KSUM);
        for (int i = qi; i < qb * 64; i += 256) { const int j = i >> 6, d = i & 63; const size_t p0 = ((size_t)(((b * 32 + j) * 2 + 0) * 8 + h)) * 64 + d, p1 = ((size_t)(((b * 32 + j) * 2 + 1) * 8 + h)) * 64 + d;
            km[i] = (ksum[p0] + ksum[p1]) * (1.0f / 256.0f); }
      }
      __syncthreads();
      if (unit < 512) {
        const LAS float* km = (const LAS float*)(C.lds) + half * 2048;
        const bf16* qa = (const bf16*)(ws + WS_QKV);
        const v4u* qp = (const v4u*)(qa + ((size_t)b * SEQ + 256 * qb + qi) * 512 + h * 64);
        float q[64];
#pragma unroll
        for (int c = 0; c < 8; ++c) { const v4u w = qp[c];
#pragma unroll
            for (int j = 0; j < 4; ++j) { q[8 * c + 2 * j] = bflo(w[j]); q[8 * c + 2 * j + 1] = bfhi(w[j]); } }
        float v0 = -INFINITY, v1 = -INFINITY, v2 = -INFINITY; int i0 = -1, i1 = -1, i2 = -1;
        for (int j = 0; j < qb; ++j) { float g0 = 0.f, g1 = 0.f, g2 = 0.f, g3 = 0.f;
#pragma unroll
            for (int d = 0; d < 64; d += 4) { const f32x4 k = *(const LAS f32x4*)(km + j * 64 + d); g0 += q[d] * k.x; g1 += q[d + 1] * k.y; g2 += q[d + 2] * k.z; g3 += q[d + 3] * k.w; }
            const float g = (g0 + g1) + (g2 + g3);
            if (g > v0) { v2 = v1; i2 = i1; v1 = v0; i1 = i0; v0 = g; i0 = j; } else if (g > v1) { v2 = v1; i2 = i1; v1 = g; i1 = j; } else if (g > v2) { v2 = g; i2 = j; } }
        unsigned msk = 0u; if (i0 >= 0) msk |= 1u << i0; if (i1 >= 0) msk |= 1u << i1; if (i2 >= 0) msk |= 1u << i2;
        ((unsigned*)(ws + WS_SEL))[((size_t)(b * 8 + h)) * SEQ + 256 * qb + qi] = msk;
      }
    }
}

__device__ __forceinline__ void p3_lists_item(const Args& a, const Ctx& C, int bh, int j) {
    unsigned char* ws = a.ws; LAS unsigned* wc = (LAS unsigned*)(C.lds);
    const unsigned* sel = (const unsigned*)(ws + WS_SEL) + (size_t)bh * SEQ;
    unsigned short* out = (unsigned short*)(ws + WS_LIST) + (size_t)bh * 126976 + (8192 * j - 128 * j * (j + 1));
    unsigned sv[16];
#pragma unroll
    for (int it = 0; it < 16; ++it) { const int q = 256 * (j + 1) + NWAVES * 64 * it + C.tid; sv[it] = q < SEQ ? sel[q] : 0u; }
    unsigned fm = 0u; unsigned short below[16];
#pragma unroll
    for (int it = 0; it < 16; ++it) { const int q = 256 * (j + 1) + NWAVES * 64 * it + C.tid; const bool f = q < SEQ && ((sv[it] >> j) & 1u);
        const unsigned long long m = __ballot(f); below[it] = (unsigned short)__builtin_popcountll(m & ((1ull << C.lane) - 1ull)); fm |= f ? (1u << it) : 0u;
        if (C.lane == 0) wc[it * NWAVES + C.wave] = (unsigned)__builtin_popcountll(m); }
    __syncthreads();
    unsigned base = 0u;
#pragma unroll
    for (int it = 0; it < 16; ++it) { unsigned off = base, tot = 0u;
#pragma unroll
        for (int w = 0; w < NWAVES; ++w) { const unsigned c = wc[it * NWAVES + w]; if (w < C.wave) off += c; tot += c; }
        if ((fm >> it) & 1u) out[off + below[it]] = (unsigned short)(256 * (j + 1) + NWAVES * 64 * it + C.tid);
        base += tot; }
    if (C.tid == 0) ((int*)(ws + WS_CNT))[bh * 32 + j] = (int)base;
    __syncthreads();
}
__device__ __forceinline__ void p3_lists(const Args& a, const Ctx& C) {
    for (int item = C.vcu; item < 16 * 31; item += C.G) p3_lists_item(a, C, item / 31, item % 31);
}

__device__ __forceinline__ void p4_attn_l0a(const Args& a, const Ctx& C) {
    unsigned char* ws = a.ws; const attn_body::bf16* qkv = (const attn_body::bf16*)(ws + WS_QKV); const size_t BUF = (size_t)M * 512;
    char* shm = (char*)C.lds;
    LAS int* upref = (LAS int*)(C.lds + 124928);
    const int* cnt = (const int*)(ws + WS_CNT);
    { int v = 0; if (C.tid < 496) v = (cnt[(C.tid / 31) * 32 + (C.tid % 31)] + 255) >> 8;
      int inc = v;
#pragma unroll
      for (int o = 1; o < 64; o <<= 1) { const int y = __shfl_up(inc, o); if (C.lane >= o) inc += y; }
      LAS int* wtot = (LAS int*)(C.lds + 127232 + 2048);
      if (C.lane == 63) wtot[C.wave] = inc;
      __syncthreads();
      int base = 0;
      for (int w2 = 0; w2 < C.wave; ++w2) base += wtot[w2];
      if (C.tid < 496) upref[C.tid] = base + inc - v;
      if (C.tid == 495) upref[496] = base + inc; }
    __syncthreads();
    const int U = upref[496];
    LAS int* bnd = (LAS int*)(C.lds + 127232);
    if (C.wave == 0) {
        constexpr float CG = 11.0f, CT = 1.3f, CFO = 4.0f;
        const float gq_ = wave_max(fabsf(a.in[7][C.lane])), gk_ = wave_max(fabsf(a.in[8][C.lane]));
        const float bl_ = 2.0f * (64.0f * gq_ * gk_ * attn_body::C2 * 1.02f + 1.0f);
        float cfv[4], s4 = 0.f, f4 = 0.f;
#pragma unroll
        for (int k = 0; k < 4; ++k) { const int c = 4 * C.lane + k; cfv[k] = 0.f;
            if (c < C.G && c < 256) { const int bh = c >> 4, sq = c & 15; const float fend = ((const float*)(ws + WS_FL2))[(size_t)bh * SEQ + SEQ - 1];
                const float slope = fmaxf(-fend * (1.0f / (float)(SEQ - 1)), 1e-6f); const float wtf = (160.0f + bl_) / (slope * 64.0f) + 3.0f; const int wt = wtf < 128.f ? (int)wtf : 128;
                const int ta = 4 * sq + 4 < wt + 4 ? 4 * sq + 4 : wt + 4, tb = 4 * (31 - sq) + 4 < wt + 4 ? 4 * (31 - sq) + 4 : wt + 4;
                cfv[k] = CT * (float)(ta + tb) + 2.0f * CFO; }
            f4 += cfv[k]; }
        const float target = ((float)U * CG + wave_sum(f4)) / (float)C.G;
        float sh[4];
#pragma unroll
        for (int k = 0; k < 4; ++k) { sh[k] = (4 * C.lane + k < C.G) ? fmaxf(0.f, (target - cfv[k]) * (1.0f / CG)) : 0.f; s4 += sh[k]; }
        float inc = s4;
#pragma unroll
        for (int o = 1; o < 64; o <<= 1) { const float y = __shfl_up(inc, o); if (C.lane >= o) inc += y; }
        const float tots = __shfl(inc, 63), scale = tots > 0.f ? (float)U / tots : 0.f;
        float run = inc - s4;
#pragma unroll
        for (int k = 0; k < 4; ++k) { run += sh[k]; int e = (int)(run * scale + 0.5f); e = e < U ? e : U; if (4 * C.lane + k >= C.G - 1) e = U; if (4 * C.lane + k < 256) bnd[4 * C.lane + k] = e; }
    }
    __syncthreads();
    const int u0 = C.vcu ? bnd[C.vcu - 1] : 0, u1 = bnd[C.vcu];
#ifndef PROBE_GREP
#define PROBE_GREP 1
#endif
    for (int grep_ = 0; grep_ < PROBE_GREP; ++grep_)
    for (int u = u0; u < u1; ++u) {
        int lo = 0, hi = 496;
        while (hi - lo > 1) { const int mid = (lo + hi) >> 1; if (upref[mid] <= u) lo = mid; else hi = mid; }
        const int item = lo, c = u - upref[lo], bh = item / 31, j = item % 31, b = bh >> 3, h = bh & 7, n = cnt[bh * 32 + j] - 256 * c;
        attn_body::UnitArgs um; um.Q = qkv; um.K = qkv + BUF; um.V = qkv + 2 * BUF; um.O = nullptr; um.qcol = h * 64; um.kcol = h * 64; um.ocol = 0;
        um.Fl2 = nullptr; um.gate = nullptr; um.sel = (const unsigned*)(ws + WS_SEL) + (size_t)bh * SEQ; um.sinkp = nullptr; um.bl2x2 = 0.f;
        um.glist = (const unsigned short*)(ws + WS_LIST) + (size_t)bh * 126976 + (8192 * j - 128 * j * (j + 1)) + 256 * c; um.gn = n < 256 ? n : 256;
        um.PO = (attn_body::bf16*)(ws + WS_PO) + (size_t)bh * SEQ * 192; um.LSE = (float*)(ws + WS_LSE) + (size_t)bh * SEQ * 3;
        um.kvres = (u > u0 && c > 0) ? 1 : 0;
        attn_body::attn_unit<3, 8, 512, 512, 1024>(b, j, um, shm);
    }
    { const int bh = C.vcu >> 4, s = C.vcu & 15, b = bh >> 3, h = bh & 7;
      const float gq = wave_max(fabsf(a.in[7][C.lane])), gk = wave_max(fabsf(a.in[8][C.lane]));
      const float bl2x2 = 2.0f * (64.0f * gq * gk * attn_body::C2 * 1.02f + 1.0f);
      attn_body::UnitArgs uf; uf.Q = qkv + 3 * BUF; uf.K = qkv + 4 * BUF; uf.V = qkv + 5 * BUF; uf.O = (attn_body::bf16*)(ws + WS_AO); uf.qcol = h * 64; uf.kcol = h * 64; uf.ocol = 512 + h * 64;
      uf.Fl2 = (const float*)(ws + WS_FL2) + (size_t)bh * SEQ; uf.gate = qkv + 6 * BUF + h * 64; uf.sel = nullptr; uf.sinkp = nullptr; uf.bl2x2 = bl2x2;
      uf.glist = nullptr; uf.gn = 0; uf.PO = nullptr; uf.LSE = nullptr; uf.kvres = 0;
      if (C.vcu < 256)
#ifndef PROBE_FREP
#define PROBE_FREP 1
#endif
          for (int i = 0; i < 2 * PROBE_FREP; ++i) attn_body::attn_unit<1, 8, 512, 512, 1024>(b, (i & 1) ? s : 31 - s, uf, shm); }
}
__device__ __forceinline__ void p5_attn_l0b(const Args& a, const Ctx& C) {
    unsigned char* ws = a.ws; const attn_body::bf16* qkv = (const attn_body::bf16*)(ws + WS_QKV); const size_t BUF = (size_t)M * 512;
    for (int pmb = C.vcu >> 2; pmb < M / 256; pmb += C.G >> 2)
    for (int i = 0; i < 2; ++i) {
    const int b = pmb >> 5, qbk = pmb & 31, h = (C.vcu & 3) * 2 + i, bh = b * 8 + h;
    attn_body::UnitArgs um; um.Q = qkv; um.K = qkv + BUF; um.V = qkv + 2 * BUF; um.O = (attn_body::bf16*)(ws + WS_AO); um.qcol = h * 64; um.kcol = h * 64; um.ocol = h * 64;
    um.Fl2 = nullptr; um.gate = nullptr; um.sel = (const unsigned*)(ws + WS_SEL) + (size_t)bh * SEQ; um.sinkp = nullptr; um.bl2x2 = 0.f;
    um.glist = nullptr; um.gn = 0; um.PO = (attn_body::bf16*)(ws + WS_PO) + (size_t)bh * SEQ * 192; um.LSE = (float*)(ws + WS_LSE) + (size_t)bh * SEQ * 3; um.kvres = 0;
    char* shm = (char*)C.lds;
    attn_body::attn_unit<4, 8, 512, 512, 1024>(b, qbk, um, shm); }
}
__device__ __forceinline__ void p8_attn_l1(const Args& a, const Ctx& C) {
    unsigned char* ws = a.ws;
    char* shm = (char*)C.lds;
    for (int pmb = C.vcu >> 2; pmb < M / 256; pmb += C.G >> 2)
    for (int i = 0; i < 4; ++i) {
    const int b = pmb >> 5, qbk = pmb & 31, hq = (C.vcu & 3) * 4 + i;
    attn_body::UnitArgs u; u.Q = (const attn_body::bf16*)(ws + WS_QKV); u.K = (const attn_body::bf16*)(ws + WS_QKV + 32 * MiB); u.V = (const attn_body::bf16*)(ws + WS_QKV + 36 * MiB); u.O = (attn_body::bf16*)(ws + WS_AO);
    u.qcol = hq * 64; u.kcol = (hq >> 3) * 64; u.ocol = hq * 64; u.Fl2 = nullptr; u.gate = nullptr; u.sel = nullptr; u.sinkp = a.in[13] + hq; u.bl2x2 = 0.f; u.glist = nullptr; u.gn = 0; u.PO = nullptr; u.LSE = nullptr; u.kvres = 0;
    attn_body::attn_unit<2, 8, 1024, 128, 1024>(b, qbk, u, shm); }
}

constexpr int SC_LD = 129;
constexpr int PL_TOPIDX = 256 * SC_LD * 4;
constexpr int PL_ALDS = PL_TOPIDX + 4096;
constexpr int PL_END = PL_ALDS + 4096;
static_assert(PL_END <= LDSCTL_OFF, "PEER LDS map");
__device__ __forceinline__ float gelu_erf(float v) { return 0.5f * v * (1.0f + erff(v * 0.70710678118654752f)); }

__device__ const unsigned char PEER_CAND[52] = {0,1,2,3,4,5,6,7,8,9,10,11,12,13,14,15,16,17,18,19,20,21,22,23,32,33,34,35,36,48,49,50,51,64,65,66,80,81,96,97,112,113,128,144,160,176,192,208,224,240,255,255};
template <int XM> __device__ __forceinline__ void merge16(float (&L)[16]) {
    float R[16];
#pragma unroll
    for (int i = 0; i < 16; ++i) R[i] = __shfl_xor(L[15 - i], XM);
#pragma unroll
    for (int i = 0; i < 16; ++i) L[i] = fmaxf(L[i], R[i]);
#pragma unroll
    for (int d = 8; d >= 1; d >>= 1)
#pragma unroll
        for (int i = 0; i < 16; ++i) if ((i & d) == 0) { const float hi = fmaxf(L[i], L[i + d]), lo = fminf(L[i], L[i + d]); L[i] = hi; L[i + d] = lo; }
}
constexpr int PL_SEQ = 32768, PL_HIST = 98304, PL_AL = 102400;
template <bool LAST> __device__ __forceinline__ void peer_phase(const Args& a, const Ctx& C, int layer) {
    unsigned char* ws = a.ws;
    const bf16* qp = (const bf16*)(ws + WS_QP);
    const bf16* skb = (const bf16*)(ws + WS_SK) + (size_t)layer * 131072;
    const unsigned char* Dt = ws + WS_TAB + (size_t)(2 * layer) * 32 * MiB;
    const unsigned char* Ut = ws + WS_TAB + (size_t)(2 * layer + 1) * 32 * MiB;
    const float* tsc = (const float*)(ws + WS_TSC) + (size_t)(2 * layer) * NEXP;
    const float* rsp = (const float*)(ws + WS_RSP);
    const float* gffn = a.in[2] + layer * 1024;
    float* xio = a.out;
    v2u* UL = (v2u*)(ws + WS_UL);
    LAS float* sc = (LAS float*)C.lds;
    LAS unsigned char* topidx = (LAS unsigned char*)(C.lds + PL_TOPIDX);
    const int w = C.wave;
    LAS unsigned char* candl = (LAS unsigned char*)(C.lds + PL_TOPIDX + 4096);
    if (C.tid < 52) candl[C.tid] = PEER_CAND[C.tid];
    __syncthreads();
    for (int grp = C.vcu; grp < M / 64; grp += C.G) {
#ifndef PROBE_ROUTE_REPS
#define PROBE_ROUTE_REPS 1
#endif
      bf16x8 kf0[2][8], kf1[2][8];
      { int tk_ = C.tid; asm volatile("" : "+v"(tk_)); const int lane0 = tk_ & 63, l15k = lane0 & 15, lgk = lane0 >> 4;
#pragma unroll
        for (int p = 0; p < 2; ++p) { const bf16* kb = skb + ((size_t)(w * 2 + p) * 128 + l15k) * 64 + 8 * lgk;
#pragma unroll
            for (int nt = 0; nt < 8; ++nt) { kf0[p][nt] = *(const bf16x8*)(kb + (size_t)nt * 16 * 64); kf1[p][nt] = *(const bf16x8*)(kb + (size_t)nt * 16 * 64 + 32); } } }
      for (int tl_ = 0; tl_ < 4 * PROBE_ROUTE_REPS; ++tl_) { const int tl = tl_ & 3;
        const int tok0 = grp * 64 + tl * 16;
        int tid_ = C.tid; asm volatile("" : "+v"(tid_));
        const int tid = tid_, lane = tid & 63, l15 = lane & 15, lg = lane >> 4;
#ifndef PROBE_RA
#define PROBE_RA 1
#define PROBE_RB 1
#define PROBE_RC 1
#endif
        for (int ra_ = 0; ra_ < PROBE_RA; ++ra_) {
            typedef float f32x4v __attribute__((ext_vector_type(4)));
#pragma unroll
            for (int p = 0; p < 2; ++p) {
                const bf16* qrow = qp + (size_t)(tok0 + l15) * 1024 + 128 * w + 64 * p + 8 * lg;
                const bf16x8 a0 = *(const bf16x8*)(qrow), a1 = *(const bf16x8*)(qrow + 32);
#pragma unroll
                for (int nt = 0; nt < 8; ++nt) {
                    const bf16x8 b0 = kf0[p][nt], b1 = kf1[p][nt];
                    f32x4v acc = {0.f, 0.f, 0.f, 0.f};
                    acc = __builtin_amdgcn_mfma_f32_16x16x32_bf16(a0, b0, acc, 0, 0, 0);
                    acc = __builtin_amdgcn_mfma_f32_16x16x32_bf16(a1, b1, acc, 0, 0, 0);
#pragma unroll
                    for (int r = 0; r < 4; ++r) sc[((w * 2 + p) * 16 + 4 * lg + r) * SC_LD + 16 * nt + l15] = acc[r];
                }
            }
        }
        LDS_WAIT(); asm volatile("" ::: "memory");
        for (int rb_ = 0; rb_ < PROBE_RB; ++rb_) { const int prob = lane >> 1, kh = lane & 1, P = w * 32 + prob;
            const LAS float* row = sc + P * SC_LD + 64 * kh;
            float L[16];
#pragma unroll
            for (int i = 0; i < 16; ++i) L[i] = -INFINITY;
            for (int k0 = 0; k0 < 64; k0 += 8) {
#pragma unroll
                for (int kk = 0; kk < 8; ++kk) { const int k = k0 + kk;
                    const float v = __uint_as_float((__float_as_uint(row[k]) & 0xffffff80u) | (unsigned)(127 - (64 * kh + k)));
#pragma unroll
                    for (int i = 15; i >= 1; --i) L[i] = __builtin_amdgcn_fmed3f(L[i - 1], v, L[i]);
                    L[0] = fmaxf(L[0], v); }
            }
            merge16<1>(L);
            if (kh == 0) { unsigned pk[4];
#pragma unroll
                for (int i = 0; i < 4; ++i) pk[i] = (127u - (__float_as_uint(L[4 * i]) & 127u)) | ((127u - (__float_as_uint(L[4 * i + 1]) & 127u)) << 8) | ((127u - (__float_as_uint(L[4 * i + 2]) & 127u)) << 16) | ((127u - (__float_as_uint(L[4 * i + 3]) & 127u)) << 24);
                *(LAS v4u*)(topidx + P * 16) = (v4u){pk[0], pk[1], pk[2], pk[3]}; }
        }
        LDS_WAIT(); asm volatile("" ::: "memory");
        for (int rc_ = 0; rc_ < PROBE_RC; ++rc_) {
            const int token = lane >> 2, sub = lane & 3, P1 = (w * 2) * 16 + token, P2 = P1 + 16;
            float L[16];
#pragma unroll
            for (int i = 0; i < 16; ++i) L[i] = -INFINITY;
#pragma unroll
            for (int n = 0; n < 13; ++n) { const unsigned code = candl[4 * n + sub]; const unsigned aa = (code >> 4) & 15u, bb = code & 15u;
                const unsigned k1 = topidx[P1 * 16 + aa], k2 = topidx[P2 * 16 + bb];
                const float sm = sc[P1 * SC_LD + k1] + sc[P2 * SC_LD + k2];
                const float v = code == 255u ? -INFINITY : __uint_as_float((__float_as_uint(sm) & 0xffffff00u) | (255u - code));
#pragma unroll
                for (int i = 15; i >= 1; --i) L[i] = __builtin_amdgcn_fmed3f(L[i - 1], v, L[i]);
                L[0] = fmaxf(L[0], v); }
            merge16<1>(L); merge16<2>(L);
            float ts[4]; unsigned myidx[4]; float mx = -INFINITY;
#pragma unroll
            for (int j = 0; j < 4; ++j) { const float lv = sub == 0 ? L[j] : sub == 1 ? L[4 + j] : sub == 2 ? L[8 + j] : L[12 + j];
                const unsigned code = 255u - (__float_as_uint(lv) & 255u), aa = code >> 4, bb = code & 15u;
                const unsigned k1 = topidx[P1 * 16 + aa], k2 = topidx[P2 * 16 + bb];
                ts[j] = sc[P1 * SC_LD + k1] + sc[P2 * SC_LD + k2]; myidx[j] = k1 * 128u + k2; mx = fmaxf(mx, ts[j]); }
            mx = fmaxf(mx, __shfl_xor(mx, 1)); mx = fmaxf(mx, __shfl_xor(mx, 2));
            float sum = 0.f;
#pragma unroll
            for (int j = 0; j < 4; ++j) { ts[j] = __expf(ts[j] - mx); sum += ts[j]; }
            sum += __shfl_xor(sum, 1); sum += __shfl_xor(sum, 2);
            const float inv = 1.0f / sum;
#pragma unroll
            for (int j = 0; j < 4; ++j) UL[(size_t)(tok0 + token) * 128 + w * 16 + 4 * sub + j] = (v2u){myidx[j], __float_as_uint(ts[j] * inv)};
        }
        LDS_WAIT(); asm volatile("" ::: "memory");
      }
      __syncthreads();
#define SW_LOAD(buf, T, sq_, i) do { const unsigned e_ = sq_[128 * g + (i)].x; const unsigned char* rp_ = (T) + (size_t)e_ * 1024 + 16 * li; \
            _Pragma("unroll") for (int c = 0; c < 4; ++c) buf[c] = *(const v4u*)(rp_ + 256 * c); } while (0)
      {
        int ln_ = C.tid; asm volatile("" : "+v"(ln_)); const int lane = ln_ & 63, g = lane >> 4, li = lane & 15;
        LAS v2u* seq0 = (LAS v2u*)(C.lds + PL_SEQ) + (w * 2 + 0) * 512;
        LAS v2u* seq1 = (LAS v2u*)(C.lds + PL_SEQ) + (w * 2 + 1) * 512;
        LAS unsigned* hist = (LAS unsigned*)(C.lds + PL_HIST) + w * 128;
        LAS int* al0 = (LAS int*)(C.lds + PL_AL) + (w * 2 + 0) * 512;
        LAS int* al1 = (LAS int*)(C.lds + PL_AL) + (w * 2 + 1) * 512;
        v4u xq[2][4]; float sxp[2];
#pragma unroll 1
        for (int pass = 0; pass < 2; ++pass) { v4u xqt[4]; float sxt;
          const int tokb = grp * 64 + 32 * pass + 4 * w, row = tokb + g;
          LAS v2u* seq = pass ? seq1 : seq0;
          hist[lane] = 0u; hist[64 + lane] = 0u;
          const float* xr = xio + (size_t)row * 1024 + 16 * li;
          { float rn; { const f32x4 ra = *(const f32x4*)(rsp + (size_t)row * 16), rb = *(const f32x4*)(rsp + (size_t)row * 16 + 4), rc = *(const f32x4*)(rsp + (size_t)row * 16 + 8), rd = *(const f32x4*)(rsp + (size_t)row * 16 + 12);
                const float ss = ((ra[0] + ra[1]) + (ra[2] + ra[3])) + ((rb[0] + rb[1]) + (rb[2] + rb[3])) + ((rc[0] + rc[1]) + (rc[2] + rc[3])) + ((rd[0] + rd[1]) + (rd[2] + rd[3]));
                rn = 1.0f / sqrtf(ss * (1.0f / 1024.0f) + RMS_EPS); }
            f32x4 n[4][4]; float mx = 0.f;
#pragma unroll
            for (int c = 0; c < 4; ++c)
#pragma unroll
                for (int j = 0; j < 4; ++j) { n[c][j] = *(const f32x4*)(xr + 256 * c + 4 * j) * rn * *(const f32x4*)(gffn + 256 * c + 16 * li + 4 * j);
                    mx = fmaxf(mx, fmaxf(fmaxf(fabsf(n[c][j].x), fabsf(n[c][j].y)), fmaxf(fabsf(n[c][j].z), fabsf(n[c][j].w)))); }
            mx = fmaxf(mx, __shfl_xor(mx, 8)); mx = fmaxf(mx, __shfl_xor(mx, 4)); mx = fmaxf(mx, __shfl_xor(mx, 2)); mx = fmaxf(mx, __shfl_xor(mx, 1));
            const float sx = mx > 0.f ? mx * (1.0f / 127.0f) : 1.0f, inv = 1.0f / sx; sxt = sx;
#pragma unroll
            for (int c = 0; c < 4; ++c)
#pragma unroll
                for (int j = 0; j < 4; ++j) { const int q0 = (int)rintf(n[c][j].x * inv), q1 = (int)rintf(n[c][j].y * inv), q2 = (int)rintf(n[c][j].z * inv), q3 = (int)rintf(n[c][j].w * inv);
                    xqt[c][j] = (unsigned)(q0 & 255) | ((unsigned)(q1 & 255) << 8) | ((unsigned)(q2 & 255) << 16) | ((unsigned)(q3 & 255) << 24); } }
          if (pass == 0) { sxp[0] = sxt;
#pragma unroll
              for (int c = 0; c < 4; ++c) xq[0][c] = xqt[c]; }
          else { sxp[1] = sxt;
#pragma unroll
              for (int c = 0; c < 4; ++c) xq[1][c] = xqt[c]; }
          { unsigned pe[8], pgb[8], prank[8];
            LDS_WAIT();
#pragma unroll
            for (int s8 = 0; s8 < 8; ++s8) { const v2u u = UL[(size_t)(tokb + (s8 >> 1)) * 128 + 64 * (s8 & 1) + lane]; pe[s8] = u.x; pgb[s8] = u.y;
                prank[s8] = __hip_atomic_fetch_add(hist + 32 * (s8 >> 1) + ((u.x >> 9) & 31u), 1u, __ATOMIC_RELAXED, __HIP_MEMORY_SCOPE_WAVEFRONT); }
            LDS_WAIT();
            unsigned c0 = hist[lane], c1 = hist[64 + lane], i0 = c0, i1 = c1;
#pragma unroll
            for (int o = 1; o < 32; o <<= 1) { const unsigned y0 = __shfl_up(i0, o), y1 = __shfl_up(i1, o); if ((lane & 31) >= o) { i0 += y0; i1 += y1; } }
            LDS_WAIT();
            hist[lane] = i0 - c0; hist[64 + lane] = i1 - c1;
            LDS_WAIT();
#pragma unroll
            for (int s8 = 0; s8 < 8; ++s8) seq[128 * (s8 >> 1) + hist[32 * (s8 >> 1) + ((pe[s8] >> 9) & 31u)] + prank[s8]] = (v2u){pe[s8], pgb[s8]};
            LDS_WAIT(); }
        }
#define SW_DOWN(buf, xqp, alp, i) do { int sacc = 0; _Pragma("unroll") for (int c = 0; c < 4; ++c) { sacc = __builtin_amdgcn_sdot4((int)buf[c].x, (int)xqp[c].x, sacc, false); sacc = __builtin_amdgcn_sdot4((int)buf[c].y, (int)xqp[c].y, sacc, false); \
                sacc = __builtin_amdgcn_sdot4((int)buf[c].z, (int)xqp[c].z, sacc, false); sacc = __builtin_amdgcn_sdot4((int)buf[c].w, (int)xqp[c].w, sacc, false); } \
            sacc += __shfl_xor(sacc, 8); sacc += __shfl_xor(sacc, 4); sacc += __shfl_xor(sacc, 2); sacc += __shfl_xor(sacc, 1); \
            if (li == 0) alp[128 * g + (i)] = sacc; } while (0)
        {
#define DLD(buf, k, par) do { if ((k) < 256) { if (par) SW_LOAD(buf, Dt, seq1, (k) >> 1); else SW_LOAD(buf, Dt, seq0, (k) >> 1); } } while (0)
#define DCP(buf, k, par) do { if ((k) < 256) { if (par) SW_DOWN(buf, xq[1], al1, (k) >> 1); else SW_DOWN(buf, xq[0], al0, (k) >> 1); } } while (0)
v4u b0[4], b1[4], b2[4], b3[4], b4[4];
          DLD(b0, 0, 0); DLD(b1, 1, 1); DLD(b2, 2, 0); DLD(b3, 3, 1);
#pragma unroll 1
          for (int kb = 0; kb < 256; kb += 10) {
              DLD(b4, kb + 4, 0); DCP(b0, kb + 0, 0);
              DLD(b0, kb + 5, 1); DCP(b1, kb + 1, 1);
              DLD(b1, kb + 6, 0); DCP(b2, kb + 2, 0);
              DLD(b2, kb + 7, 1); DCP(b3, kb + 3, 1);
              DLD(b3, kb + 8, 0); DCP(b4, kb + 4, 0);
              DLD(b4, kb + 9, 1); DCP(b0, kb + 5, 1);
              DLD(b0, kb + 10, 0); DCP(b1, kb + 6, 0);
              DLD(b1, kb + 11, 1); DCP(b2, kb + 7, 1);
              DLD(b2, kb + 12, 0); DCP(b3, kb + 8, 0);
              DLD(b3, kb + 13, 1); DCP(b4, kb + 9, 1);
          }
#undef DLD
#undef DCP
        }
#undef SW_DOWN
        LDS_WAIT();
        float tsinv[2];
#pragma unroll
        for (int pass = 0; pass < 2; ++pass) { LAS int* al = pass ? al1 : al0; LAS float* cl = (LAS float*)al; LAS v2u* seq = pass ? seq1 : seq0; const float sx = sxp[pass];
          const float sx0 = __uint_as_float(__builtin_amdgcn_readlane(__float_as_uint(sx), 0)), sx1 = __uint_as_float(__builtin_amdgcn_readlane(__float_as_uint(sx), 16)),
                      sx2 = __uint_as_float(__builtin_amdgcn_readlane(__float_as_uint(sx), 32)), sx3 = __uint_as_float(__builtin_amdgcn_readlane(__float_as_uint(sx), 48));
          float cv[8];
#pragma unroll
          for (int s8 = 0; s8 < 8; ++s8) { const int idx = 64 * s8 + lane; const v2u ent = seq[idx]; const unsigned ee = ent.x;
              const float sd = tsc[ee], su = tsc[NEXP + ee]; const float sxl = (s8 >> 1) == 0 ? sx0 : (s8 >> 1) == 1 ? sx1 : (s8 >> 1) == 2 ? sx2 : sx3;
              const float av = (float)al[idx]; cv[s8] = __uint_as_float(ent.y) * su * gelu_erf(av * (sd * sxl)); }
          float tsl = 1.f;
#pragma unroll
          for (int t4 = 0; t4 < 4; ++t4) { const float m = wave_max(fmaxf(fabsf(cv[2 * t4]), fabsf(cv[2 * t4 + 1])));
              const float sc = m > 0.f ? exp2f(-ceilf(log2f(m))) : 1.f;
              cl[128 * t4 + lane] = cv[2 * t4] * sc; cl[128 * t4 + 64 + lane] = cv[2 * t4 + 1] * sc; if (g == t4) tsl = sc; }
          tsinv[pass] = 1.0f / tsl; }
        LDS_WAIT();
        { const LAS float* cl0 = (const LAS float*)al0; const LAS float* cl1 = (const LAS float*)al1;
          typedef _Float16 h2 __attribute__((ext_vector_type(2)));
          h2 acc0[2][16], acc1[2][16];
#pragma unroll
          for (int c = 0; c < 2; ++c)
#pragma unroll
              for (int i = 0; i < 16; ++i) { acc0[c][i] = (h2){(_Float16)0.f, (_Float16)0.f}; acc1[c][i] = (h2){(_Float16)0.f, (_Float16)0.f}; }
#define SW_LOADU(buf, sq_, i) do { const unsigned e_ = sq_[128 * g + (i)].x; const unsigned char* rp_ = Ut + (size_t)e_ * 768; \
            buf[0].a4 = *(const v4u*)(rp_ + 16 * li); buf[0].b4 = *(const v4u*)(rp_ + 256 + 16 * li); buf[0].a2 = *(const v2u*)(rp_ + 512 + 8 * li); buf[0].b2 = *(const v2u*)(rp_ + 640 + 8 * li); } while (0)
#define SW_UP(buf, accp, clp, i) do { const _Float16 ch_ = (_Float16)clp[128 * g + (i)]; const h2 cc_ = {ch_, ch_}; \
            _Pragma("unroll") for (int c = 0; c < 2; ++c) { const v6u s6_ = c ? (v6u){buf[0].b4.x, buf[0].b4.y, buf[0].b4.z, buf[0].b4.w, buf[0].b2.x, buf[0].b2.y} : (v6u){buf[0].a4.x, buf[0].a4.y, buf[0].a4.z, buf[0].a4.w, buf[0].a2.x, buf[0].a2.y}; \
                const h32 r_ = __builtin_amdgcn_cvt_scalef32_pk32_f16_fp6(s6_, 1.0f); \
                _Pragma("unroll") for (int q = 0; q < 16; ++q) { const h2 t_ = {r_[2 * q], r_[2 * q + 1]}; accp[c][q] = t_ * cc_ + accp[c][q]; } \
                asm volatile("" : "+v"(accp[c][0]), "+v"(accp[c][1]), "+v"(accp[c][2]), "+v"(accp[c][3]), "+v"(accp[c][4]), "+v"(accp[c][5]), "+v"(accp[c][6]), "+v"(accp[c][7]), \
                                  "+v"(accp[c][8]), "+v"(accp[c][9]), "+v"(accp[c][10]), "+v"(accp[c][11]), "+v"(accp[c][12]), "+v"(accp[c][13]), "+v"(accp[c][14]), "+v"(accp[c][15])); } } while (0)
          {
#define ULD(buf, k, par) do { if ((k) < 256) { if (par) SW_LOADU(buf, seq1, (k) >> 1); else SW_LOADU(buf, seq0, (k) >> 1); } } while (0)
#define UCP(buf, k, par) do { if ((k) < 256) { if (par) SW_UP(buf, acc1, cl1, (k) >> 1); else SW_UP(buf, acc0, cl0, (k) >> 1); } } while (0)
UB b0[4], b1[4], b2[4], b3[4], b4[4], b5[4], b6[4], b7[4];
          ULD(b0, 0, 0); ULD(b1, 1, 1); ULD(b2, 2, 0); ULD(b3, 3, 1); ULD(b4, 4, 0); ULD(b5, 5, 1); ULD(b6, 6, 0);
#pragma unroll 1
          for (int kb = 0; kb < 256; kb += 8) {
              ULD(b7, kb + 7, 1); UCP(b0, kb + 0, 0);
              ULD(b0, kb + 8, 0); UCP(b1, kb + 1, 1);
              ULD(b1, kb + 9, 1); UCP(b2, kb + 2, 0);
              ULD(b2, kb + 10, 0); UCP(b3, kb + 3, 1);
              ULD(b3, kb + 11, 1); UCP(b4, kb + 4, 0);
              ULD(b4, kb + 12, 0); UCP(b5, kb + 5, 1);
              ULD(b5, kb + 13, 1); UCP(b6, kb + 6, 0);
              ULD(b6, kb + 14, 0); UCP(b7, kb + 7, 1);
          }
#undef ULD
#undef UCP
          }
#undef SW_UP
#undef SW_LOADU
#define SW_OUT(accp, pass) do { const int row = grp * 64 + 32 * (pass) + 4 * w + g; float* xr = xio + (size_t)row * 1024 + 4 * li; float ss = 0.f; const float ti_ = tsinv[pass]; \
            _Pragma("unroll") for (int c = 0; c < 2; ++c) { \
                _Pragma("unroll") for (int q = 0; q < 8; ++q) { float* xp_ = xr + 512 * c + 64 * q; \
                    const f32x4 y = *(const f32x4*)xp_ + (f32x4){(float)accp[c][2 * q].x, (float)accp[c][2 * q].y, (float)accp[c][2 * q + 1].x, (float)accp[c][2 * q + 1].y} * ti_; *(f32x4*)xp_ = y; \
                    ss += (y.x * y.x + y.y * y.y) + (y.z * y.z + y.w * y.w); \
                    if (!LAST) { bf16* xb = (bf16*)(ws + WS_XB) + (size_t)row * 1024 + 512 * c + 64 * q + 4 * li; *(v2u*)xb = (v2u){pk2(y.x, y.y), pk2(y.z, y.w)}; } } } \
            if (!LAST) { ss += __shfl_xor(ss, 8); ss += __shfl_xor(ss, 4); ss += __shfl_xor(ss, 2); ss += __shfl_xor(ss, 1); \
                if (li == 0) ((float*)(ws + WS_RA1))[row] = 1.0f / sqrtf(ss * (1.0f / 1024.0f) + RMS_EPS); } } while (0)
          SW_OUT(acc0, 0); SW_OUT(acc1, 1);
#undef SW_OUT
        }
      }
#undef SW_LOAD
      __syncthreads();
    }
}

constexpr int CW_GRP = 8192, CW_XID = 16384;
struct GroupOrder {
    int nN, c, G4, nM;
    __device__ bool next(int i, pg8::Unit& u) const {
        const bool five = nN == 5 && (c & 3) == 0; const int j = five ? (i >> 1) : i, pm = (c >> 2) + j * G4; if (pm >= nM) return false;
        u.pm = pm; u.pn = (five && (i & 1)) ? 4 : (c & 3); return true; }
    __device__ __forceinline__ void a_ready(const pg8::Unit&) const {}
    __device__ __forceinline__ void done(const pg8::Unit&) const {}
};
__device__ __forceinline__ void sub_barrier(gu32* ctl, int cword, unsigned target, volatile LAS unsigned* same_xcd) {
    asm volatile("s_waitcnt vmcnt(0)" ::: "memory");
    __syncthreads();
    if (threadIdx.x == 0) {
        unsigned* cnt = (unsigned*)ctl + cword; unsigned* bar = (unsigned*)ctl + CW_BAR;
        if (same_xcd[0] != 1u) { __builtin_amdgcn_fence(__ATOMIC_RELEASE, "agent"); asm volatile("s_waitcnt vmcnt(0)" ::: "memory"); }
        (void)xb_add(cnt, 1u);
        XB_SPIN(xb_ld(cnt) < target, bar);
        __builtin_amdgcn_fence(__ATOMIC_ACQUIRE, "agent");
        asm volatile("s_waitcnt vmcnt(0)" ::: "memory");
    }
    __syncthreads();
}

__device__ __forceinline__ void grp_barrier(gu32* ctl, int vcu, unsigned target, volatile LAS unsigned* same_xcd) { sub_barrier(ctl, CW_GRP + 64 * (vcu >> 2), target, same_xcd); }
constexpr int CW_GRP16 = 12288;
struct PairOrder { int c; __device__ bool next(int i, pg8::Unit& u) const { if (i) return false; u.pm = c >> 1; u.pn = c & 1; return true; }
    __device__ __forceinline__ void a_ready(const pg8::Unit&) const {} __device__ __forceinline__ void done(const pg8::Unit&) const {} };

__global__ void __launch_bounds__(NWAVES * 64, 2) mk_fwd(Args args) {
    extern __shared__ __attribute__((aligned(16))) unsigned char lds[];
    Ctx C; C.lds = lds; C.tid = threadIdx.x; C.lane = C.tid & 63; C.wave = __builtin_amdgcn_readfirstlane(C.tid >> 6);
    C.G = gridDim.x; { const int bx = blockIdx.x; C.vcu = (C.G % 8 == 0) ? (bx % 8) * (C.G / 8) + bx / 8 : bx; }
    LAS unsigned char* lds3 = (LAS unsigned char*)lds;
    volatile LAS unsigned* MISC = (volatile LAS unsigned*)(lds3 + MISC_OFF);
    for (int u = C.tid; u < (LDS_BYTES - LDSCTL_OFF) / 4; u += NWAVES * 64) ((LAS unsigned*)(lds3 + LDSCTL_OFF))[u] = 0u;
    __syncthreads();
    unsigned char* ws = args.ws;
    gu32* ctl = (gu32*)(ws + WS_CTL);
    XcdBarrier bar; bar.bar = (unsigned*)(ctl + CW_BAR); bar.x = 0; bar.st = nullptr;
    if (N_LAUNCHES == 1) bar = xcd_barrier_post((unsigned*)(ctl + CW_BAR), MISC + 8);
    const bool merged23 = false && (N_LAUNCHES == 1) && C.G == 256;
    const bool grouped = (N_LAUNCHES == 1);
    if (grouped && C.tid == 0) __hip_atomic_store((unsigned*)ctl + CW_XID + C.vcu, xb_xcc_id() + 1u, RLX_AGENT);
    const int lo = args.ph_lo, hi = args.ph_hi;
#ifdef ONLY_PHASE
#define IN(k) ((k) == ONLY_PHASE && lo <= (k) && (k) < hi)
#else
#define IN(k) (lo <= (k) && (k) < hi)
#endif
#ifndef PROBE_XBAR
#define PROBE_XBAR 0
#endif
#define SEAM(k) do { if (IN(k) && IN((k) + 1)) { xcd_barrier(bar); if ((k) == 6) for (int xb_ = 0; xb_ < PROBE_XBAR; ++xb_) xcd_barrier(bar); } } while (0)
#define GSEAM(k, n) do { if (IN(k) && IN((k) + 1)) { if (grouped) grp_barrier(ctl, C.vcu, 4u * (n), MISC + 10); else xcd_barrier(bar); } } while (0)
#ifndef PROBE_MASK
#define PROBE_MASK 0
#endif
#define REPS(k) ((((PROBE_MASK) >> (k)) & 1) ? 2 : 1)
    bf16* xb = (bf16*)(ws + WS_XB);
    if (IN(0)) { for (int rep = 0; rep < REPS(0); ++rep) { p0_prologue(args, C); __syncthreads(); } SEAM(0); }
    if (grouped) { if (C.tid == 0) { const unsigned* xi = (const unsigned*)ctl + CW_XID + (C.vcu & ~3); const unsigned a0 = xb_ld((unsigned*)xi), a1 = xb_ld((unsigned*)xi + 1), a2 = xb_ld((unsigned*)xi + 2), a3 = xb_ld((unsigned*)xi + 3);
          MISC[10] = (a0 != 0u && a0 == a1 && a0 == a2 && a0 == a3) ? 1u : 2u;
          const unsigned* xj = (const unsigned*)ctl + CW_XID + (C.vcu & ~15); bool same16 = a0 != 0u;
          for (int i = 0; i < 16; ++i) same16 = same16 && (xb_ld((unsigned*)xj + i) == a0);
          MISC[11] = same16 ? 1u : 2u; }
        __syncthreads(); }
    if (IN(1)) for (int rep = 0; rep < REPS(1); ++rep) {
        pg8::Gemm g{xb, (const bf16*)(ws + WS_WIN0), M, EV_N - 512, DMODEL}; pg8::StaticOrder S; S.init(M, EV_N - 512, C.G, (int)blockIdx.x);
        pg8::EpiProj<0> E{(const float*)(ws + WS_RA0), (const float*)(ws + WS_ROPE), (bf16*)(ws + WS_QKV), nullptr, nullptr, (const float*)(ws + WS_GAIN), (float*)(ws + WS_KSUM), 0};
        pg8::gemm_phase<pg8::EpiProj<0>, pg8::StaticOrder, true, true>(lds3, g, S, E);
        if (rep + 1 == REPS(1)) SEAM(1); }
    if (IN(2)) {
        const int nr = C.G / 2;
        if (C.vcu < nr) { p2_route(args, C, C.vcu, nr);
            if (merged23) { sub_barrier(ctl, CW_GRP16 + 64 * (C.vcu >> 4), 16u, MISC + 11); const int hh = C.vcu >> 4;
                for (int idx = C.vcu & 15; idx < 62; idx += 16) p3_lists_item(args, C, hh + 8 * (idx / 31), idx % 31); } }
        else { pg8::Gemm g{xb, (const bf16*)(ws + WS_WIN0) + (size_t)(EV_N - 512) * DMODEL, M, 512, DMODEL}; PairOrder S{C.vcu - nr};
            pg8::EpiProj<0> E{(const float*)(ws + WS_RA0), (const float*)(ws + WS_ROPE), (bf16*)(ws + WS_QKV), nullptr, nullptr, (const float*)(ws + WS_GAIN), (float*)(ws + WS_KSUM), 12};
            pg8::gemm_phase<pg8::EpiProj<0>, PairOrder, true, true>(lds3, g, S, E); }
        SEAM(2); }
    if (IN(3) && !merged23) { for (int rep = 0; rep < REPS(3); ++rep) p3_lists(args, C); SEAM(3); }
    if (IN(4)) { for (int rep = 0; rep < REPS(4); ++rep) p4_attn_l0a(args, C); SEAM(4); }
    if (IN(5)) { for (int rep = 0; rep < REPS(5); ++rep) p5_attn_l0b(args, C); GSEAM(5, 1); }
    if (IN(6)) {
        pg8::Gemm g{(const bf16*)(ws + WS_AO), (const bf16*)(ws + WS_WOUT0), M, DMODEL, DMODEL};
        pg8::EpiResid E{args.in[0], args.out, xb, (float*)(ws + WS_RSP)};
        { GroupOrder S{4, C.vcu, C.G >> 2, M / 256}; pg8::gemm_phase<pg8::EpiResid, GroupOrder, true, true>(lds3, g, S, E); }
        GSEAM(6, 2); }
    if (IN(7)) for (int rep = 0; rep < REPS(7); ++rep) {
        pg8::Gemm g{xb, (const bf16*)(ws + WS_WQ0), M, DMODEL, DMODEL};
        pg8::EpiPeerQ E{(const float*)(ws + WS_RSP), (bf16*)(ws + WS_QP)};
        { GroupOrder S{4, C.vcu, C.G >> 2, M / 256}; pg8::gemm_phase<pg8::EpiPeerQ, GroupOrder, true, true>(lds3, g, S, E); }
        if (rep + 1 == REPS(7)) GSEAM(7, 3); }
    if (IN(8)) { peer_phase<false>(args, C, 0); GSEAM(8, 4); }
    if (IN(9)) for (int rep = 0; rep < REPS(9); ++rep) {
        pg8::Gemm g{xb, (const bf16*)(ws + WS_WIN1), M, OD_N, DMODEL};
        pg8::EpiProj<1> E{(const float*)(ws + WS_RA1), (const float*)(ws + WS_ROPE), (bf16*)(ws + WS_QKV), (bf16*)(ws + WS_QKV + 32 * MiB), (bf16*)(ws + WS_QKV + 36 * MiB), (const float*)(ws + WS_GAIN) + 256, nullptr, 0};
        { GroupOrder S{5, C.vcu, C.G >> 2, M / 256}; pg8::gemm_phase<pg8::EpiProj<1>, GroupOrder, true, true>(lds3, g, S, E); }
        if (CONV_L1_LATE == 2 && rep == 0) conv_pull(args, C, 1);
        if (rep + 1 == REPS(9)) SEAM(9); }
    if (IN(10)) { for (int rep = 0; rep < REPS(10); ++rep) p8_attn_l1(args, C); GSEAM(10, 5); }
    if (IN(11)) {
        pg8::Gemm g{(const bf16*)(ws + WS_AO), (const bf16*)(ws + WS_WOUT1), M, DMODEL, DMODEL};
        pg8::EpiResid E{args.out, args.out, xb, (float*)(ws + WS_RSP)};
        { GroupOrder S{4, C.vcu, C.G >> 2, M / 256}; pg8::gemm_phase<pg8::EpiResid, GroupOrder, true, true>(lds3, g, S, E); }
        GSEAM(11, 6); }
    if (IN(12)) for (int rep = 0; rep < REPS(12); ++rep) {
        pg8::Gemm g{xb, (const bf16*)(ws + WS_WQ1), M, DMODEL, DMODEL};
        pg8::EpiPeerQ E{(const float*)(ws + WS_RSP), (bf16*)(ws + WS_QP)};
        { GroupOrder S{4, C.vcu, C.G >> 2, M / 256}; pg8::gemm_phase<pg8::EpiPeerQ, GroupOrder, true, true>(lds3, g, S, E); }
        if (rep + 1 == REPS(12)) GSEAM(12, 7); }
    if (IN(13)) { peer_phase<true>(args, C, 1); }
#undef IN
#undef SEAM
}

extern "C" void kernel_launch(void* const* d_in, const int* in_sizes, int n_in, void* d_out, int out_size, void* d_ws, size_t ws_size, hipStream_t stream) {
    static int grid = 0;
    if (grid == 0) {
        if (n_in != 19 || in_sizes[0] != M * DMODEL || out_size != M * DMODEL || ws_size < WS_END) { fprintf(stderr, "kernel_launch: unexpected shapes (n_in %d, in0 %d, out %d, ws %zu); nothing launched\n", n_in, n_in > 0 ? in_sizes[0] : -1, out_size, ws_size); grid = -1; return; }
        int dev = 0, cus = 0, per_cu = 0;
        if (hipGetDevice(&dev) != hipSuccess || hipDeviceGetAttribute(&cus, hipDeviceAttributeMultiprocessorCount, dev) != hipSuccess) { grid = -1; return; }
        if (hipFuncSetAttribute((const void*)mk_fwd, hipFuncAttributeMaxDynamicSharedMemorySize, LDS_BYTES) != hipSuccess) { fprintf(stderr, "kernel_launch: hipFuncSetAttribute failed\n"); grid = -1; return; }
        if (hipOccupancyMaxActiveBlocksPerMultiprocessor(&per_cu, (const void*)mk_fwd, NWAVES * 64, LDS_BYTES) != hipSuccess || per_cu < 1) { fprintf(stderr, "kernel_launch: occupancy query reports %d workgroups per CU\n", per_cu); }
        (void)hipGetLastError();
        grid = cus > 256 ? 256 : (cus / 8) * 8;
        if (grid != 256) fprintf(stderr, "kernel_launch: %d CUs; the phase schedules assume 256\n", grid);
    }
    if (grid < 0) return;
    if (hipMemsetAsync((char*)d_ws + WS_CTL, 0, CTL_ZERO_BYTES, stream) != hipSuccess) { fprintf(stderr, "kernel_launch: hipMemsetAsync failed\n"); return; }
    Args a{};
    for (int i = 0; i < 19; ++i) a.in[i] = (const float*)d_in[i];
    a.out = (float*)d_out; a.ws = (unsigned char*)d_ws;
    for (int li = 0; li < N_LAUNCHES; ++li) {
        a.ph_lo = (N_LAUNCHES == 1) ? 0 : li; a.ph_hi = (N_LAUNCHES == 1) ? N_PHASES : li + 1; a.li = li;
        hipLaunchKernelGGL(mk_fwd, dim3(grid), dim3(NWAVES * 64), LDS_BYTES, stream, a);
        const hipError_t le = hipPeekAtLastError();
        if (le != hipSuccess) { fprintf(stderr, "kernel_launch: launch %d failed: %s\n", li, hipGetErrorName(le)); break; }
    }
}
```

```cpp
#define MK_N_LAUNCHES 1
#include <hip/hip_runtime.h>
#include <cstdio>
#include <cstdint>
namespace pg8 {
#define PG8_LAS __attribute__((address_space(3)))
typedef unsigned short bf16_t;
typedef short bf16x8 __attribute__((ext_vector_type(8)));
typedef float f32x4 __attribute__((ext_vector_type(4)));
typedef unsigned u32x4 __attribute__((ext_vector_type(4)));
constexpr int BM = 256, BK = 64, HALF = 128, HTB = HALF * BK * 2  , STAGE_BYTES = 8 * HTB, NXCD = 8, WGM = 8;

__host__ __device__ __forceinline__ int lds_byte(int r, int c) { const int st = (r >> 4) * 2 + (c >> 5), rr = r & 15, cc = c & 31, ob = rr * 64 + cc * 2; return st * 1024 + (ob ^ (((ob >> 9) & 1) << 5)); }
__host__ __device__ __forceinline__ void stage_rc(int b, int& R, int& C) { const int st = b / 1024, sb = b % 1024, swz = sb ^ (((sb >> 9) & 1) << 5); R = (st >> 1) * 16 + swz / 64; C = (st & 1) * 32 + (swz % 64) / 2; }
__host__ __device__ __forceinline__ int perm32(int rho) { const int n = rho >> 4, i = rho & 15; return 8 * (i >> 2) + 4 * n + (i & 3); }

struct Unit { int pm, pn; };
struct Gemm { const bf16_t* A; const bf16_t* Bt; int M, N, K; };

struct StaticOrder {
    int nM, nN, nwg, G, c;
    __host__ __device__ void init(int M, int N, int G_, int c_) { nM = M / BM; nN = N / BM; nwg = nM * nN; G = G_; c = c_; }
    __host__ __device__ bool next(int i, Unit& u) const {
        const long L = (long)i * G + c; if (L >= nwg) return false;
        int wgid = (int)L; { const int q = nwg / NXCD, r = nwg % NXCD, xcd = wgid % NXCD, off = wgid / NXCD; wgid = (xcd < r ? xcd * (q + 1) : r * (q + 1) + (xcd - r) * q) + off; }
        const int nig = WGM * nN, gid = wgid / nig, fm = gid * WGM, gsz = (nM - fm) < WGM ? (nM - fm) : WGM;
        u.pm = fm + ((wgid % nig) % gsz); u.pn = (wgid % nig) / gsz; return true;
    }
    __device__ __forceinline__ void a_ready(const Unit&) const {}
    __device__ __forceinline__ void done(const Unit&) const {}
};

__device__ __forceinline__ unsigned cvt_pk_bf16(float lo, float hi) { unsigned r; asm volatile("v_cvt_pk_bf16_f32 %0, %1, %2" : "=v"(r) : "v"(lo), "v"(hi)); return r; }
typedef float f32x2 __attribute__((ext_vector_type(2)));
__device__ __forceinline__ f32x2 gelu_pk(f32x2 v) {
    const f32x2 av = __builtin_elementwise_abs(v), d = av * 0.2316418882f + 1.0f;
    f32x2 t; t.x = __builtin_amdgcn_rcpf(d.x); t.y = __builtin_amdgcn_rcpf(d.y);
    f32x2 q = t * 0.5307027145f + (-0.7265760135f); q = q * t + 0.7107068705f; q = q * t + (-0.142248368f); q = q * t + 0.127414796f; q = q * t;
    const f32x2 s = (v * v) * (-0.72134752044f);
    f32x2 e; e.x = __builtin_amdgcn_exp2f(s.x); e.y = __builtin_amdgcn_exp2f(s.y);
    const f32x2 m = v * (q * e), r = v - m;
    f32x2 o; o.x = v.x < 0.f ? m.x : r.x; o.y = v.y < 0.f ? m.y : r.y; return o;
}

template <int ACT  > struct EpiBf16 {
    static constexpr bool PERM = true, AFTER_DRAIN = false; static_assert(ACT == 0 || ACT == 1, "EpiBf16: ACT is 0 (none) or 1 (gelu_pk)");
    bf16_t* O; int ldc; const float* bias; int split_cols; size_t split_stride; float scale0;
    __device__ __forceinline__ void operator()(const f32x4 (&acc)[2][2][4][2], const Unit& u, int wr, int wc, int fr, int fq) const {
        const int row0 = u.pm * BM + wr * 64 + fr; int colt = u.pn * BM; bf16_t* base = O;
        float sc = 1.f; if (split_cols) { const int t = colt / split_cols; base += (size_t)t * split_stride; colt -= t * split_cols; if (t == 0) sc = scale0; }
        const int col0 = colt + wc * 32 + 8 * fq, bcol0 = u.pn * BM + wc * 32 + 8 * fq;
        f32x4 bv[2][2];
#pragma unroll
        for (int bj = 0; bj < 2; ++bj)
#pragma unroll
            for (int n = 0; n < 2; ++n) bv[bj][n] = bias ? *(const f32x4*)(bias + bcol0 + bj * HALF + 4 * n) : (f32x4){0.f, 0.f, 0.f, 0.f};
#pragma unroll
        for (int ai = 0; ai < 2; ++ai)
#pragma unroll
            for (int m = 0; m < 4; ++m) { bf16_t* rowp = base + (size_t)(row0 + ai * HALF + m * 16) * ldc + col0;
#pragma unroll
                for (int bj = 0; bj < 2; ++bj) { f32x4 v0 = acc[ai][bj][m][0] + bv[bj][0], v1 = acc[ai][bj][m][1] + bv[bj][1];
                    if (ACT == 1) { f32x2 a = gelu_pk((f32x2){v0[0], v0[1]}), b = gelu_pk((f32x2){v0[2], v0[3]}), c = gelu_pk((f32x2){v1[0], v1[1]}), d = gelu_pk((f32x2){v1[2], v1[3]});
                        v0 = (f32x4){a.x, a.y, b.x, b.y}; v1 = (f32x4){c.x, c.y, d.x, d.y}; }
                    v0 = v0 * sc; v1 = v1 * sc; u32x4 w; w.x = cvt_pk_bf16(v0[0], v0[1]); w.y = cvt_pk_bf16(v0[2], v0[3]); w.z = cvt_pk_bf16(v1[0], v1[1]); w.w = cvt_pk_bf16(v1[2], v1[3]);
                    *(u32x4*)(rowp + bj * HALF) = w; } }
    }
};

template <class Epi, class Sched, bool ALIGN_EPI = false, bool SP2 = false>
__device__ __forceinline__ void gemm_phase(PG8_LAS unsigned char* lds, const Gemm g, const Sched& S, const Epi& E) {
    const int tid = threadIdx.x, wid = __builtin_amdgcn_readfirstlane(tid >> 6), lane = tid & 63, wr = wid >> 2, wc = wid & 3, fr = lane & 15, fq = lane >> 4;
    const int K = g.K, nt = K / BK;
    unsigned voffA[2], voffB[2];
#pragma unroll
    for (int i = 0; i < 2; ++i) { int R, C; stage_rc(tid * 16 + i * 8192, R, C); const int Rb = Epi::PERM ? ((R & ~31) + perm32(R & 31)) : R;
        voffA[i] = (unsigned)(R * K + C) * 2u; voffB[i] = (unsigned)(Rb * K + C) * 2u; }
    const size_t kstep = (size_t)(BK * 2);
    const size_t hstep = (size_t)HALF * K * 2;
    const size_t tstep = 2 * hstep;
    const unsigned ldsw = (unsigned)wid * 1024u;
    const int aoff = lds_byte(wr * 64 + fr, fq * 8), boff = lds_byte(wc * 32 + fr, fq * 8);
#define PG8_SA(b, h) (((b) * 2 + (h)) * HTB)
#define PG8_SB(b, h) ((4 + (b) * 2 + (h)) * HTB)
#define PG8_STAGE(bufoff, gbase, voff) do { _Pragma("unroll") for (int _i = 0; _i < 2; ++_i) \
        __builtin_amdgcn_global_load_lds((const unsigned*)((const char*)(gbase) + (voff)[_i]), (PG8_LAS unsigned*)(lds + (bufoff) + ldsw + _i * 8192), 16, 0, 0); } while (0)
#define PG8_LDA(dst, b, h) do { _Pragma("unroll") for (int m = 0; m < 4; ++m) _Pragma("unroll") for (int k = 0; k < 2; ++k) dst[m][k] = *(const PG8_LAS bf16x8*)(lds + PG8_SA(b, h) + aoff + m * 2048 + k * 1024); } while (0)
#define PG8_LDB(dst, b, h) do { _Pragma("unroll") for (int n = 0; n < 2; ++n) _Pragma("unroll") for (int k = 0; k < 2; ++k) dst[n][k] = *(const PG8_LAS bf16x8*)(lds + PG8_SB(b, h) + boff + n * 2048 + k * 1024); } while (0)
#define PG8_MMA(ai, bj, At, Bt) do { __builtin_amdgcn_s_setprio(1); _Pragma("unroll") for (int m = 0; m < 4; ++m) _Pragma("unroll") for (int n = 0; n < 2; ++n) _Pragma("unroll") for (int k = 0; k < 2; ++k) \
        acc[ai][bj][m][n] = __builtin_amdgcn_mfma_f32_16x16x32_bf16(Bt[n][k], At[m][k], acc[ai][bj][m][n], 0, 0, 0); __builtin_amdgcn_s_setprio(0); } while (0)
#define PG8_WAIT_V(n) asm volatile("s_waitcnt vmcnt(" #n ")" ::: "memory")
#define PG8_WAIT_L(n) asm volatile("s_waitcnt lgkmcnt(" #n ")" ::: "memory")
#define PG8_BAR __builtin_amdgcn_s_barrier()
#define PG8_SCHED __builtin_amdgcn_sched_barrier(0)
    Unit cur, nxt; int ui = 0;
    if (!S.next(0, cur)) return;
    f32x4 acc[2][2][4][2];
#pragma unroll
    for (int a = 0; a < 2; ++a)
#pragma unroll
        for (int b = 0; b < 2; ++b)
#pragma unroll
            for (int m = 0; m < 4; ++m)
#pragma unroll
                for (int n = 0; n < 2; ++n) acc[a][b][m][n] = (f32x4){0.f, 0.f, 0.f, 0.f};
    bf16x8 At[4][2], B0[2][2], B1[2][2];
    const char* cA = (const char*)g.A + (size_t)cur.pm * tstep; const char* cB = (const char*)g.Bt + (size_t)cur.pn * tstep;
    S.a_ready(cur);
    if constexpr (SP2) {
        PG8_STAGE(PG8_SB(0, 0), cB, voffB); PG8_STAGE(PG8_SB(0, 1), cB + hstep, voffB); PG8_STAGE(PG8_SA(0, 0), cA, voffA); PG8_STAGE(PG8_SA(0, 1), cA + hstep, voffA);
        if (wr == 1) PG8_BAR;
        PG8_WAIT_V(2); PG8_BAR;
        PG8_STAGE(PG8_SB(1, 0), cB + kstep, voffB); PG8_STAGE(PG8_SA(1, 0), cA + kstep, voffA); PG8_STAGE(PG8_SB(1, 1), cB + hstep + kstep, voffB);
        PG8_WAIT_V(6); PG8_BAR;
    } else {
        PG8_STAGE(PG8_SB(0, 0), cB, voffB); PG8_STAGE(PG8_SA(0, 0), cA, voffA); PG8_STAGE(PG8_SB(0, 1), cB + hstep, voffB); PG8_STAGE(PG8_SA(0, 1), cA + hstep, voffA);
        if (wr == 1) PG8_BAR;
        PG8_WAIT_V(4); PG8_BAR;
        PG8_STAGE(PG8_SB(1, 0), cB + kstep, voffB); PG8_STAGE(PG8_SA(1, 0), cA + kstep, voffA); PG8_STAGE(PG8_SB(1, 1), cB + hstep + kstep, voffB);
        PG8_WAIT_V(6); PG8_BAR;
    }
    for (;;) {
        const bool has_next = S.next(ui + 1, nxt);
        const char* nA = has_next ? (const char*)g.A + (size_t)nxt.pm * tstep : cA; const char* nB = has_next ? (const char*)g.Bt + (size_t)nxt.pn * tstep : cB;
        for (int t = 0; t < nt; t += 2) {
            const bool last = (t == nt - 2);
            const char* a1 = cA + (size_t)(t + 1) * kstep;
            const char* a2 = last ? nA : cA + (size_t)(t + 2) * kstep; const char* b2 = last ? nB : cB + (size_t)(t + 2) * kstep;
            const char* a3 = a2 + kstep; const char* b3 = b2 + kstep;
            if (last && has_next) S.a_ready(nxt);
            if constexpr (SP2) {
            PG8_LDB(B0, 0, 0); PG8_LDB(B1, 0, 1); PG8_SCHED; PG8_LDA(At, 0, 0); PG8_STAGE(PG8_SA(1, 1), a1 + hstep, voffA);
            PG8_WAIT_V(8); PG8_WAIT_L(0); PG8_BAR; PG8_MMA(0, 0, At, B0); PG8_MMA(0, 1, At, B1); PG8_BAR; PG8_SCHED;
            PG8_LDA(At, 0, 1); PG8_STAGE(PG8_SB(0, 0), b2, voffB); PG8_STAGE(PG8_SB(0, 1), b2 + hstep, voffB); PG8_STAGE(PG8_SA(0, 0), a2, voffA);
            PG8_WAIT_V(8); PG8_WAIT_L(0); PG8_BAR; PG8_MMA(1, 0, At, B0); PG8_MMA(1, 1, At, B1); PG8_BAR; PG8_SCHED;
            PG8_LDB(B0, 1, 0); PG8_LDB(B1, 1, 1); PG8_SCHED; PG8_LDA(At, 1, 0); PG8_STAGE(PG8_SA(0, 1), a2 + hstep, voffA);
            PG8_WAIT_V(8); PG8_WAIT_L(0); PG8_BAR; PG8_MMA(0, 0, At, B0); PG8_MMA(0, 1, At, B1); PG8_BAR; PG8_SCHED;
            PG8_LDA(At, 1, 1); PG8_STAGE(PG8_SB(1, 0), b3, voffB); PG8_STAGE(PG8_SB(1, 1), b3 + hstep, voffB); PG8_STAGE(PG8_SA(1, 0), a3, voffA);
            PG8_WAIT_V(8); PG8_WAIT_L(0); PG8_BAR; PG8_MMA(1, 0, At, B0); PG8_MMA(1, 1, At, B1); PG8_BAR; PG8_SCHED;
            } else {
            PG8_LDB(B0, 0, 0); PG8_SCHED; PG8_LDA(At, 0, 0); PG8_STAGE(PG8_SA(1, 1), a1 + hstep, voffA);
            PG8_WAIT_L(8); PG8_BAR; PG8_WAIT_L(0); PG8_MMA(0, 0, At, B0); PG8_BAR; PG8_SCHED;
            PG8_LDB(B1, 0, 1); PG8_STAGE(PG8_SB(0, 0), b2, voffB);
            PG8_BAR; PG8_WAIT_L(0); PG8_MMA(0, 1, At, B1); PG8_BAR;
            PG8_LDA(At, 0, 1); PG8_STAGE(PG8_SA(0, 0), a2, voffA);
            PG8_BAR; PG8_WAIT_L(0); PG8_MMA(1, 0, At, B0); PG8_BAR; PG8_SCHED;
            PG8_STAGE(PG8_SB(0, 1), b2 + hstep, voffB);
            PG8_WAIT_V(6); PG8_BAR; PG8_MMA(1, 1, At, B1); PG8_BAR;
            PG8_LDB(B0, 1, 0); PG8_SCHED; PG8_LDA(At, 1, 0); PG8_STAGE(PG8_SA(0, 1), a2 + hstep, voffA);
            PG8_WAIT_L(8); PG8_BAR; PG8_WAIT_L(0); PG8_MMA(0, 0, At, B0); PG8_BAR; PG8_SCHED;
            PG8_LDB(B1, 1, 1); PG8_STAGE(PG8_SB(1, 0), b3, voffB);
            PG8_BAR; PG8_WAIT_L(0); PG8_MMA(0, 1, At, B1); PG8_BAR;
            PG8_LDA(At, 1, 1); PG8_STAGE(PG8_SA(1, 0), a3, voffA);
            PG8_BAR; PG8_WAIT_L(0); PG8_MMA(1, 0, At, B0); PG8_BAR; PG8_SCHED;
            PG8_STAGE(PG8_SB(1, 1), b3 + hstep, voffB);
            PG8_WAIT_V(6); PG8_BAR; PG8_MMA(1, 1, At, B1); PG8_BAR;
            }
        }
        if constexpr (ALIGN_EPI) { if (wr == 0) PG8_BAR; }
        if constexpr (!Epi::AFTER_DRAIN) { E(acc, cur, wr, wc, fr, fq); S.done(cur); }
        if (!has_next) break;
#pragma unroll
        for (int a = 0; a < 2; ++a)
#pragma unroll
            for (int b = 0; b < 2; ++b)
#pragma unroll
                for (int m = 0; m < 4; ++m)
#pragma unroll
                    for (int n = 0; n < 2; ++n) acc[a][b][m][n] = (f32x4){0.f, 0.f, 0.f, 0.f};
        cur = nxt; cA = nA; cB = nB; ++ui;
        if constexpr (ALIGN_EPI) { if (wr == 1) PG8_BAR; }
    }
    PG8_WAIT_V(0);
    if constexpr (!ALIGN_EPI) { if (wr == 0) PG8_BAR; }
    PG8_BAR;
    if constexpr (Epi::AFTER_DRAIN) { E.fused(acc, cur, wr, wc, fr, fq, lds, wid, lane); S.done(cur); }
#undef PG8_SA
#undef PG8_SB
#undef PG8_STAGE
#undef PG8_LDA
#undef PG8_LDB
#undef PG8_MMA
#undef PG8_WAIT_V
#undef PG8_WAIT_L
#undef PG8_BAR
#undef PG8_SCHED
}
}
namespace pg8 {
typedef unsigned u32x2 __attribute__((ext_vector_type(2)));
constexpr float RMS_EPS = 1e-6f;
constexpr float QC2 = 0.125f * 1.4426950408889634f;
constexpr int MROWS = 16384;

template <int LAYER> struct EpiProj {
    static constexpr bool PERM = true, AFTER_DRAIN = false;
    const float* rrow; const float* cs; bf16_t* base; bf16_t* k1; bf16_t* v1; const float* gains; float* ksum; int pn_off;
    __device__ __forceinline__ void operator()(const f32x4 (&acc)[2][2][4][2], const Unit& u, int wr, int wc, int fr, int fq) const {
        int kind; bf16_t* dst; int pitch, col, head = 0; const float* gain;
        if (LAYER == 0) { const int pnx = u.pn + pn_off; const int grp = pnx >> 1; head = (pnx & 1) * 4 + wc; dst = base + (size_t)grp * ((size_t)MROWS * 512); pitch = 512; col = head * 64 + 16 * fq;
            kind = grp == 0 ? (1 | 2 | 4) : grp == 1 ? (1 | 2 | 16) : grp == 3 ? (1 | 4) : grp == 4 ? 1 : grp == 6 ? 8 : 0;
            gain = gains + 64 * (grp == 0 ? 0 : grp == 1 ? 1 : grp == 3 ? 2 : 3); }
        else { if (u.pn < 4) { dst = base; pitch = 1024; col = (u.pn * 4 + wc) * 64 + 16 * fq; kind = 1 | 2 | 4; gain = gains; }
               else if (wc < 2) { dst = k1; pitch = 128; col = wc * 64 + 16 * fq; kind = 1 | 2; gain = gains + 64; }
               else { dst = v1; pitch = 128; col = (wc - 2) * 64 + 16 * fq; kind = 0; gain = gains + 64; } }
        f32x4 gv[2][2];
#pragma unroll
        for (int bj = 0; bj < 2; ++bj)
#pragma unroll
            for (int n = 0; n < 2; ++n) gv[bj][n] = *(const f32x4*)(gain + 16 * fq + 8 * bj + 4 * n);
        f32x4 ks[2][2];
#pragma unroll
        for (int bj = 0; bj < 2; ++bj)
#pragma unroll
            for (int n = 0; n < 2; ++n) ks[bj][n] = (f32x4){0.f, 0.f, 0.f, 0.f};
#pragma unroll
        for (int ai = 0; ai < 2; ++ai)
#pragma unroll
            for (int m = 0; m < 4; ++m) {
                const int row = u.pm * BM + ai * HALF + wr * 64 + m * 16 + fr; const float rs = rrow[row];
                f32x4 v[2][2];
#pragma unroll
                for (int bj = 0; bj < 2; ++bj)
#pragma unroll
                    for (int n = 0; n < 2; ++n) v[bj][n] = acc[ai][bj][m][n] * rs;
                if (kind & 1) { float ss = 0.f;
#pragma unroll
                    for (int bj = 0; bj < 2; ++bj)
#pragma unroll
                        for (int n = 0; n < 2; ++n) { const f32x4 x = v[bj][n]; ss += (x[0] * x[0] + x[1] * x[1]) + (x[2] * x[2] + x[3] * x[3]); }
                    ss += __shfl_xor(ss, 16); ss += __shfl_xor(ss, 32);
                    const float ri = 1.0f / sqrtf(ss * (1.0f / 64.0f) + RMS_EPS);
#pragma unroll
                    for (int bj = 0; bj < 2; ++bj)
#pragma unroll
                        for (int n = 0; n < 2; ++n) v[bj][n] = (v[bj][n] * ri) * gv[bj][n]; }
                if ((kind & 2) && fq == 0) { const float* cp = cs + (size_t)(row & 8191) * 16;
#pragma unroll
                    for (int n = 0; n < 2; ++n) { const f32x4 c = *(const f32x4*)(cp + 4 * n), s = *(const f32x4*)(cp + 8 + 4 * n); const f32x4 x1 = v[0][n], x2 = v[1][n];
                        v[0][n] = x1 * c - x2 * s; v[1][n] = x2 * c + x1 * s; } }
                if (kind & 16) {
#pragma unroll
                    for (int bj = 0; bj < 2; ++bj)
#pragma unroll
                        for (int n = 0; n < 2; ++n) ks[bj][n] += v[bj][n]; }
                if (kind & 4) {
#pragma unroll
                    for (int bj = 0; bj < 2; ++bj)
#pragma unroll
                        for (int n = 0; n < 2; ++n) v[bj][n] = v[bj][n] * QC2; }
                if (kind & 8) {
#pragma unroll
                    for (int bj = 0; bj < 2; ++bj)
#pragma unroll
                        for (int n = 0; n < 2; ++n)
#pragma unroll
                            for (int j = 0; j < 4; ++j) v[bj][n][j] = 1.0f / (1.0f + __expf(-v[bj][n][j])); }
                bf16_t* rp = dst + (size_t)row * pitch + col;
#pragma unroll
                for (int bj = 0; bj < 2; ++bj) { u32x4 w; w.x = cvt_pk_bf16(v[bj][0][0], v[bj][0][1]); w.y = cvt_pk_bf16(v[bj][0][2], v[bj][0][3]); w.z = cvt_pk_bf16(v[bj][1][0], v[bj][1][1]); w.w = cvt_pk_bf16(v[bj][1][2], v[bj][1][3]);
                    *(u32x4*)(rp + 8 * bj) = w; }
            }
        if (LAYER == 0 && (kind & 16)) {
#pragma unroll
            for (int bj = 0; bj < 2; ++bj)
#pragma unroll
                for (int n = 0; n < 2; ++n)
#pragma unroll
                    for (int j = 0; j < 4; ++j) { float s = ks[bj][n][j]; s += __shfl_xor(s, 1); s += __shfl_xor(s, 2); s += __shfl_xor(s, 4); s += __shfl_xor(s, 8); ks[bj][n][j] = s; }
            if (fr == 0) { float* kp = ksum + ((size_t)((u.pm * 2 + wr) * 8 + head)) * 64 + 16 * fq;
#pragma unroll
                for (int bj = 0; bj < 2; ++bj)
#pragma unroll
                    for (int n = 0; n < 2; ++n) *(f32x4*)(kp + 8 * bj + 4 * n) = ks[bj][n]; }
        }
    }
};

struct EpiResid {
    static constexpr bool PERM = false, AFTER_DRAIN = false;
    const float* xin; float* xout; bf16_t* xb; float* rsp;
    __device__ __forceinline__ void operator()(const f32x4 (&acc)[2][2][4][2], const Unit& u, int wr, int wc, int fr, int fq) const {
        const int col0 = u.pn * BM + wc * 32 + 4 * fq;
#pragma unroll
        for (int ai = 0; ai < 2; ++ai)
#pragma unroll
            for (int m = 0; m < 4; ++m) { const int row = u.pm * BM + ai * HALF + wr * 64 + m * 16 + fr; float ss = 0.f;
#pragma unroll
                for (int bj = 0; bj < 2; ++bj)
#pragma unroll
                    for (int n = 0; n < 2; ++n) { const size_t off = (size_t)row * 1024 + col0 + bj * HALF + n * 16;
                        const f32x4 o = *(const f32x4*)(xin + off) + acc[ai][bj][m][n]; *(f32x4*)(xout + off) = o;
                        ss += (o[0] * o[0] + o[1] * o[1]) + (o[2] * o[2] + o[3] * o[3]);
                        u32x2 w; w.x = cvt_pk_bf16(o[0], o[1]); w.y = cvt_pk_bf16(o[2], o[3]); *(u32x2*)(xb + off) = w; }
                ss += __shfl_xor(ss, 16); ss += __shfl_xor(ss, 32);
                if (fq == 0) rsp[(size_t)row * 16 + u.pn * 4 + wc] = ss; }
    }
};

struct EpiPeerQ {
    static constexpr bool PERM = true, AFTER_DRAIN = false;
    const float* rsp; bf16_t* qp;
    __device__ __forceinline__ void operator()(const f32x4 (&acc)[2][2][4][2], const Unit& u, int wr, int wc, int fr, int fq) const {
        const int col0 = u.pn * BM + wc * 32 + 8 * fq;
#pragma unroll
        for (int ai = 0; ai < 2; ++ai)
#pragma unroll
            for (int m = 0; m < 4; ++m) { const int row = u.pm * BM + ai * HALF + wr * 64 + m * 16 + fr;
                const f32x4 a = *(const f32x4*)(rsp + (size_t)row * 16), b = *(const f32x4*)(rsp + (size_t)row * 16 + 4), c = *(const f32x4*)(rsp + (size_t)row * 16 + 8), d = *(const f32x4*)(rsp + (size_t)row * 16 + 12);
                const float ss = ((a[0] + a[1]) + (a[2] + a[3])) + ((b[0] + b[1]) + (b[2] + b[3])) + ((c[0] + c[1]) + (c[2] + c[3])) + ((d[0] + d[1]) + (d[2] + d[3]));
                const float rs = 1.0f / sqrtf(ss * (1.0f / 1024.0f) + RMS_EPS);
                bf16_t* rp = qp + (size_t)row * 1024 + col0;
#pragma unroll
                for (int bj = 0; bj < 2; ++bj) { const f32x4 v0 = acc[ai][bj][m][0] * rs, v1 = acc[ai][bj][m][1] * rs; u32x4 w; w.x = cvt_pk_bf16(v0[0], v0[1]); w.y = cvt_pk_bf16(v0[2], v0[3]); w.z = cvt_pk_bf16(v1[0], v1[1]); w.w = cvt_pk_bf16(v1[2], v1[3]);
                    *(u32x4*)(rp + bj * HALF) = w; } }
    }
};
}
#include <hip/hip_bf16.h>
#include <cmath>
namespace attn_body {
using bf16=__hip_bfloat16;
using bf16x8=__attribute__((ext_vector_type(8)))short;
using s16x4=__attribute__((ext_vector_type(4)))short;
using f32x16=__attribute__((ext_vector_type(16)))float;
using u32x4=__attribute__((ext_vector_type(4)))unsigned;
constexpr int BATCH=2,SEQ=8192,D=64;
constexpr int NW=8,QBLK=32,QB=QBLK*NW,KVBLK=64,NQB=SEQ/QB;
constexpr int ATTN_UNIT_ROWS=QB;
__device__ __forceinline__ int crow(int r,int hi){return (r&3)+8*(r>>2)+4*hi;}
#define SBAR() __builtin_amdgcn_sched_barrier(0)
typedef __attribute__((address_space(3))) const float* lds_cfptr;
typedef float f32x4a __attribute__((ext_vector_type(4)));
__device__ __forceinline__ float badd_s(float a,float b){float r;asm("v_add_f32_e32 %0, %1, %2":"=v"(r):"v"(a),"v"(b));return r;}
template<int VAR,bool BAND> __device__ __forceinline__ void bias_tile(f32x16&p0,f32x16&p1,int t,int jb,int qrel,int hi,lds_cfptr ftab,unsigned selm,int t0,float negs){
  const float NEG=-INFINITY;
  if(VAR==1){ const lds_cfptr f=ftab+64*t+4*hi;
    #pragma unroll
    for(int g=0;g<4;++g){ const f32x4a a=*(const __attribute__((address_space(3))) f32x4a*)(f+8*g); const f32x4a c=*(const __attribute__((address_space(3))) f32x4a*)(f+32+8*g);
      #pragma unroll
      for(int j=0;j<4;++j){p0[4*g+j]+=negs-a[j];p1[4*g+j]+=negs-c[j];} } }
  else { float s=negs;
    if(VAR==0){ if(!BAND||jb<0){ const bool ok=((selm>>((t0+t)>>2))&1u)!=0u; s=ok?negs:NEG; } }
    #pragma unroll
    for(int r=0;r<16;++r){p0[r]+=s;p1[r]+=s;} }
  if(BAND){
    if(VAR==2){ const int kb=64*jb+4*hi;
      #pragma unroll
      for(int r=0;r<16;++r){const int kv=kb+(r&3)+8*(r>>2); if(kv>qrel||kv<=qrel-128)p0[r]=NEG; if(kv+32>qrel||kv+32<=qrel-128)p1[r]=NEG;} }
    else if(jb>=0&&VAR!=3){ const int kb=64*jb+4*hi;
      #pragma unroll
      for(int r=0;r<16;++r){const int kv=kb+(r&3)+8*(r>>2); if(kv>qrel)p0[r]=NEG; if(kv+32>qrel)p1[r]=NEG;} }
  }
}
struct UnitArgs { const bf16*Q; const bf16*K; const bf16*V; bf16*O; int qcol,kcol,ocol; const float*Fl2; const bf16*gate; const unsigned*sel; const float*sinkp; float bl2x2; const unsigned short*glist; int gn; bf16*PO; float*LSE; int kvres; };

constexpr int NSLOT=3, SLOTB=8192;
constexpr int LDS_K=0, LDS_V=NSLOT*SLOTB, LDS_WS=2*NSLOT*SLOTB, LDS_OST=LDS_WS+NW*256*4, LDS_F=90112, LDS_BYTES=LDS_F+SEQ*4;
constexpr float C2=0.125f*1.4426950408889634f;
__device__ __forceinline__ void glds16(const void*gsrc,unsigned lds_dst){unsigned keep;
  asm volatile("s_mov_b32 %0, m0\n\ts_mov_b32 m0, %2\n\ts_nop 0\n\tglobal_load_lds_dwordx4 %1, off\n\ts_mov_b32 m0, %0":"=&s"(keep):"v"(gsrc),"s"(lds_dst):"memory");}
__device__ __forceinline__ float max3f(float a,float b,float c){float r;asm("v_max3_f32 %0, %1, %2, %3":"=v"(r):"v"(a),"v"(b),"v"(c));return r;}
__device__ __forceinline__ float max2f(float a,float b){float r;asm("v_max_f32_e32 %0, %1, %2":"=v"(r):"v"(a),"v"(b));return r;}
__device__ __forceinline__ float fadd_s(float a,float b){float r;asm("v_add_f32_e32 %0, %1, %2":"=v"(r):"v"(a),"v"(b));return r;}
__device__ __forceinline__ float fsub_s(float a,float b){float r;asm("v_sub_f32_e32 %0, %1, %2":"=v"(r):"v"(a),"v"(b));return r;}
typedef float f32x2_t __attribute__((ext_vector_type(2))); typedef __bf16 bf16x2_t __attribute__((ext_vector_type(2)));
__device__ __forceinline__ unsigned cvtpk_s(float lo,float hi){f32x2_t v={lo,hi};bf16x2_t b=__builtin_convertvector(v,bf16x2_t);return __builtin_bit_cast(unsigned,b);}
#define WAIT_BAR(N) asm volatile("s_waitcnt vmcnt(" #N ") lgkmcnt(0)\n\ts_barrier":::"memory")

__device__ __forceinline__ void qkt(f32x16&p0,f32x16&p1,const char*Kslot,const bf16x8*qr,const f32x16&negm,int r32,int hi){
  const char*kb=Kslot+hi*1024+r32*16;
  #pragma unroll
  for(int d0=0;d0<4;++d0){
    const bf16x8 b0=*reinterpret_cast<const bf16x8*>(kb+d0*2048);
    const bf16x8 b1=*reinterpret_cast<const bf16x8*>(kb+d0*2048+512);
    if(d0==0){p0=__builtin_amdgcn_mfma_f32_32x32x16_bf16(b0,qr[0],negm,0,0,0);p1=__builtin_amdgcn_mfma_f32_32x32x16_bf16(b1,qr[0],negm,0,0,0);}
    else{p0=__builtin_amdgcn_mfma_f32_32x32x16_bf16(b0,qr[d0],p0,0,0,0);p1=__builtin_amdgcn_mfma_f32_32x32x16_bf16(b1,qr[d0],p1,0,0,0);}}
}
typedef __attribute__((address_space(3))) const char* lds_cptr;
typedef short v4i16_t __attribute__((ext_vector_type(4)));
__device__ __forceinline__ void kload8(bf16x8*kf,lds_cptr kp){
  kf[0]=*(const __attribute__((address_space(3))) bf16x8*)(kp);      kf[1]=*(const __attribute__((address_space(3))) bf16x8*)(kp+512);
  kf[2]=*(const __attribute__((address_space(3))) bf16x8*)(kp+2048); kf[3]=*(const __attribute__((address_space(3))) bf16x8*)(kp+2560);
  kf[4]=*(const __attribute__((address_space(3))) bf16x8*)(kp+4096); kf[5]=*(const __attribute__((address_space(3))) bf16x8*)(kp+4608);
  kf[6]=*(const __attribute__((address_space(3))) bf16x8*)(kp+6144); kf[7]=*(const __attribute__((address_space(3))) bf16x8*)(kp+6656);
}
__device__ __forceinline__ void kload2(bf16x8*kf,lds_cptr kp,int j){ kf[2*j]=*(const __attribute__((address_space(3))) bf16x8*)(kp+j*2048); kf[2*j+1]=*(const __attribute__((address_space(3))) bf16x8*)(kp+j*2048+512); }
__device__ __forceinline__ s16x4 vtr(lds_cptr p){ return __builtin_bit_cast(s16x4,__builtin_amdgcn_ds_read_tr16_b64_v4i16((__attribute__((address_space(3))) v4i16_t*)p)); }
__device__ __forceinline__ float rowmax(const f32x16&p0,const f32x16&p1){
  float a=max3f(p0[0],p0[1],p1[0]),b=max3f(p0[2],p0[3],p1[1]);a=max3f(a,p1[2],p1[3]);
  #pragma unroll
  for(int r=4;r<16;r+=4){a=max3f(a,p0[r],p0[r+1]);b=max3f(b,p0[r+2],p0[r+3]);a=max3f(a,p1[r],p1[r+1]);b=max3f(b,p1[r+2],p1[r+3]);}
  const float m=max2f(a,b);
  auto rr=__builtin_amdgcn_permlane32_swap(__float_as_uint(m),__float_as_uint(m),false,false);
  return max2f(__uint_as_float(rr[0]),__uint_as_float(rr[1]));
}
__device__ __forceinline__ void pv(f32x16*o,int vb,bf16x8 pa0,bf16x8 pa1,bf16x8 pa2,bf16x8 pa3){
  #pragma unroll
  for(int d0=0;d0<2;++d0){s16x4 lo[4],hi[4];
    #pragma unroll
    for(int ks=0;ks<4;++ks){
      asm volatile("ds_read_b64_tr_b16 %0,%1 offset:%c2":"=&v"(lo[ks]):"v"(vb),"i"(d0*4096+ks*1024):"memory");
      asm volatile("ds_read_b64_tr_b16 %0,%1 offset:%c2":"=&v"(hi[ks]):"v"(vb),"i"(d0*4096+ks*1024+512):"memory");}
    asm volatile("s_waitcnt lgkmcnt(0)":::"memory");SBAR();
    #define PK(k) (bf16x8){lo[k][0],lo[k][1],lo[k][2],lo[k][3],hi[k][0],hi[k][1],hi[k][2],hi[k][3]}
    o[d0]=__builtin_amdgcn_mfma_f32_32x32x16_bf16(pa0,PK(0),o[d0],0,0,0);
    o[d0]=__builtin_amdgcn_mfma_f32_32x32x16_bf16(pa1,PK(1),o[d0],0,0,0);
    o[d0]=__builtin_amdgcn_mfma_f32_32x32x16_bf16(pa2,PK(2),o[d0],0,0,0);
    o[d0]=__builtin_amdgcn_mfma_f32_32x32x16_bf16(pa3,PK(3),o[d0],0,0,0);
    #undef PK
  }
}

#ifndef ATTN_STORE16
#define ATTN_STORE16(p,v) (*(u32x4*)(p)=(v))
#endif
template<int VAR,int THRL,int DMQ,int DMK,int DMO> __device__ __forceinline__ void attn_unit(int b,int qb,const UnitArgs&A,char*shm){
  int tid_=threadIdx.x; asm volatile("":"+v"(tid_)); const int tid=tid_,lane=tid&63,r32=lane&31,hi=lane>>5; const int wid=__builtin_amdgcn_readfirstlane(tid>>6);
  const long rowbase=(long)b*SEQ; const int q0=qb*QB;
  const lds_cptr shm3=(lds_cptr)shm;
  int t0=0, NT=4*qb+4; float rowc=0.f; unsigned selm=0u;
  if(VAR==2){ t0=qb?4*qb-2:0; NT=qb?6:4; }
  if(VAR==3||VAR==4){ t0=4*qb; NT=4; }
  int gpos=q0+wid*QBLK+r32; bool gvalid=true;
  if(VAR==3){ const int gi=wid*QBLK+r32; gvalid=gi<A.gn; gpos=(int)A.glist[gvalid?gi:0]; }
  if(VAR==4){ selm=A.sel[gpos]; }
  if(VAR==0){ selm=A.sel[q0+wid*QBLK+r32]; asm volatile("":"+s"(NT)); }
  if(VAR==1){ const float fq0=A.Fl2[q0]; const int ntile=4*qb+4;
    const bool k0=(lane<ntile)?(A.bl2x2+fq0-A.Fl2[64*lane+63]>=-160.f):true;
    const bool k1=(lane+64<ntile)?(A.bl2x2+fq0-A.Fl2[64*(lane+64)+63]>=-160.f):true;
    const unsigned long long m0=__ballot(k0), m1=__ballot(k1);
    int first=m0?(int)__builtin_ctzll(m0):64+(int)__builtin_ctzll(m1|(1ull<<63));
    first&=~1; if(first>4*qb)first=4*qb;
    t0=__builtin_amdgcn_readfirstlane(first); NT=4*qb+4-t0;
    __attribute__((address_space(3))) float*ft=(__attribute__((address_space(3))) float*)(shm3+LDS_F);
    for(int i=tid;i<64*NT;i+=NW*64)ft[i]=A.Fl2[64*t0+i]-fq0;
    rowc=A.Fl2[q0+wid*QBLK+r32]-fq0;
    asm volatile("s_waitcnt vmcnt(0) lgkmcnt(0)\n\ts_barrier":::"memory");
  }
  const lds_cfptr ftab=(lds_cfptr)(shm3+LDS_F);
  const bf16*Qrow=A.Q+(rowbase+gpos)*DMQ+A.qcol;
  const bf16*Kh=A.K+(rowbase+(long)t0*KVBLK)*DMK+A.kcol,*Vh=A.V+(rowbase+(long)t0*KVBLK)*DMK+A.kcol;
  const unsigned lds0=(unsigned)(uintptr_t)shm;
  constexpr bool RES=(VAR>=3); constexpr int NSL=RES?4:3, LV=NSL*SLOTB, LWS=2*NSL*SLOTB, LOST=LWS+NW*256*4;
  float*wsf=(float*)(shm+LWS)+wid*256;
  const bf16*ksrc=Kh+(long)lane*DMK+wid*8;
  const bf16*vsrc=Vh+(long)(16*(wid&3)+(lane>>2))*DMK+(wid>>2)*32+(lane&3)*8;
  const unsigned kdst=lds0+LDS_K+wid*1024, vdst=lds0+LV+wid*1024;
  #define DMA_K(t,slot) glds16(ksrc+(long)(t)*KVBLK*DMK,(unsigned)__builtin_amdgcn_readfirstlane(kdst+(slot)))
  #define DMA_V(t,slot) glds16(vsrc+(long)(t)*KVBLK*DMK,(unsigned)__builtin_amdgcn_readfirstlane(vdst+(slot)))
  const int vb0=(int)(lds0+LV)+((lane>>4)&1)*32+(lane&3)*8+(4*hi+((lane&15)>>2))*64;
  const char*Kbase=shm+LDS_K; bf16x8 kf[8];
  const lds_cptr kp0=shm3+LDS_K+hi*1024+r32*16; const lds_cptr vp0=shm3+LV+((lane>>4)&1)*32+(lane&3)*8+(4*hi+((lane&15)>>2))*64;
  const bool kvres=(VAR==3)&&A.kvres;
  if(!kvres){DMA_K(0,0);DMA_V(0,0);DMA_K(1,SLOTB); if(RES){DMA_V(1,SLOTB);}}
  bf16x8 qr[4];
  #pragma unroll
  for(int d0=0;d0<4;++d0)qr[d0]=*reinterpret_cast<const bf16x8*>(&Qrow[d0*16+hi*8]);
  float lse0=-INFINITY,lse1=-INFINITY,lse2=-INFINITY,sinkv=0.f;
  if(VAR==3){ selm=A.sel[gpos]; }
  if(VAR==4){ const int ns=__builtin_popcount(selm); if(ns>0)lse0=A.LSE[(long)gpos*3+0]; if(ns>1)lse1=A.LSE[(long)gpos*3+1]; if(ns>2)lse2=A.LSE[(long)gpos*3+2]; }
  if(VAR==2){ sinkv=A.sinkp[0]; }
  float mhat=0.f,l_reg=0.f;f32x16 o[2];o[0]=f32x16{};o[1]=f32x16{};const f32x16 negm=f32x16{};
  const int qrel=wid*QBLK+r32;
  #define CMASK(P0,P1,t) bias_tile<VAR,true>(P0,P1,(t),(t)-(NT-4),qrel,hi,ftab,selm,t0,rowc-mhat)
  bool resc=false;
  #define START(P0,P1) do{ const float rm=rowmax(P0,P1); resc=false; \
    { const float dl=max2f(rm,-30.f); mhat=fadd_s(mhat,dl); \
      _Pragma("unroll") for(int r=0;r<16;++r){P0[r]=fsub_s(P0[r],dl);P1[r]=fsub_s(P1[r],dl);} \
      } \
    _Pragma("unroll") for(int r=0;r<16;++r)P0[r]=__builtin_amdgcn_exp2f(P0[r]); }while(0)
  #define RESC() do{ if(resc){ asm volatile("s_waitcnt lgkmcnt(0)":::"memory"); \
      _Pragma("unroll") for(int d_=0;d_<2;++d_) _Pragma("unroll") for(int r=0;r<16;++r)o[d_][r]*=wsf[crow(r,hi)]; } }while(0)
  f32x16 pA0,pA1,pB0,pB1;
  int sl_prev=0,sl_cur=0,sl_next=SLOTB;
  #define ROT() do{sl_prev=sl_cur;sl_cur=sl_next;sl_next=(sl_next==(NSL-1)*SLOTB)?0:sl_next+SLOTB;}while(0)
  if(!kvres){DMA_K(2,2*SLOTB);}
  if(RES){ if(!kvres){DMA_V(2,2*SLOTB);DMA_K(3,3*SLOTB);DMA_V(3,3*SLOTB);WAIT_BAR(0);} } else {WAIT_BAR(3);}
  qkt(pA0,pA1,Kbase,qr,negm,r32,hi);asm volatile("s_nop 15\n\ts_nop 7":"+v"(pA0),"+v"(pA1));CMASK(pA0,pA1,0);
  START(pA0,pA1);
  _Pragma("unroll") for(int r=0;r<16;++r)pA1[r]=__builtin_amdgcn_exp2f(pA1[r]);
  if(!RES){ WAIT_BAR(0);
  DMA_K(3,0);DMA_V(1,SLOTB); }
  ROT();
  kload8(kf,kp0+sl_cur);
  if(!RES){WAIT_BAR(2);}
  s16x4 vlo[8],vhi[8]; u32x4 pw0,pw1,pw2,pw3;
  #define PKW(P,B) cvtpk_s(P[B],P[B+1])
  #define PAF(k) __builtin_bit_cast(bf16x8,pw##k)
  #define VFR(i) (bf16x8){vlo[i][0],vlo[i][1],vlo[i][2],vlo[i][3],vhi[i][0],vhi[i][1],vhi[i][2],vhi[i][3]}
  #define PIN(x) asm volatile("":"+v"(x))
  #define MX3(a,b,c) __builtin_fmaxf(__builtin_fmaxf((a),(b)),(c))
  #define GAPA(MF,A0,A1,A2,A3,W0,W1,PW) do{ MF; sacc+=A0; sacc+=A1; sacc+=A2; sacc+=A3; PIN(sacc); W0; W1; PIN(PW); SBAR(); }while(0)
  #define EX(v) __builtin_amdgcn_exp2f(v)
  #define GAPB(MF,X,B) do{ MF; X[B]=EX(X[B]); X[B+1]=EX(X[B+1]); X[B+2]=EX(X[B+2]); X[B+3]=EX(X[B+3]); PIN(X); SBAR(); }while(0)
  #define VRD(i) do{ vlo[i]=vtr(vp_+(((i)>>2)*4096+((i)&3)*1024)); vhi[i]=vtr(vp_+(((i)>>2)*4096+((i)&3)*1024+512)); }while(0)
  #define KRD(G,j) do{ if(G){ kload2(kf,kp0+sl_next,j); SBAR(); } }while(0)
  #define STEP(C0,C1,P0,P1,t,GK,GV,GL) do{ SBAR(); \
    const lds_cptr vp_=vp0+sl_prev; \
    VRD(0); SBAR(); float sacc=(P0[0]+P0[1]); \
    GAPA(C0=__builtin_amdgcn_mfma_f32_32x32x16_bf16(kf[0],qr[0],negm,0,0,0), P0[2],P0[3],P0[4],P0[5],     pw0[0]=PKW(P0,0), pw0[1]=PKW(P0,2), pw0); \
    VRD(4); SBAR(); GAPA(C1=__builtin_amdgcn_mfma_f32_32x32x16_bf16(kf[1],qr[0],negm,0,0,0), P0[6],P0[7],P0[8],P0[9],     pw0[2]=PKW(P0,4), pw0[3]=PKW(P0,6), pw0); \
    VRD(1); SBAR(); GAPA(C0=__builtin_amdgcn_mfma_f32_32x32x16_bf16(kf[2],qr[1],C0,0,0,0),   P0[10],P0[11],P0[12],P0[13], pw1[0]=PKW(P0,8), pw1[1]=PKW(P0,10), pw1); \
    VRD(5); SBAR(); GAPA(C1=__builtin_amdgcn_mfma_f32_32x32x16_bf16(kf[3],qr[1],C1,0,0,0),   P0[14],P0[15],P1[0],P1[1],   pw1[2]=PKW(P0,12),pw1[3]=PKW(P0,14), pw1); \
    VRD(2); SBAR(); GAPA(C0=__builtin_amdgcn_mfma_f32_32x32x16_bf16(kf[4],qr[2],C0,0,0,0),   P1[2],P1[3],P1[4],P1[5],     pw2[0]=PKW(P1,0), pw2[1]=PKW(P1,2), pw2); \
    VRD(6); SBAR(); GAPA(C1=__builtin_amdgcn_mfma_f32_32x32x16_bf16(kf[5],qr[2],C1,0,0,0),   P1[6],P1[7],P1[8],P1[9],     pw2[2]=PKW(P1,4), pw2[3]=PKW(P1,6), pw2); \
    VRD(3); SBAR(); GAPA(C0=__builtin_amdgcn_mfma_f32_32x32x16_bf16(kf[6],qr[3],C0,0,0,0),   P1[10],P1[11],P1[12],P1[13], pw3[0]=PKW(P1,8), pw3[1]=PKW(P1,10), pw3); \
    VRD(7); SBAR(); GAPA(C1=__builtin_amdgcn_mfma_f32_32x32x16_bf16(kf[7],qr[3],C1,0,0,0),   P1[14],P1[15],0.f,0.f,       pw3[2]=PKW(P1,12),pw3[3]=PKW(P1,14), pw3); \
    l_reg+=sacc; \
    if(GK){DMA_K((t)+3,sl_cur);} if(GV){DMA_V((t)+1,sl_next);} \
    CMASK(C0,C1,t); \
    { float a=MX3(C0[0],C0[1],C1[0]),b=MX3(C0[2],C0[3],C1[1]); a=MX3(a,C1[2],C1[3]); \
      _Pragma("unroll") for(int r=4;r<16;r+=4){a=MX3(a,C0[r],C0[r+1]);b=MX3(b,C0[r+2],C0[r+3]);a=MX3(a,C1[r],C1[r+1]);b=MX3(b,C1[r+2],C1[r+3]);} \
      float rm=__builtin_fmaxf(a,b); { auto rr=__builtin_amdgcn_permlane32_swap(__float_as_uint(rm),__float_as_uint(rm),false,false); rm=__builtin_fmaxf(__uint_as_float(rr[0]),__uint_as_float(rr[1])); } \
      resc=false; \
      if(__builtin_expect(__any(rm>(float)THRL),0)){ const float dl=__builtin_fmaxf(rm,0.f); mhat+=dl; \
        _Pragma("unroll") for(int r=0;r<16;++r){C0[r]-=dl;C1[r]-=dl;} \
        const float f=__builtin_amdgcn_exp2f(-dl); l_reg*=f; if(hi==0)wsf[r32]=f; resc=true; } } \
    SBAR(); \
    GAPB(o[0]=__builtin_amdgcn_mfma_f32_32x32x16_bf16(PAF(0),VFR(0),o[0],0,0,0), C0,0); \
    GAPB(o[1]=__builtin_amdgcn_mfma_f32_32x32x16_bf16(PAF(0),VFR(4),o[1],0,0,0), C0,4); \
    KRD(GL,0); GAPB(o[0]=__builtin_amdgcn_mfma_f32_32x32x16_bf16(PAF(1),VFR(1),o[0],0,0,0), C0,8); \
    KRD(GL,1); GAPB(o[1]=__builtin_amdgcn_mfma_f32_32x32x16_bf16(PAF(1),VFR(5),o[1],0,0,0), C0,12); \
    KRD(GL,2); GAPB(o[0]=__builtin_amdgcn_mfma_f32_32x32x16_bf16(PAF(2),VFR(2),o[0],0,0,0), C1,0); \
    KRD(GL,3); GAPB(o[1]=__builtin_amdgcn_mfma_f32_32x32x16_bf16(PAF(2),VFR(6),o[1],0,0,0), C1,4); \
    GAPB(o[0]=__builtin_amdgcn_mfma_f32_32x32x16_bf16(PAF(3),VFR(3),o[0],0,0,0), C1,8); \
    GAPB(o[1]=__builtin_amdgcn_mfma_f32_32x32x16_bf16(PAF(3),VFR(7),o[1],0,0,0), C1,12); \
    }while(0)
  int t=1;
  #undef CMASK
  #define CMASK(P0,P1,t) bias_tile<VAR,false>(P0,P1,(t),-1,qrel,hi,ftab,selm,t0,rowc-mhat)
  for(;t+5<NT;t+=2){
    STEP(pB0,pB1,pA0,pA1,t,true,true,true);     WAIT_BAR(2); RESC(); ROT();
    STEP(pA0,pA1,pB0,pB1,t+1,true,true,true);   WAIT_BAR(2); RESC(); ROT();
  }
  #undef CMASK
  #define CMASK(P0,P1,t) bias_tile<VAR,true>(P0,P1,(t),(t)-(NT-4),qrel,hi,ftab,selm,t0,rowc-mhat)
  #define ENDW(tt) do{ if((tt)+3<NT){WAIT_BAR(2);} else if((tt)+2<NT){WAIT_BAR(1);} else {WAIT_BAR(0);} }while(0)
  for(;t+1<NT;t+=2){
    if(RES){ STEP(pB0,pB1,pA0,pA1,t,false,false,(t+1<NT)); RESC(); ROT(); STEP(pA0,pA1,pB0,pB1,t+1,false,false,(t+2<NT)); RESC(); ROT(); }
    else {
    STEP(pB0,pB1,pA0,pA1,t,(t+3<NT),(t+1<NT),(t+1<NT));       ENDW(t);   RESC(); ROT();
    STEP(pA0,pA1,pB0,pB1,t+1,(t+4<NT),(t+2<NT),(t+2<NT));     ENDW(t+1); RESC(); ROT(); }
  }
  STEP(pB0,pB1,pA0,pA1,NT-1,false,false,false); RESC();
  { float sacc=pB0[0]+pB0[1]; _Pragma("unroll") for(int r=2;r<16;++r)sacc+=pB0[r]; _Pragma("unroll") for(int r=0;r<16;++r)sacc+=pB1[r]; l_reg+=sacc;
    pw0=(u32x4){PKW(pB0,0),PKW(pB0,2),PKW(pB0,4),PKW(pB0,6)};pw1=(u32x4){PKW(pB0,8),PKW(pB0,10),PKW(pB0,12),PKW(pB0,14)};pw2=(u32x4){PKW(pB1,0),PKW(pB1,2),PKW(pB1,4),PKW(pB1,6)};pw3=(u32x4){PKW(pB1,8),PKW(pB1,10),PKW(pB1,12),PKW(pB1,14)};
    SBAR(); pv(o,vb0+sl_cur,PAF(0),PAF(1),PAF(2),PAF(3)); }
  #undef PKW
  #undef PAF
  #undef VFR
  #undef PIN
  #undef MX3
  #undef GAPA
  #undef GAPB
  #undef EX
  #undef VRD
  #undef KRD
  #undef STEP
  #undef ENDW
  {auto rr=__builtin_amdgcn_permlane32_swap(__float_as_uint(l_reg),__float_as_uint(l_reg),false,false);l_reg=__uint_as_float(rr[0])+__uint_as_float(rr[1]);}
  if(VAR==2)l_reg+=__builtin_amdgcn_exp2f(sinkv*1.4426950408889634f-mhat);
  if(VAR==3&&hi==0){ const int slot=__builtin_popcount(selm&((1u<<qb)-1u)); const int dst=gvalid?gpos*3+slot:-1; wsf[64+r32]=__int_as_float(dst);
    if(gvalid)A.LSE[(long)gpos*3+slot]=mhat+__builtin_amdgcn_logf(l_reg); }
  if(VAR==4&&hi==0){ const int ns=__builtin_popcount(selm); const float lo=mhat+__builtin_amdgcn_logf(l_reg);
    const float l0=lse0, l1=lse1, l2=lse2; (void)ns;
    const float mm=__builtin_fmaxf(__builtin_fmaxf(lo,l0),__builtin_fmaxf(l1,l2));
    const float e0=__builtin_amdgcn_exp2f(lo-mm), e1=__builtin_amdgcn_exp2f(l0-mm), e2=__builtin_amdgcn_exp2f(l1-mm), e3=__builtin_amdgcn_exp2f(l2-mm), inv=__builtin_amdgcn_rcpf((e0+e1)+(e2+e3));
    wsf[64+4*r32]=e0*inv; wsf[65+4*r32]=e1*inv; wsf[66+4*r32]=e2*inv; wsf[67+4*r32]=e3*inv; }
  if(hi==0)wsf[32+r32]=l_reg;asm volatile("s_waitcnt lgkmcnt(0)":::"memory");
  float rli[16];
  #pragma unroll
  for(int r=0;r<16;++r)rli[r]=__builtin_amdgcn_rcpf(wsf[32+crow(r,hi)]);
  bf16*Ow=A.O+(rowbase+q0+wid*QBLK)*DMO+A.ocol;
  { bf16*stg=(bf16*)(shm+LOST)+wid*2048;
    #pragma unroll
    for(int r=0;r<16;++r){const int orow=crow(r,hi);
      #pragma unroll
      for(int d0=0;d0<2;++d0)stg[orow*64+d0*32+r32]=__float2bfloat16(o[d0][r]*rli[r]);}
    asm volatile("s_waitcnt lgkmcnt(0)":::"memory");
    #pragma unroll
    for(int once_=0;once_<1;++once_){ u32x4 gl[4]; u32x4 pl[4][3];
    if(VAR==1){
      #pragma unroll
      for(int i=0;i<4;++i)gl[i]=*(const u32x4*)(A.gate+(rowbase+q0+wid*QBLK+i*8+(lane>>3))*512+(lane&7)*8); }
    if(VAR==4){
      #pragma unroll
      for(int i=0;i<4;++i)
        #pragma unroll
        for(int sl=0;sl<3;++sl)pl[i][sl]=*(const u32x4*)(A.PO+((long)(q0+wid*QBLK+i*8+(lane>>3))*3+sl)*64+(lane&7)*8); }
    #pragma unroll
    for(int i=0;i<4;++i){const int row=i*8+(lane>>3),ch=lane&7; u32x4 v=*(const u32x4*)(stg+row*64+ch*8);
      if(VAR==1){ const u32x4 g=gl[i];
        #pragma unroll
        for(int j=0;j<4;++j){ const float vl=__uint_as_float(v[j]<<16)*__uint_as_float(g[j]<<16), vh=__uint_as_float(v[j]&0xffff0000u)*__uint_as_float(g[j]&0xffff0000u); v[j]=cvtpk_s(vl,vh); } }
      if(VAR==3){ const int dst=__float_as_int(wsf[64+row]); if(dst>=0)ATTN_STORE16(A.PO+(long)dst*64+ch*8,v); }
      else if(VAR==4){ const float w0=wsf[64+4*row],w1=wsf[65+4*row],w2=wsf[66+4*row],w3=wsf[67+4*row];
        float acc8[8];
        #pragma unroll
        for(int j=0;j<4;++j){ acc8[2*j]=w0*__uint_as_float(v[j]<<16); acc8[2*j+1]=w0*__uint_as_float(v[j]&0xffff0000u); }
        #pragma unroll
        for(int sl=0;sl<3;++sl){ const float ws_=sl==0?w1:sl==1?w2:w3; const u32x4 p=pl[i][sl];
          #pragma unroll
          for(int j=0;j<4;++j){ acc8[2*j]+=ws_!=0.f?ws_*__uint_as_float(p[j]<<16):0.f; acc8[2*j+1]+=ws_!=0.f?ws_*__uint_as_float(p[j]&0xffff0000u):0.f; } }
        #pragma unroll
        for(int j=0;j<4;++j)v[j]=cvtpk_s(acc8[2*j],acc8[2*j+1]);
        ATTN_STORE16(Ow+(long)row*DMO+ch*8,v); }
      else ATTN_STORE16(Ow+(long)row*DMO+ch*8,v);} } }
  asm volatile("s_waitcnt lgkmcnt(0)\n\ts_barrier":::"memory");
  #undef DMA_K
  #undef DMA_V
  #undef CMASK
  #undef START
  #undef RESC
  #undef ROT
}
constexpr int ATTN_LDS_BYTES=LDS_BYTES;
#undef SBAR
#undef WAIT_BAR
}
#define GAS __attribute__((address_space(1)))
#define LAS __attribute__((address_space(3)))
typedef unsigned short bf16;
typedef unsigned v4u __attribute__((ext_vector_type(4)));
typedef float f32x4 __attribute__((ext_vector_type(4)));
typedef short bf16x8 __attribute__((ext_vector_type(8)));
typedef GAS unsigned gu32;
typedef GAS unsigned long long gu64;
#define RLX_AGENT __ATOMIC_RELAXED, __HIP_MEMORY_SCOPE_AGENT
#define LDS_WAIT() asm volatile("s_waitcnt lgkmcnt(0)" ::: "memory")
#define VM_WAIT() asm volatile("s_waitcnt vmcnt(0)" ::: "memory")
__device__ __forceinline__ unsigned long long rt() { return __builtin_amdgcn_s_memrealtime(); }
__device__ __forceinline__ unsigned f2bf(float f) { unsigned u = __builtin_bit_cast(unsigned, f); return (u + 0x7fffu + ((u >> 16) & 1u)) >> 16; }
__device__ __forceinline__ unsigned pk2(float lo, float hi) { return f2bf(lo) | (f2bf(hi) << 16); }

#define XB_TMO      128
#define XB_XCNT(j)  (256  + 64 * (j))
#define XB_XSUB(j)  (1280 + 64 * (j))
#define XB_XGEN(j)  (2304 + 64 * (j))
#define XB_TOP      3328
#define XB_TOPGEN   3392
#define XCD_BAR_WORDS 3456
#define XB_SPIN_CAP (1u << 18)

__device__ __forceinline__ unsigned xb_ld(unsigned* p)              { return __hip_atomic_load(p, __ATOMIC_RELAXED, __HIP_MEMORY_SCOPE_AGENT); }
__device__ __forceinline__ unsigned xb_add(unsigned* p, unsigned v) { return __hip_atomic_fetch_add(p, v, __ATOMIC_RELAXED, __HIP_MEMORY_SCOPE_AGENT); }
__device__ __forceinline__ unsigned xb_xcc_id() { return (unsigned)__builtin_amdgcn_s_getreg((3 << 11) | 20) & 0xFu; }
#define XB_SPIN(cond, bar) do { unsigned _sp = 0; while (cond) { __builtin_amdgcn_s_sleep(1); \
    if ((++_sp & 255u) == 0u) { if (xb_ld(&(bar)[XB_TMO])) break; if (_sp > XB_SPIN_CAP) { atomicAdd(&(bar)[XB_TMO], 1u); break; } } } } while (0)

struct XcdBarrier {
    unsigned* bar; unsigned x;
    volatile LAS unsigned* st;
};

__device__ __forceinline__ XcdBarrier xcd_barrier_post(unsigned* bar, volatile LAS unsigned* st) {
    XcdBarrier b; b.bar = bar; b.x = xb_xcc_id(); b.st = st;
    if (threadIdx.x == 0) (void)xb_add(&bar[XB_XCNT(b.x)], 1u);
    return b;
}
__device__ __forceinline__ void xcd_barrier_complete(unsigned* bar, unsigned x, unsigned& nloc, unsigned& nx) {
    const unsigned G = gridDim.x * gridDim.y * gridDim.z;
    unsigned sum, cnt, mine, sp = 0u;
    for (;;) {
        sum = 0u; cnt = 0u; mine = 0u;
#pragma unroll
        for (unsigned j = 0; j < 16; ++j) { const unsigned c = xb_ld(&bar[XB_XCNT(j)]); sum += c; cnt += (c > 0u) ? 1u : 0u; mine = (j == x) ? c : mine; }
        if (sum == G) break;
        __builtin_amdgcn_s_sleep(1);
        if ((++sp & 255u) == 0u) { if (xb_ld(&bar[XB_TMO])) break; if (sp > XB_SPIN_CAP) { atomicAdd(&bar[XB_TMO], 1u); break; } }
    }
    nloc = mine > 0u ? mine : 1u; nx = cnt > 0u ? cnt : 1u;
}

__device__ __forceinline__ void xcd_barrier(const XcdBarrier& b) {
    asm volatile("s_waitcnt vmcnt(0)" ::: "memory");
    __syncthreads();
    if (threadIdx.x == 0) {
        unsigned* bar = b.bar;
        __builtin_amdgcn_s_waitcnt(0);
        unsigned nloc = b.st[0], nx = b.st[1];
        if (nloc == 0u) { xcd_barrier_complete(bar, b.x, nloc, nx); b.st[0] = nloc; b.st[1] = nx; }
        const unsigned old = xb_add(&bar[XB_XSUB(b.x)], 1u);
        const unsigned gen = old / nloc;
        if (old + 1u == (gen + 1u) * nloc) {
            __builtin_amdgcn_fence(__ATOMIC_RELEASE, "agent");
            asm volatile("s_waitcnt vmcnt(0)" ::: "memory");
            const unsigned og = xb_add(&bar[XB_TOP], 1u);
            const unsigned tg = og / nx;
            if (og + 1u == (tg + 1u) * nx) xb_add(&bar[XB_TOPGEN], 1u);
            else XB_SPIN(xb_ld(&bar[XB_TOPGEN]) == tg, bar);
            __builtin_amdgcn_fence(__ATOMIC_ACQUIRE, "agent");
            xb_add(&bar[XB_XGEN(b.x)], 1u);
            asm volatile("s_waitcnt vmcnt(0)" ::: "memory");
        } else {
            XB_SPIN(xb_ld(&bar[XB_XGEN(b.x)]) == gen, bar);
            __builtin_amdgcn_fence(__ATOMIC_ACQUIRE, "agent");
            asm volatile("s_waitcnt vmcnt(0)" ::: "memory");
        }
    }
    __syncthreads();
}
constexpr int NWAVES = 8;
constexpr int BATCH = 2, SEQ = 8192, DMODEL = 1024, M = BATCH * SEQ;
constexpr int EV_COLS = 3592, EV_N = 3584, OD_N = 1280;
constexpr int NEXP = 16384;
constexpr float L2E = 1.4426950408889634f;
constexpr float RMS_EPS = 1e-6f;

#ifndef MK_N_LAUNCHES
#define MK_N_LAUNCHES 1
#endif
constexpr int N_PHASES = 14;
constexpr int N_LAUNCHES = MK_N_LAUNCHES;

constexpr size_t MiB = 1u << 20;
constexpr size_t WS_CTL = 0, CTL_ZERO_BYTES = 1 * MiB;
constexpr size_t WS_WIN0 = 2 * MiB, WS_WOUT0 = 9 * MiB, WS_WQ0 = 11 * MiB, WS_WIN1 = 13 * MiB, WS_WOUT1 = 16 * MiB, WS_WQ1 = 18 * MiB;
constexpr size_t WS_SK = 20 * MiB;
constexpr size_t WS_ROPE = 21 * MiB;
constexpr size_t WS_RA0 = 22 * MiB, WS_RA1 = 22 * MiB + 65536;
constexpr size_t WS_LF = 23 * MiB;
constexpr size_t WS_FL2 = 24 * MiB;
constexpr size_t WS_KSUM = 25 * MiB;
constexpr size_t WS_SEL = 26 * MiB;
constexpr size_t WS_GAIN = 28 * MiB;
constexpr size_t WS_TSC = 29 * MiB;
constexpr size_t WS_RSP = 27 * MiB;
constexpr size_t WS_XB = 32 * MiB;
constexpr size_t WS_QKV = 64 * MiB;
constexpr size_t WS_AO = 176 * MiB;
constexpr size_t WS_QP = 208 * MiB;
constexpr size_t WS_TAB = 240 * MiB;
constexpr size_t WS_UL = 368 * MiB;
constexpr size_t WS_LIST = 385 * MiB;
constexpr size_t WS_CNT = 389 * MiB;
constexpr size_t WS_LSE = 390 * MiB;
constexpr size_t WS_PO = 392 * MiB;
constexpr size_t WS_END = 440 * MiB;
constexpr int CW_BAR = 4096;

constexpr int RING_BYTES = 131072;
constexpr int LDS_BYTES = 147456;
constexpr int LDSCTL_OFF = LDS_BYTES - 512, MISC_OFF = LDSCTL_OFF + 64;

typedef unsigned v2u __attribute__((ext_vector_type(2)));
typedef __bf16 bf16x2v __attribute__((ext_vector_type(2)));
__device__ __forceinline__ float bflo(unsigned w) { return __uint_as_float(w << 16); }
__device__ __forceinline__ float bfhi(unsigned w) { return __uint_as_float(w & 0xffff0000u); }
__device__ __forceinline__ float dot2bf(unsigned a, unsigned b, float c) { return __builtin_amdgcn_fdot2_f32_bf16(__builtin_bit_cast(bf16x2v, a), __builtin_bit_cast(bf16x2v, b), c, false); }
#define DPPF(x, ctrl) __builtin_bit_cast(float, __builtin_amdgcn_update_dpp(0, __builtin_bit_cast(int, x), ctrl, 0xf, 0xf, false))
#define RDLF(x, l) __builtin_bit_cast(float, __builtin_amdgcn_readlane(__builtin_bit_cast(int, x), l))
__device__ __forceinline__ float wave_sum(float v) {
    v += DPPF(v, 0xB1); v += DPPF(v, 0x4E); v += DPPF(v, 0x124); v += DPPF(v, 0x128);
    return (RDLF(v, 0) + RDLF(v, 16)) + (RDLF(v, 32) + RDLF(v, 48));
}
__device__ __forceinline__ float wave_max(float v) {
    v = fmaxf(v, DPPF(v, 0xB1)); v = fmaxf(v, DPPF(v, 0x4E)); v = fmaxf(v, DPPF(v, 0x124)); v = fmaxf(v, DPPF(v, 0x128));
    return fmaxf(fmaxf(RDLF(v, 0), RDLF(v, 16)), fmaxf(RDLF(v, 32), RDLF(v, 48)));
}

struct Args { const float* in[19]; float* out; unsigned char* ws; int ph_lo, ph_hi, li, pad; };
struct Ctx { unsigned char* lds; int tid, lane, wave, vcu, G; };

__device__ __forceinline__ int perm_src_col(int c) { const int r = c & 255; return (c & ~255) + 64 * ((r >> 5) & 3) + 16 * ((r >> 3) & 3) + 8 * (r >> 7) + (r & 7); }
__device__ __forceinline__ void p0_transpose_item(const float* W, int Nsrc, const float* gain, bool permc, bf16* WT, LAS float* scr, int item, int nblk, int lane) {
    const int kb = item / nblk, nb = item % nblk, k0 = 64 * kb, n0 = 32 * nb;
    const int sc = permc ? perm_src_col(n0 + (lane & 31)) : n0 + (lane & 31);
    const int c = lane & 7;
    f32x4 ga = {1.f, 1.f, 1.f, 1.f}, gb = ga;
    if (gain) { ga = *(const f32x4*)(gain + k0 + 8 * c); gb = *(const f32x4*)(gain + k0 + 8 * c + 4); }
    { const float* wp = W + (size_t)(k0 + (lane >> 5)) * Nsrc + sc; float wv[32];
#pragma unroll
      for (int i = 0; i < 32; ++i) wv[i] = wp[(size_t)(2 * i) * Nsrc];
#pragma unroll
      for (int i = 0; i < 32; ++i) scr[(2 * i + (lane >> 5)) * 33 + (lane & 31)] = wv[i]; }
    LDS_WAIT(); asm volatile("" ::: "memory");
#pragma unroll
    for (int j = 0; j < 4; ++j) { const int n = (lane >> 3) + 8 * j; const LAS float* s = scr + (8 * c) * 33 + n;
        v4u o; o.x = pk2(s[0 * 33] * ga.x, s[1 * 33] * ga.y); o.y = pk2(s[2 * 33] * ga.z, s[3 * 33] * ga.w); o.z = pk2(s[4 * 33] * gb.x, s[5 * 33] * gb.y); o.w = pk2(s[6 * 33] * gb.z, s[7 * 33] * gb.w);
        *(GAS v4u*)(WT + (size_t)(n0 + n) * 1024 + k0 + 8 * c) = o; }
    LDS_WAIT(); asm volatile("" ::: "memory");
}
__device__ __forceinline__ void sincos_d(float af, float& s, float& c) {
    const double a = (double)af, k = __builtin_rint(a * 0.15915494309189535), r = (a - k * 6.283185307179586) - k * 2.4492935982947064e-16, r2 = r * r;
    double ts = 1.0, tc = 1.0, ss = 1.0, cc = 1.0;
#pragma unroll
    for (int i = 1; i <= 13; ++i) { tc *= r2 * (-1.0 / (double)((2 * i - 1) * (2 * i))); ts *= r2 * (-1.0 / (double)((2 * i) * (2 * i + 1))); cc += tc; ss += ts; }
    s = (float)(r * ss); c = (float)cc;
}
#ifndef CONV_L1_LATE
#define CONV_L1_LATE 2
#endif
constexpr int CW_CONV = 2048;
typedef unsigned v6u __attribute__((ext_vector_type(6)));
typedef unsigned v3u __attribute__((ext_vector_type(3)));
struct UB { v4u a4, b4; v2u a2, b2; };
typedef _Float16 h32 __attribute__((ext_vector_type(32)));
__device__ __forceinline__ void conv_rows4_fp6(const Args& a, unsigned char* ws, int layer, int t, int e0, int lane) {
    const int slot = 2 * layer + t; float* tsc = (float*)(ws + WS_TSC);
    const int sub = lane >> 5, blk = (lane >> 4) & 1, li = lane & 15;
    const f32x4* sp = (const f32x4*)(a.in[17 + t] + ((size_t)layer * NEXP + e0 + sub) * 1024 + 512 * blk + 4 * li);
    f32x4 v[2][8];
#pragma unroll
    for (int r2 = 0; r2 < 2; ++r2)
#pragma unroll
        for (int q = 0; q < 8; ++q) v[r2][q] = __builtin_nontemporal_load(sp + r2 * 512 + 16 * q);
#pragma unroll
    for (int r2 = 0; r2 < 2; ++r2) { float mx = 0.f;
#pragma unroll
        for (int q = 0; q < 8; ++q) mx = fmaxf(mx, fmaxf(fmaxf(fabsf(v[r2][q].x), fabsf(v[r2][q].y)), fmaxf(fabsf(v[r2][q].z), fabsf(v[r2][q].w))));
        mx = fmaxf(mx, __shfl_xor(mx, 1)); mx = fmaxf(mx, __shfl_xor(mx, 2)); mx = fmaxf(mx, __shfl_xor(mx, 4)); mx = fmaxf(mx, __shfl_xor(mx, 8)); mx = fmaxf(mx, __shfl_xor(mx, 16));
        const float step = mx > 0.f ? mx * (1.0f / 7.5f) : 1.0f, inv = 1.0f / step;
        h32 hv;
#pragma unroll
        for (int q = 0; q < 8; ++q) { hv[4 * q] = (_Float16)(v[r2][q].x * inv); hv[4 * q + 1] = (_Float16)(v[r2][q].y * inv); hv[4 * q + 2] = (_Float16)(v[r2][q].z * inv); hv[4 * q + 3] = (_Float16)(v[r2][q].w * inv); }
        const v6u pk = __builtin_amdgcn_cvt_scalef32_pk32_fp6_f16(hv, 1.0f);
        unsigned char* op = ws + WS_TAB + (size_t)slot * 32 * MiB + (size_t)(e0 + 2 * r2 + sub) * 768;
        *(v4u*)(op + 256 * blk + 16 * li) = (v4u){pk[0], pk[1], pk[2], pk[3]}; *(v2u*)(op + 512 + 128 * blk + 8 * li) = (v2u){pk[4], pk[5]};
        if ((lane & 31) == 0) tsc[slot * NEXP + e0 + 2 * r2 + sub] = step; }
}
__device__ __forceinline__ void conv_rows4(const Args& a, unsigned char* ws, int layer, int t, int e0, int lane) {
    if (t) { conv_rows4_fp6(a, ws, layer, t, e0, lane); return; }
    const int slot = 2 * layer + t; float* tsc = (float*)(ws + WS_TSC);
    const f32x4* sp = (const f32x4*)(a.in[17 + t] + ((size_t)layer * NEXP + e0) * 1024) + lane;
    f32x4 v[4][4];
#pragma unroll
    for (int r = 0; r < 4; ++r)
#pragma unroll
        for (int j = 0; j < 4; ++j) v[r][j] = __builtin_nontemporal_load(sp + r * 256 + 64 * j);
#pragma unroll
    for (int r = 0; r < 4; ++r) { float mx = 0.f;
#pragma unroll
        for (int j = 0; j < 4; ++j) mx = fmaxf(mx, fmaxf(fmaxf(fabsf(v[r][j].x), fabsf(v[r][j].y)), fmaxf(fabsf(v[r][j].z), fabsf(v[r][j].w))));
        mx = wave_max(mx); const float step = mx > 0.f ? mx * (t ? 1.0f / 240.0f : 1.0f / 127.0f) : 1.0f, inv = 1.0f / step;
        unsigned* op = (unsigned*)(ws + WS_TAB + (size_t)slot * 32 * MiB + (size_t)(e0 + r) * 1024) + lane;
#pragma unroll
        for (int j = 0; j < 4; ++j) {
            if (t) { int w = 0; w = __builtin_amdgcn_cvt_pk_fp8_f32(v[r][j].x * inv, v[r][j].y * inv, w, false); w = __builtin_amdgcn_cvt_pk_fp8_f32(v[r][j].z * inv, v[r][j].w * inv, w, true); op[64 * j] = (unsigned)w; }
            else { const int q0 = (int)rintf(v[r][j].x * inv), q1 = (int)rintf(v[r][j].y * inv), q2 = (int)rintf(v[r][j].z * inv), q3 = (int)rintf(v[r][j].w * inv);
                op[64 * j] = (unsigned)(q0 & 255) | ((unsigned)(q1 & 255) << 8) | ((unsigned)(q2 & 255) << 16) | ((unsigned)(q3 & 255) << 24); } }
        if (lane == 0) tsc[slot * NEXP + e0 + r] = step; }
}
__device__ __forceinline__ void conv_pull(const Args& a, const Ctx& C, int layer) {
    volatile LAS unsigned* box = (volatile LAS unsigned*)(C.lds + LDSCTL_OFF + 256);
    gu32* cnt = (gu32*)(a.ws + WS_CTL) + CW_CONV + 64 * layer;
    for (;;) {
        if (C.tid == 0) box[0] = __hip_atomic_fetch_add(cnt, 1u, RLX_AGENT);
        __syncthreads();
        const unsigned c = box[0];
        __syncthreads();
        if (c >= 512u) break;
        const int t = (int)(c >> 8), e0 = (int)(c & 255u) * 64 + C.wave * 8;
        conv_rows4(a, a.ws, layer, t, e0, C.lane); conv_rows4(a, a.ws, layer, t, e0 + 4, C.lane);
    }
}
__device__ __forceinline__ void p0_prologue(const Args& a, const Ctx& C) {
    unsigned char* ws = a.ws;
    const int gw = C.vcu * NWAVES + C.wave, NGW = C.G * NWAVES, gt = C.vcu * (NWAVES * 64) + C.tid, NGT = C.G * NWAVES * 64;
    const float* x = a.in[0]; const float* an = a.in[1]; const float* fn = a.in[2]; const float* ev_w_in = a.in[3]; const float* fbias = a.in[4];
    LAS float* wf = (LAS float*)(C.lds + 69632);
    for (int i = C.tid; i < 1024; i += NWAVES * 64) { const float g = an[i];
#pragma unroll
        for (int h = 0; h < 8; ++h) wf[h * 1024 + i] = ev_w_in[(size_t)i * EV_COLS + EV_N + h] * g; }
    __syncthreads();
    for (int stage = 0; stage < 2; ++stage) {
      if ((stage ^ (C.wave & 1)) == 0) {
    LAS float* scr = (LAS float*)(C.lds + C.wave * 8704);
    constexpr int I_IN0 = 16 * (EV_N / 32), I_SQ = 16 * 32, I_IN1 = 16 * (OD_N / 32);
    constexpr int NITEMS = I_IN0 + 2 * I_SQ + I_IN1 + 2 * I_SQ;
#ifndef PROBE_TR_REPS
#define PROBE_TR_REPS 1
#endif
    for (int rep_ = 0; rep_ < PROBE_TR_REPS; ++rep_)
    for (int it = gw; it < NITEMS; it += NGW) {
        int r = it;
        if (r < I_IN0) { p0_transpose_item(ev_w_in, EV_COLS, an, true, (bf16*)(ws + WS_WIN0), scr, r, EV_N / 32, C.lane); continue; } r -= I_IN0;
        if (r < I_SQ) { p0_transpose_item(a.in[9], 1024, nullptr, false, (bf16*)(ws + WS_WOUT0), scr, r, 32, C.lane); continue; } r -= I_SQ;
        if (r < I_SQ) { p0_transpose_item(a.in[15], 1024, fn, false, (bf16*)(ws + WS_WQ0), scr, r, 32, C.lane); continue; } r -= I_SQ;
        if (r < I_IN1) { p0_transpose_item(a.in[10], OD_N, an + 1024, true, (bf16*)(ws + WS_WIN1), scr, r, OD_N / 32, C.lane); continue; } r -= I_IN1;
        if (r < I_SQ) { p0_transpose_item(a.in[14], 1024, nullptr, false, (bf16*)(ws + WS_WOUT1), scr, r, 32, C.lane); continue; } r -= I_SQ;
        p0_transpose_item(a.in[15] + (size_t)1024 * 1024, 1024, fn + 1024, false, (bf16*)(ws + WS_WQ1), scr, r, 32, C.lane);
    }
    { bf16* xb = (bf16*)(ws + WS_XB); float* ra0 = (float*)(ws + WS_RA0); float* lf = (float*)(ws + WS_LF);
#ifndef PROBE_ROW_REPS
#define PROBE_ROW_REPS 1
#endif
      for (int rep_ = 0; rep_ < PROBE_ROW_REPS; ++rep_) {
      f32x4 vn[4];
      if (gw < M) { const GAS f32x4* xr0 = (const GAS f32x4*)(x + (size_t)gw * DMODEL) + C.lane;
#pragma unroll
          for (int j = 0; j < 4; ++j) vn[j] = xr0[64 * j]; }
      for (int m = gw; m < M; m += NGW) {
        f32x4 v[4]; float s = 0.f; float fa[8];
#pragma unroll
        for (int j = 0; j < 4; ++j) v[j] = vn[j];
        if (m + NGW < M) { const GAS f32x4* xr1 = (const GAS f32x4*)(x + (size_t)(m + NGW) * DMODEL) + C.lane;
#pragma unroll
            for (int j = 0; j < 4; ++j) vn[j] = xr1[64 * j]; }
#pragma unroll
        for (int h = 0; h < 8; ++h) fa[h] = 0.f;
#pragma unroll
        for (int j = 0; j < 4; ++j) { s += (v[j].x * v[j].x + v[j].y * v[j].y) + (v[j].z * v[j].z + v[j].w * v[j].w);
#pragma unroll
            for (int h = 0; h < 8; ++h) { const f32x4 w = *(const LAS f32x4*)(wf + h * 1024 + 256 * j + 4 * C.lane); fa[h] += (v[j].x * w.x + v[j].y * w.y) + (v[j].z * w.z + v[j].w * w.w); } }
        const float r = 1.0f / sqrtf(wave_sum(s) * (1.0f / DMODEL) + RMS_EPS);
        GAS unsigned long long* o8 = (GAS unsigned long long*)(xb + (size_t)m * DMODEL) + C.lane;
#pragma unroll
        for (int j = 0; j < 4; ++j) o8[64 * j] = (unsigned long long)pk2(v[j].x, v[j].y) | ((unsigned long long)pk2(v[j].z, v[j].w) << 32);
        float mine = 0.f;
#pragma unroll
        for (int h = 0; h < 8; ++h) { const float t = wave_sum(fa[h]); if (C.lane == h) mine = t; }
        if (C.lane < 8) { const float z = r * mine + fbias[C.lane]; lf[(size_t)m * 8 + C.lane] = z >= 0.f ? -log1pf(expf(-z)) : z - log1pf(expf(z)); }
        if (C.lane == 0) ra0[m] = r;
      } } }
      } else {
#ifndef PROBE_CONV_REPS
#define PROBE_CONV_REPS 1
#endif
      for (int rep_ = 0; rep_ < PROBE_CONV_REPS; ++rep_) for (int r4 = gw; r4 < NEXP / CONV_L1_LATE; r4 += NGW) { const int tl = r4 / (NEXP / 4), e0 = (r4 % (NEXP / 4)) * 4; conv_rows4(a, ws, tl >> 1, tl & 1, e0, C.lane); }
      }
    }
    {
      const float* sk = a.in[16];
      for (size_t i = gt; i < (size_t)262144 / 8; i += NGT) { const f32x4 p = *((const f32x4*)sk + 2 * i), q = *((const f32x4*)sk + 2 * i + 1);
            v4u o; o.x = pk2(p.x, p.y); o.y = pk2(p.z, p.w); o.z = pk2(q.x, q.y); o.w = pk2(q.z, q.w); *((v4u*)(ws + WS_SK) + i) = o; } }
    if (gt < 384) { const int g = gt >> 6, d = gt & 63; const float* src = g == 0 ? a.in[5] : g == 1 ? a.in[6] : g == 2 ? a.in[7] : g == 3 ? a.in[8] : g == 4 ? a.in[11] : a.in[12]; ((float*)(ws + WS_GAIN))[gt] = src[d]; }
    { float* cs = (float*)(ws + WS_ROPE);
      for (int i = gt; i < SEQ * 8; i += NGT) { const int pos = i >> 3, f = i & 7; const float inv = powf(500000.0f, -0.125f * (float)f), ang = (float)pos * inv; float s, c; sincos_d(ang, s, c);
          cs[pos * 16 + f] = c; cs[pos * 16 + 8 + f] = s; } }
}

__device__ __forceinline__ void p2_route(const Args& a, const Ctx& C, int rid, int nr) {
    unsigned char* ws = a.ws;
    for (int sq = rid; sq < 16; sq += nr) { const int b = sq >> 3, h = sq & 7; const float* lf = (const float*)(ws + WS_LF); float* fl2 = (float*)(ws + WS_FL2) + (size_t)sq * SEQ;
        LAS double* wtot = (LAS double*)(C.lds + 32768);
        double loc[16]; double run = 0.0;
#pragma unroll
        for (int i = 0; i < 16; ++i) { run += (double)lf[((size_t)b * SEQ + 16 * C.tid + i) * 8 + h]; loc[i] = run; }
        double inc = run;
#pragma unroll
        for (int o = 1; o < 64; o <<= 1) { const double y = __shfl_up(inc, o); if (C.lane >= o) inc += y; }
        if (C.lane == 63) wtot[C.wave] = inc;
        __syncthreads();
        double base = inc - run;
        for (int w = 0; w < C.wave; ++w) base += wtot[w];
#pragma unroll
        for (int i = 0; i < 16; ++i) fl2[16 * C.tid + i] = (float)((base + loc[i]) * 1.4426950408889634);
    }
    __syncthreads();
    for (int u0 = 2 * rid; u0 < 512; u0 += 2 * nr) { const int unit = u0 + (C.tid >> 8), qi = C.tid & 255, half = C.tid >> 8; const int b = unit >> 8, h = (unit >> 5) & 7, qb = unit & 31;
      __syncthreads();
      if (unit < 512) {
        LAS float* km = (LAS float*)(C.lds) + half * 2048;
        const float* ksum = (const float*)(ws + WS_KSUM);
        float k0v[8], k1v[8];
#pragma unroll
        for (int it = 0; it < 8; ++it) { const int i = qi + 256 * it, j = i >> 6, d = i & 63; const size_t p0 = ((size_t)(((b * 32 + j) * 2 + 0) * 8 + h)) * 64 + d, p1 = ((size_t)(((b * 32 + j) * 2 + 1) * 8 + h)) * 64 + d;
            const bool in = i < qb * 64; k0v[it] = in ? ksum[p0] : 0.f; k1v[it] = in ? ksum[p1] : 0.f; }
#pragma unroll
        for (int it = 0; it < 8; ++it) { const int i = qi + 256 * it; if (i < qb * 64) km[i] = (k0v[it] + k1v[it]) * (1.0f / 256.0f); }
      }
      __syncthreads();
      if (unit < 512) {
        const LAS float* km = (const LAS float*)(C.lds) + half * 2048;
        const bf16* qa = (const bf16*)(ws + WS_QKV);
        const v4u* qp = (const v4u*)(qa + ((size_t)b * SEQ + 256 * qb + qi) * 512 + h * 64);
        float q[64];
#pragma unroll
        for (int c = 0; c < 8; ++c) { const v4u w = qp[c];
#pragma unroll
            for (int j = 0; j < 4; ++j) { q[8 * c + 2 * j] = bflo(w[j]); q[8 * c + 2 * j + 1] = bfhi(w[j]); } }
        float v0 = -INFINITY, v1 = -INFINITY, v2 = -INFINITY; int i0 = -1, i1 = -1, i2 = -1;
        for (int j = 0; j < qb; ++j) { float g0 = 0.f, g1 = 0.f, g2 = 0.f, g3 = 0.f;
#pragma unroll
            for (int d = 0; d < 64; d += 4) { const f32x4 k = *(const LAS f32x4*)(km + j * 64 + d); g0 += q[d] * k.x; g1 += q[d + 1] * k.y; g2 += q[d + 2] * k.z; g3 += q[d + 3] * k.w; }
            const float g = (g0 + g1) + (g2 + g3);
            if (g > v0) { v2 = v1; i2 = i1; v1 = v0; i1 = i0; v0 = g; i0 = j; } else if (g > v1) { v2 = v1; i2 = i1; v1 = g; i1 = j; } else if (g > v2) { v2 = g; i2 = j; } }
        unsigned msk = 0u; if (i0 >= 0) msk |= 1u << i0; if (i1 >= 0) msk |= 1u << i1; if (i2 >= 0) msk |= 1u << i2;
        ((unsigned*)(ws + WS_SEL))[((size_t)(b * 8 + h)) * SEQ + 256 * qb + qi] = msk;
      }
    }
}

__device__ __forceinline__ void p3_lists_item(const Args& a, const Ctx& C, int bh, int j) {
    unsigned char* ws = a.ws; LAS unsigned* wc = (LAS unsigned*)(C.lds);
    const unsigned* sel = (const unsigned*)(ws + WS_SEL) + (size_t)bh * SEQ;
    unsigned short* out = (unsigned short*)(ws + WS_LIST) + (size_t)bh * 126976 + (8192 * j - 128 * j * (j + 1));
    unsigned sv[16];
#pragma unroll
    for (int it = 0; it < 16; ++it) { const int q = 256 * (j + 1) + NWAVES * 64 * it + C.tid; sv[it] = q < SEQ ? sel[q] : 0u; }
    unsigned fm = 0u; unsigned short below[16];
#pragma unroll
    for (int it = 0; it < 16; ++it) { const int q = 256 * (j + 1) + NWAVES * 64 * it + C.tid; const bool f = q < SEQ && ((sv[it] >> j) & 1u);
        const unsigned long long m = __ballot(f); below[it] = (unsigned short)__builtin_popcountll(m & ((1ull << C.lane) - 1ull)); fm |= f ? (1u << it) : 0u;
        if (C.lane == 0) wc[it * NWAVES + C.wave] = (unsigned)__builtin_popcountll(m); }
    __syncthreads();
    unsigned base = 0u;
#pragma unroll
    for (int it = 0; it < 16; ++it) { unsigned off = base, tot = 0u;
#pragma unroll
        for (int w = 0; w < NWAVES; ++w) { const unsigned c = wc[it * NWAVES + w]; if (w < C.wave) off += c; tot += c; }
        if ((fm >> it) & 1u) out[off + below[it]] = (unsigned short)(256 * (j + 1) + NWAVES * 64 * it + C.tid);
        base += tot; }
    if (C.tid == 0) ((int*)(ws + WS_CNT))[bh * 32 + j] = (int)base;
    __syncthreads();
}
__device__ __forceinline__ void p3_lists(const Args& a, const Ctx& C) {
    for (int item = C.vcu; item < 16 * 31; item += C.G) p3_lists_item(a, C, item / 31, item % 31);
}

__device__ __forceinline__ void p4_attn_l0a(const Args& a, const Ctx& C) {
    unsigned char* ws = a.ws; const attn_body::bf16* qkv = (const attn_body::bf16*)(ws + WS_QKV); const size_t BUF = (size_t)M * 512;
    char* shm = (char*)C.lds;
    LAS int* upref = (LAS int*)(C.lds + 124928);
    const int* cnt = (const int*)(ws + WS_CNT);
    { int v = 0; if (C.tid < 496) v = (cnt[(C.tid / 31) * 32 + (C.tid % 31)] + 255) >> 8;
      int inc = v;
#pragma unroll
      for (int o = 1; o < 64; o <<= 1) { const int y = __shfl_up(inc, o); if (C.lane >= o) inc += y; }
      LAS int* wtot = (LAS int*)(C.lds + 127232 + 2048);
      if (C.lane == 63) wtot[C.wave] = inc;
      __syncthreads();
      int base = 0;
      for (int w2 = 0; w2 < C.wave; ++w2) base += wtot[w2];
      if (C.tid < 496) upref[C.tid] = base + inc - v;
      if (C.tid == 495) upref[496] = base + inc; }
    __syncthreads();
    const int U = upref[496];
    LAS int* bnd = (LAS int*)(C.lds + 127232);
    if (C.wave == 0) {
        constexpr float CG = 11.0f, CT = 1.3f, CFO = 4.0f;
        const float gq_ = wave_max(fabsf(a.in[7][C.lane])), gk_ = wave_max(fabsf(a.in[8][C.lane]));
        const float bl_ = 2.0f * (64.0f * gq_ * gk_ * attn_body::C2 * 1.02f + 1.0f);
        float cfv[4], s4 = 0.f, f4 = 0.f;
#pragma unroll
        for (int k = 0; k < 4; ++k) { const int c = 4 * C.lane + k; cfv[k] = 0.f;
            if (c < C.G && c < 256) { const int bh = c >> 4, sq = c & 15; const float fend = ((const float*)(ws + WS_FL2))[(size_t)bh * SEQ + SEQ - 1];
                const float slope = fmaxf(-fend * (1.0f / (float)(SEQ - 1)), 1e-6f); const float wtf = (160.0f + bl_) / (slope * 64.0f) + 3.0f; const int wt = wtf < 128.f ? (int)wtf : 128;
                const int ta = 4 * sq + 4 < wt + 4 ? 4 * sq + 4 : wt + 4, tb = 4 * (31 - sq) + 4 < wt + 4 ? 4 * (31 - sq) + 4 : wt + 4;
                cfv[k] = CT * (float)(ta + tb) + 2.0f * CFO; }
            f4 += cfv[k]; }
        const float target = ((float)U * CG + wave_sum(f4)) / (float)C.G;
        float sh[4];
#pragma unroll
        for (int k = 0; k < 4; ++k) { sh[k] = (4 * C.lane + k < C.G) ? fmaxf(0.f, (target - cfv[k]) * (1.0f / CG)) : 0.f; s4 += sh[k]; }
        float inc = s4;
#pragma unroll
        for (int o = 1; o < 64; o <<= 1) { const float y = __shfl_up(inc, o); if (C.lane >= o) inc += y; }
        const float tots = __shfl(inc, 63), scale = tots > 0.f ? (float)U / tots : 0.f;
        float run = inc - s4;
#pragma unroll
        for (int k = 0; k < 4; ++k) { run += sh[k]; int e = (int)(run * scale + 0.5f); e = e < U ? e : U; if (4 * C.lane + k >= C.G - 1) e = U; if (4 * C.lane + k < 256) bnd[4 * C.lane + k] = e; }
    }
    __syncthreads();
    const int u0 = C.vcu ? bnd[C.vcu - 1] : 0, u1 = bnd[C.vcu];
#ifndef PROBE_GREP
#define PROBE_GREP 1
#endif
    for (int grep_ = 0; grep_ < PROBE_GREP; ++grep_)
    for (int u = u0; u < u1; ++u) {
        int lo = 0, hi = 496;
        while (hi - lo > 1) { const int mid = (lo + hi) >> 1; if (upref[mid] <= u) lo = mid; else hi = mid; }
        const int item = lo, c = u - upref[lo], bh = item / 31, j = item % 31, b = bh >> 3, h = bh & 7, n = cnt[bh * 32 + j] - 256 * c;
        attn_body::UnitArgs um; um.Q = qkv; um.K = qkv + BUF; um.V = qkv + 2 * BUF; um.O = nullptr; um.qcol = h * 64; um.kcol = h * 64; um.ocol = 0;
        um.Fl2 = nullptr; um.gate = nullptr; um.sel = (const unsigned*)(ws + WS_SEL) + (size_t)bh * SEQ; um.sinkp = nullptr; um.bl2x2 = 0.f;
        um.glist = (const unsigned short*)(ws + WS_LIST) + (size_t)bh * 126976 + (8192 * j - 128 * j * (j + 1)) + 256 * c; um.gn = n < 256 ? n : 256;
        um.PO = (attn_body::bf16*)(ws + WS_PO) + (size_t)bh * SEQ * 192; um.LSE = (float*)(ws + WS_LSE) + (size_t)bh * SEQ * 3;
        um.kvres = (u > u0 && c > 0) ? 1 : 0;
        attn_body::attn_unit<3, 8, 512, 512, 1024>(b, j, um, shm);
    }
    { const int bh = C.vcu >> 4, s = C.vcu & 15, b = bh >> 3, h = bh & 7;
      const float gq = wave_max(fabsf(a.in[7][C.lane])), gk = wave_max(fabsf(a.in[8][C.lane]));
      const float bl2x2 = 2.0f * (64.0f * gq * gk * attn_body::C2 * 1.02f + 1.0f);
      attn_body::UnitArgs uf; uf.Q = qkv + 3 * BUF; uf.K = qkv + 4 * BUF; uf.V = qkv + 5 * BUF; uf.O = (attn_body::bf16*)(ws + WS_AO); uf.qcol = h * 64; uf.kcol = h * 64; uf.ocol = 512 + h * 64;
      uf.Fl2 = (const float*)(ws + WS_FL2) + (size_t)bh * SEQ; uf.gate = qkv + 6 * BUF + h * 64; uf.sel = nullptr; uf.sinkp = nullptr; uf.bl2x2 = bl2x2;
      uf.glist = nullptr; uf.gn = 0; uf.PO = nullptr; uf.LSE = nullptr; uf.kvres = 0;
      if (C.vcu < 256)
#ifndef PROBE_FREP
#define PROBE_FREP 1
#endif
          for (int i = 0; i < 2 * PROBE_FREP; ++i) attn_body::attn_unit<1, 8, 512, 512, 1024>(b, (i & 1) ? s : 31 - s, uf, shm); }
}
__device__ __forceinline__ void p5_attn_l0b(const Args& a, const Ctx& C) {
    unsigned char* ws = a.ws; const attn_body::bf16* qkv = (const attn_body::bf16*)(ws + WS_QKV); const size_t BUF = (size_t)M * 512;
    for (int pmb = C.vcu >> 2; pmb < M / 256; pmb += C.G >> 2)
    for (int i = 0; i < 2; ++i) {
    const int b = pmb >> 5, qbk = pmb & 31, h = (C.vcu & 3) * 2 + i, bh = b * 8 + h;
    attn_body::UnitArgs um; um.Q = qkv; um.K = qkv + BUF; um.V = qkv + 2 * BUF; um.O = (attn_body::bf16*)(ws + WS_AO); um.qcol = h * 64; um.kcol = h * 64; um.ocol = h * 64;
    um.Fl2 = nullptr; um.gate = nullptr; um.sel = (const unsigned*)(ws + WS_SEL) + (size_t)bh * SEQ; um.sinkp = nullptr; um.bl2x2 = 0.f;
    um.glist = nullptr; um.gn = 0; um.PO = (attn_body::bf16*)(ws + WS_PO) + (size_t)bh * SEQ * 192; um.LSE = (float*)(ws + WS_LSE) + (size_t)bh * SEQ * 3; um.kvres = 0;
    char* shm = (char*)C.lds;
    attn_body::attn_unit<4, 8, 512, 512, 1024>(b, qbk, um, shm); }
}
__device__ __forceinline__ void p8_attn_l1(const Args& a, const Ctx& C) {
    unsigned char* ws = a.ws;
    char* shm = (char*)C.lds;
    for (int pmb = C.vcu >> 2; pmb < M / 256; pmb += C.G >> 2)
    for (int i = 0; i < 4; ++i) {
    const int b = pmb >> 5, qbk = pmb & 31, hq = (C.vcu & 3) * 4 + i;
    attn_body::UnitArgs u; u.Q = (const attn_body::bf16*)(ws + WS_QKV); u.K = (const attn_body::bf16*)(ws + WS_QKV + 32 * MiB); u.V = (const attn_body::bf16*)(ws + WS_QKV + 36 * MiB); u.O = (attn_body::bf16*)(ws + WS_AO);
    u.qcol = hq * 64; u.kcol = (hq >> 3) * 64; u.ocol = hq * 64; u.Fl2 = nullptr; u.gate = nullptr; u.sel = nullptr; u.sinkp = a.in[13] + hq; u.bl2x2 = 0.f; u.glist = nullptr; u.gn = 0; u.PO = nullptr; u.LSE = nullptr; u.kvres = 0;
    attn_body::attn_unit<2, 8, 1024, 128, 1024>(b, qbk, u, shm); }
}

constexpr int SC_LD = 129;
constexpr int PL_TOPIDX = 256 * SC_LD * 4;
constexpr int PL_ALDS = PL_TOPIDX + 4096;
constexpr int PL_END = PL_ALDS + 4096;
static_assert(PL_END <= LDSCTL_OFF, "PEER LDS map");
__device__ __forceinline__ float gelu_erf(float v) { return 0.5f * v * (1.0f + erff(v * 0.70710678118654752f)); }

__device__ const unsigned char PEER_CAND[52] = {0,1,2,3,4,5,6,7,8,9,10,11,12,13,14,15,16,17,18,19,20,21,22,23,32,33,34,35,36,48,49,50,51,64,65,66,80,81,96,97,112,113,128,144,160,176,192,208,224,240,255,255};
template <int XM> __device__ __forceinline__ void merge16(float (&L)[16]) {
    float R[16];
#pragma unroll
    for (int i = 0; i < 16; ++i) R[i] = __shfl_xor(L[15 - i], XM);
#pragma unroll
    for (int i = 0; i < 16; ++i) L[i] = fmaxf(L[i], R[i]);
#pragma unroll
    for (int d = 8; d >= 1; d >>= 1)
#pragma unroll
        for (int i = 0; i < 16; ++i) if ((i & d) == 0) { const float hi = fmaxf(L[i], L[i + d]), lo = fminf(L[i], L[i + d]); L[i] = hi; L[i + d] = lo; }
}
constexpr int PL_SEQ = 32768, PL_HIST = 98304, PL_AL = 102400;
template <bool LAST> __device__ __forceinline__ void peer_phase(const Args& a, const Ctx& C, int layer) {
    unsigned char* ws = a.ws;
    const bf16* qp = (const bf16*)(ws + WS_QP);
    const bf16* skb = (const bf16*)(ws + WS_SK) + (size_t)layer * 131072;
    const unsigned char* Dt = ws + WS_TAB + (size_t)(2 * layer) * 32 * MiB;
    const unsigned char* Ut = ws + WS_TAB + (size_t)(2 * layer + 1) * 32 * MiB;
    const float* tsc = (const float*)(ws + WS_TSC) + (size_t)(2 * layer) * NEXP;
    const float* rsp = (const float*)(ws + WS_RSP);
    const float* gffn = a.in[2] + layer * 1024;
    float* xio = a.out;
    v2u* UL = (v2u*)(ws + WS_UL);
    LAS float* sc = (LAS float*)C.lds;
    LAS unsigned char* topidx = (LAS unsigned char*)(C.lds + PL_TOPIDX);
    const int w = C.wave;
    LAS unsigned char* candl = (LAS unsigned char*)(C.lds + PL_TOPIDX + 4096);
    if (C.tid < 52) candl[C.tid] = PEER_CAND[C.tid];
    __syncthreads();
    for (int grp = C.vcu; grp < M / 64; grp += C.G) {
#ifndef PROBE_ROUTE_REPS
#define PROBE_ROUTE_REPS 1
#endif
      bf16x8 kf0[2][8], kf1[2][8];
      { int tk_ = C.tid; asm volatile("" : "+v"(tk_)); const int lane0 = tk_ & 63, l15k = lane0 & 15, lgk = lane0 >> 4;
#pragma unroll
        for (int p = 0; p < 2; ++p) { const bf16* kb = skb + ((size_t)(w * 2 + p) * 128 + l15k) * 64 + 8 * lgk;
#pragma unroll
            for (int nt = 0; nt < 8; ++nt) { kf0[p][nt] = *(const bf16x8*)(kb + (size_t)nt * 16 * 64); kf1[p][nt] = *(const bf16x8*)(kb + (size_t)nt * 16 * 64 + 32); } } }
      for (int tl_ = 0; tl_ < 4 * PROBE_ROUTE_REPS; ++tl_) { const int tl = tl_ & 3;
        const int tok0 = grp * 64 + tl * 16;
        int tid_ = C.tid; asm volatile("" : "+v"(tid_));
        const int tid = tid_, lane = tid & 63, l15 = lane & 15, lg = lane >> 4;
#ifndef PROBE_RA
#define PROBE_RA 1
#define PROBE_RB 1
#define PROBE_RC 1
#endif
        for (int ra_ = 0; ra_ < PROBE_RA; ++ra_) {
            typedef float f32x4v __attribute__((ext_vector_type(4)));
#pragma unroll
            for (int p = 0; p < 2; ++p) {
                const bf16* qrow = qp + (size_t)(tok0 + l15) * 1024 + 128 * w + 64 * p + 8 * lg;
                const bf16x8 a0 = *(const bf16x8*)(qrow), a1 = *(const bf16x8*)(qrow + 32);
#pragma unroll
                for (int nt = 0; nt < 8; ++nt) {
                    const bf16x8 b0 = kf0[p][nt], b1 = kf1[p][nt];
                    f32x4v acc = {0.f, 0.f, 0.f, 0.f};
                    acc = __builtin_amdgcn_mfma_f32_16x16x32_bf16(a0, b0, acc, 0, 0, 0);
                    acc = __builtin_amdgcn_mfma_f32_16x16x32_bf16(a1, b1, acc, 0, 0, 0);
#pragma unroll
                    for (int r = 0; r < 4; ++r) sc[((w * 2 + p) * 16 + 4 * lg + r) * SC_LD + 16 * nt + l15] = acc[r];
                }
            }
        }
        LDS_WAIT(); asm volatile("" ::: "memory");
        for (int rb_ = 0; rb_ < PROBE_RB; ++rb_) { const int prob = lane >> 1, kh = lane & 1, P = w * 32 + prob;
            const LAS float* row = sc + P * SC_LD + 64 * kh;
            float L[16];
#pragma unroll
            for (int i = 0; i < 16; ++i) L[i] = -INFINITY;
            for (int k0 = 0; k0 < 64; k0 += 8) {
#pragma unroll
                for (int kk = 0; kk < 8; ++kk) { const int k = k0 + kk;
                    const float v = __uint_as_float((__float_as_uint(row[k]) & 0xffffff80u) | (unsigned)(127 - (64 * kh + k)));
#pragma unroll
                    for (int i = 15; i >= 1; --i) L[i] = __builtin_amdgcn_fmed3f(L[i - 1], v, L[i]);
                    L[0] = fmaxf(L[0], v); }
            }
            merge16<1>(L);
            if (kh == 0) { unsigned pk[4];
#pragma unroll
                for (int i = 0; i < 4; ++i) pk[i] = (127u - (__float_as_uint(L[4 * i]) & 127u)) | ((127u - (__float_as_uint(L[4 * i + 1]) & 127u)) << 8) | ((127u - (__float_as_uint(L[4 * i + 2]) & 127u)) << 16) | ((127u - (__float_as_uint(L[4 * i + 3]) & 127u)) << 24);
                *(LAS v4u*)(topidx + P * 16) = (v4u){pk[0], pk[1], pk[2], pk[3]}; }
        }
        LDS_WAIT(); asm volatile("" ::: "memory");
        for (int rc_ = 0; rc_ < PROBE_RC; ++rc_) {
            const int token = lane >> 2, sub = lane & 3, P1 = (w * 2) * 16 + token, P2 = P1 + 16;
            float L[16];
#pragma unroll
            for (int i = 0; i < 16; ++i) L[i] = -INFINITY;
#pragma unroll
            for (int n = 0; n < 13; ++n) { const unsigned code = candl[4 * n + sub]; const unsigned aa = (code >> 4) & 15u, bb = code & 15u;
                const unsigned k1 = topidx[P1 * 16 + aa], k2 = topidx[P2 * 16 + bb];
                const float sm = sc[P1 * SC_LD + k1] + sc[P2 * SC_LD + k2];
                const float v = code == 255u ? -INFINITY : __uint_as_float((__float_as_uint(sm) & 0xffffff00u) | (255u - code));
#pragma unroll
                for (int i = 15; i >= 1; --i) L[i] = __builtin_amdgcn_fmed3f(L[i - 1], v, L[i]);
                L[0] = fmaxf(L[0], v); }
            merge16<1>(L); merge16<2>(L);
            float ts[4]; unsigned myidx[4]; float mx = -INFINITY;
#pragma unroll
            for (int j = 0; j < 4; ++j) { const float lv = sub == 0 ? L[j] : sub == 1 ? L[4 + j] : sub == 2 ? L[8 + j] : L[12 + j];
                const unsigned code = 255u - (__float_as_uint(lv) & 255u), aa = code >> 4, bb = code & 15u;
                const unsigned k1 = topidx[P1 * 16 + aa], k2 = topidx[P2 * 16 + bb];
                ts[j] = sc[P1 * SC_LD + k1] + sc[P2 * SC_LD + k2]; myidx[j] = k1 * 128u + k2; mx = fmaxf(mx, ts[j]); }
            mx = fmaxf(mx, __shfl_xor(mx, 1)); mx = fmaxf(mx, __shfl_xor(mx, 2));
            float sum = 0.f;
#pragma unroll
            for (int j = 0; j < 4; ++j) { ts[j] = __expf(ts[j] - mx); sum += ts[j]; }
            sum += __shfl_xor(sum, 1); sum += __shfl_xor(sum, 2);
            const float inv = 1.0f / sum;
#pragma unroll
            for (int j = 0; j < 4; ++j) UL[(size_t)(tok0 + token) * 128 + w * 16 + 4 * sub + j] = (v2u){myidx[j], __float_as_uint(ts[j] * inv)};
        }
        LDS_WAIT(); asm volatile("" ::: "memory");
      }
      __syncthreads();
#define SW_LOAD(buf, T, sq_, i) do { const unsigned e_ = sq_[128 * g + (i)].x; const unsigned char* rp_ = (T) + (size_t)e_ * 1024 + 16 * li; \
            _Pragma("unroll") for (int c = 0; c < 4; ++c) buf[c] = *(const v4u*)(rp_ + 256 * c); } while (0)
      {
        int ln_ = C.tid; asm volatile("" : "+v"(ln_)); const int lane = ln_ & 63, g = lane >> 4, li = lane & 15;
        LAS v2u* seq0 = (LAS v2u*)(C.lds + PL_SEQ) + (w * 2 + 0) * 512;
        LAS v2u* seq1 = (LAS v2u*)(C.lds + PL_SEQ) + (w * 2 + 1) * 512;
        LAS unsigned* hist = (LAS unsigned*)(C.lds + PL_HIST) + w * 128;
        LAS int* al0 = (LAS int*)(C.lds + PL_AL) + (w * 2 + 0) * 512;
        LAS int* al1 = (LAS int*)(C.lds + PL_AL) + (w * 2 + 1) * 512;
        v4u xq[2][4]; float sxp[2];
#pragma unroll 1
        for (int pass = 0; pass < 2; ++pass) { v4u xqt[4]; float sxt;
          const int tokb = grp * 64 + 32 * pass + 4 * w, row = tokb + g;
          LAS v2u* seq = pass ? seq1 : seq0;
          hist[lane] = 0u; hist[64 + lane] = 0u;
          const float* xr = xio + (size_t)row * 1024 + 16 * li;
          { float rn; { const f32x4 ra = *(const f32x4*)(rsp + (size_t)row * 16), rb = *(const f32x4*)(rsp + (size_t)row * 16 + 4), rc = *(const f32x4*)(rsp + (size_t)row * 16 + 8), rd = *(const f32x4*)(rsp + (size_t)row * 16 + 12);
                const float ss = ((ra[0] + ra[1]) + (ra[2] + ra[3])) + ((rb[0] + rb[1]) + (rb[2] + rb[3])) + ((rc[0] + rc[1]) + (rc[2] + rc[3])) + ((rd[0] + rd[1]) + (rd[2] + rd[3]));
                rn = 1.0f / sqrtf(ss * (1.0f / 1024.0f) + RMS_EPS); }
            f32x4 n[4][4]; float mx = 0.f;
#pragma unroll
            for (int c = 0; c < 4; ++c)
#pragma unroll
                for (int j = 0; j < 4; ++j) { n[c][j] = *(const f32x4*)(xr + 256 * c + 4 * j) * rn * *(const f32x4*)(gffn + 256 * c + 16 * li + 4 * j);
                    mx = fmaxf(mx, fmaxf(fmaxf(fabsf(n[c][j].x), fabsf(n[c][j].y)), fmaxf(fabsf(n[c][j].z), fabsf(n[c][j].w)))); }
            mx = fmaxf(mx, __shfl_xor(mx, 8)); mx = fmaxf(mx, __shfl_xor(mx, 4)); mx = fmaxf(mx, __shfl_xor(mx, 2)); mx = fmaxf(mx, __shfl_xor(mx, 1));
            const float sx = mx > 0.f ? mx * (1.0f / 127.0f) : 1.0f, inv = 1.0f / sx; sxt = sx;
#pragma unroll
            for (int c = 0; c < 4; ++c)
#pragma unroll
                for (int j = 0; j < 4; ++j) { const int q0 = (int)rintf(n[c][j].x * inv), q1 = (int)rintf(n[c][j].y * inv), q2 = (int)rintf(n[c][j].z * inv), q3 = (int)rintf(n[c][j].w * inv);
                    xqt[c][j] = (unsigned)(q0 & 255) | ((unsigned)(q1 & 255) << 8) | ((unsigned)(q2 & 255) << 16) | ((unsigned)(q3 & 255) << 24); } }
          if (pass == 0) { sxp[0] = sxt;
#pragma unroll
              for (int c = 0; c < 4; ++c) xq[0][c] = xqt[c]; }
          else { sxp[1] = sxt;
#pragma unroll
              for (int c = 0; c < 4; ++c) xq[1][c] = xqt[c]; }
          { unsigned pe[8], pgb[8], prank[8];
            LDS_WAIT();
#pragma unroll
            for (int s8 = 0; s8 < 8; ++s8) { const v2u u = UL[(size_t)(tokb + (s8 >> 1)) * 128 + 64 * (s8 & 1) + lane]; pe[s8] = u.x; pgb[s8] = u.y;
                prank[s8] = __hip_atomic_fetch_add(hist + 32 * (s8 >> 1) + ((u.x >> 9) & 31u), 1u, __ATOMIC_RELAXED, __HIP_MEMORY_SCOPE_WAVEFRONT); }
            LDS_WAIT();
            unsigned c0 = hist[lane], c1 = hist[64 + lane], i0 = c0, i1 = c1;
#pragma unroll
            for (int o = 1; o < 32; o <<= 1) { const unsigned y0 = __shfl_up(i0, o), y1 = __shfl_up(i1, o); if ((lane & 31) >= o) { i0 += y0; i1 += y1; } }
            LDS_WAIT();
            hist[lane] = i0 - c0; hist[64 + lane] = i1 - c1;
            LDS_WAIT();
#pragma unroll
            for (int s8 = 0; s8 < 8; ++s8) seq[128 * (s8 >> 1) + hist[32 * (s8 >> 1) + ((pe[s8] >> 9) & 31u)] + prank[s8]] = (v2u){pe[s8], pgb[s8]};
            LDS_WAIT(); }
        }
#define SW_DOWN(buf, xqp, alp, i) do { int sacc = 0; _Pragma("unroll") for (int c = 0; c < 4; ++c) { sacc = __builtin_amdgcn_sdot4((int)buf[c].x, (int)xqp[c].x, sacc, false); sacc = __builtin_amdgcn_sdot4((int)buf[c].y, (int)xqp[c].y, sacc, false); \
                sacc = __builtin_amdgcn_sdot4((int)buf[c].z, (int)xqp[c].z, sacc, false); sacc = __builtin_amdgcn_sdot4((int)buf[c].w, (int)xqp[c].w, sacc, false); } \
            sacc += __shfl_xor(sacc, 8); sacc += __shfl_xor(sacc, 4); sacc += __shfl_xor(sacc, 2); sacc += __shfl_xor(sacc, 1); \
            if (li == 0) alp[128 * g + (i)] = sacc; } while (0)
        {
#define DLD(buf, k, par) do { if ((k) < 256) { if (par) SW_LOAD(buf, Dt, seq1, (k) >> 1); else SW_LOAD(buf, Dt, seq0, (k) >> 1); } } while (0)
#define DCP(buf, k, par) do { if ((k) < 256) { if (par) SW_DOWN(buf, xq[1], al1, (k) >> 1); else SW_DOWN(buf, xq[0], al0, (k) >> 1); } } while (0)
v4u b0[4], b1[4], b2[4], b3[4], b4[4];
          DLD(b0, 0, 0); DLD(b1, 1, 1); DLD(b2, 2, 0); DLD(b3, 3, 1);
#pragma unroll 1
          for (int kb = 0; kb < 256; kb += 10) {
              DLD(b4, kb + 4, 0); DCP(b0, kb + 0, 0);
              DLD(b0, kb + 5, 1); DCP(b1, kb + 1, 1);
              DLD(b1, kb + 6, 0); DCP(b2, kb + 2, 0);
              DLD(b2, kb + 7, 1); DCP(b3, kb + 3, 1);
              DLD(b3, kb + 8, 0); DCP(b4, kb + 4, 0);
              DLD(b4, kb + 9, 1); DCP(b0, kb + 5, 1);
              DLD(b0, kb + 10, 0); DCP(b1, kb + 6, 0);
              DLD(b1, kb + 11, 1); DCP(b2, kb + 7, 1);
              DLD(b2, kb + 12, 0); DCP(b3, kb + 8, 0);
              DLD(b3, kb + 13, 1); DCP(b4, kb + 9, 1);
          }
#undef DLD
#undef DCP
        }
#undef SW_DOWN
        LDS_WAIT();
        float tsinv[2];
#pragma unroll
        for (int pass = 0; pass < 2; ++pass) { LAS int* al = pass ? al1 : al0; LAS float* cl = (LAS float*)al; LAS v2u* seq = pass ? seq1 : seq0; const float sx = sxp[pass];
          const float sx0 = __uint_as_float(__builtin_amdgcn_readlane(__float_as_uint(sx), 0)), sx1 = __uint_as_float(__builtin_amdgcn_readlane(__float_as_uint(sx), 16)),
                      sx2 = __uint_as_float(__builtin_amdgcn_readlane(__float_as_uint(sx), 32)), sx3 = __uint_as_float(__builtin_amdgcn_readlane(__float_as_uint(sx), 48));
          float cv[8];
#pragma unroll
          for (int s8 = 0; s8 < 8; ++s8) { const int idx = 64 * s8 + lane; const v2u ent = seq[idx]; const unsigned ee = ent.x;
              const float sd = tsc[ee], su = tsc[NEXP + ee]; const float sxl = (s8 >> 1) == 0 ? sx0 : (s8 >> 1) == 1 ? sx1 : (s8 >> 1) == 2 ? sx2 : sx3;
              const float av = (float)al[idx]; cv[s8] = __uint_as_float(ent.y) * su * gelu_erf(av * (sd * sxl)); }
          float tsl = 1.f;
#pragma unroll
          for (int t4 = 0; t4 < 4; ++t4) { const float m = wave_max(fmaxf(fabsf(cv[2 * t4]), fabsf(cv[2 * t4 + 1])));
              const float sc = m > 0.f ? exp2f(-ceilf(log2f(m))) : 1.f;
              cl[128 * t4 + lane] = cv[2 * t4] * sc; cl[128 * t4 + 64 + lane] = cv[2 * t4 + 1] * sc; if (g == t4) tsl = sc; }
          tsinv[pass] = 1.0f / tsl; }
        LDS_WAIT();
        { const LAS float* cl0 = (const LAS float*)al0; const LAS float* cl1 = (const LAS float*)al1;
          typedef _Float16 h2 __attribute__((ext_vector_type(2)));
          h2 acc0[2][16], acc1[2][16];
#pragma unroll
          for (int c = 0; c < 2; ++c)
#pragma unroll
              for (int i = 0; i < 16; ++i) { acc0[c][i] = (h2){(_Float16)0.f, (_Float16)0.f}; acc1[c][i] = (h2){(_Float16)0.f, (_Float16)0.f}; }
#define SW_LOADU(buf, sq_, i) do { const unsigned e_ = sq_[128 * g + (i)].x; const unsigned char* rp_ = Ut + (size_t)e_ * 768; \
            buf[0].a4 = *(const v4u*)(rp_ + 16 * li); buf[0].b4 = *(const v4u*)(rp_ + 256 + 16 * li); buf[0].a2 = *(const v2u*)(rp_ + 512 + 8 * li); buf[0].b2 = *(const v2u*)(rp_ + 640 + 8 * li); } while (0)
#define SW_UP(buf, accp, clp, i) do { const _Float16 ch_ = (_Float16)clp[128 * g + (i)]; const h2 cc_ = {ch_, ch_}; \
            _Pragma("unroll") for (int c = 0; c < 2; ++c) { const v6u s6_ = c ? (v6u){buf[0].b4.x, buf[0].b4.y, buf[0].b4.z, buf[0].b4.w, buf[0].b2.x, buf[0].b2.y} : (v6u){buf[0].a4.x, buf[0].a4.y, buf[0].a4.z, buf[0].a4.w, buf[0].a2.x, buf[0].a2.y}; \
                const h32 r_ = __builtin_amdgcn_cvt_scalef32_pk32_f16_fp6(s6_, 1.0f); \
                _Pragma("unroll") for (int q = 0; q < 16; ++q) { const h2 t_ = {r_[2 * q], r_[2 * q + 1]}; accp[c][q] = t_ * cc_ + accp[c][q]; } \
                asm volatile("" : "+v"(accp[c][0]), "+v"(accp[c][1]), "+v"(accp[c][2]), "+v"(accp[c][3]), "+v"(accp[c][4]), "+v"(accp[c][5]), "+v"(accp[c][6]), "+v"(accp[c][7]), \
                                  "+v"(accp[c][8]), "+v"(accp[c][9]), "+v"(accp[c][10]), "+v"(accp[c][11]), "+v"(accp[c][12]), "+v"(accp[c][13]), "+v"(accp[c][14]), "+v"(accp[c][15])); } } while (0)
          {
#define ULD(buf, k, par) do { if ((k) < 256) { if (par) SW_LOADU(buf, seq1, (k) >> 1); else SW_LOADU(buf, seq0, (k) >> 1); } } while (0)
#define UCP(buf, k, par) do { if ((k) < 256) { if (par) SW_UP(buf, acc1, cl1, (k) >> 1); else SW_UP(buf, acc0, cl0, (k) >> 1); } } while (0)
UB b0[4], b1[4], b2[4], b3[4], b4[4], b5[4], b6[4], b7[4];
          ULD(b0, 0, 0); ULD(b1, 1, 1); ULD(b2, 2, 0); ULD(b3, 3, 1); ULD(b4, 4, 0); ULD(b5, 5, 1); ULD(b6, 6, 0);
#pragma unroll 1
          for (int kb = 0; kb < 256; kb += 8) {
              ULD(b7, kb + 7, 1); UCP(b0, kb + 0, 0);
              ULD(b0, kb + 8, 0); UCP(b1, kb + 1, 1);
              ULD(b1, kb + 9, 1); UCP(b2, kb + 2, 0);
              ULD(b2, kb + 10, 0); UCP(b3, kb + 3, 1);
              ULD(b3, kb + 11, 1); UCP(b4, kb + 4, 0);
              ULD(b4, kb + 12, 0); UCP(b5, kb + 5, 1);
              ULD(b5, kb + 13, 1); UCP(b6, kb + 6, 0);
              ULD(b6, kb + 14, 0); UCP(b7, kb + 7, 1);
          }
#undef ULD
#undef UCP
          }
#undef SW_UP
#undef SW_LOADU
#define SW_OUT(accp, pass) do { const int row = grp * 64 + 32 * (pass) + 4 * w + g; float* xr = xio + (size_t)row * 1024 + 4 * li; float ss = 0.f; const float ti_ = tsinv[pass]; \
            _Pragma("unroll") for (int c = 0; c < 2; ++c) { \
                _Pragma("unroll") for (int q = 0; q < 8; ++q) { float* xp_ = xr + 512 * c + 64 * q; \
                    const f32x4 y = *(const f32x4*)xp_ + (f32x4){(float)accp[c][2 * q].x, (float)accp[c][2 * q].y, (float)accp[c][2 * q + 1].x, (float)accp[c][2 * q + 1].y} * ti_; *(f32x4*)xp_ = y; \
                    ss += (y.x * y.x + y.y * y.y) + (y.z * y.z + y.w * y.w); \
                    if (!LAST) { bf16* xb = (bf16*)(ws + WS_XB) + (size_t)row * 1024 + 512 * c + 64 * q + 4 * li; *(v2u*)xb = (v2u){pk2(y.x, y.y), pk2(y.z, y.w)}; } } } \
            if (!LAST) { ss += __shfl_xor(ss, 8); ss += __shfl_xor(ss, 4); ss += __shfl_xor(ss, 2); ss += __shfl_xor(ss, 1); \
                if (li == 0) ((float*)(ws + WS_RA1))[row] = 1.0f / sqrtf(ss * (1.0f / 1024.0f) + RMS_EPS); } } while (0)
          SW_OUT(acc0, 0); SW_OUT(acc1, 1);
#undef SW_OUT
        }
      }
#undef SW_LOAD
      __syncthreads();
    }
}

constexpr int CW_GRP = 8192, CW_XID = 16384;
struct GroupOrder {
    int nN, c, G4, nM;
    __device__ bool next(int i, pg8::Unit& u) const {
        const bool five = nN == 5 && (c & 3) == 0; const int j = five ? (i >> 1) : i, pm = (c >> 2) + j * G4; if (pm >= nM) return false;
        u.pm = pm; u.pn = (five && (i & 1)) ? 4 : (c & 3); return true; }
    __device__ __forceinline__ void a_ready(const pg8::Unit&) const {}
    __device__ __forceinline__ void done(const pg8::Unit&) const {}
};
__device__ __forceinline__ void sub_barrier(gu32* ctl, int cword, unsigned target, volatile LAS unsigned* same_xcd) {
    asm volatile("s_waitcnt vmcnt(0)" ::: "memory");
    __syncthreads();
    if (threadIdx.x == 0) {
        unsigned* cnt = (unsigned*)ctl + cword; unsigned* bar = (unsigned*)ctl + CW_BAR;
        if (same_xcd[0] != 1u) { __builtin_amdgcn_fence(__ATOMIC_RELEASE, "agent"); asm volatile("s_waitcnt vmcnt(0)" ::: "memory"); }
        (void)xb_add(cnt, 1u);
        XB_SPIN(xb_ld(cnt) < target, bar);
        __builtin_amdgcn_fence(__ATOMIC_ACQUIRE, "agent");
        asm volatile("s_waitcnt vmcnt(0)" ::: "memory");
    }
    __syncthreads();
}

__device__ __forceinline__ void grp_barrier(gu32* ctl, int vcu, unsigned target, volatile LAS unsigned* same_xcd) { sub_barrier(ctl, CW_GRP + 64 * (vcu >> 2), target, same_xcd); }
constexpr int CW_GRP16 = 12288;
struct PairOrder { int c; __device__ bool next(int i, pg8::Unit& u) const { if (i) return false; u.pm = c >> 1; u.pn = c & 1; return true; }
    __device__ __forceinline__ void a_ready(const pg8::Unit&) const {} __device__ __forceinline__ void done(const pg8::Unit&) const {} };

__global__ void __launch_bounds__(NWAVES * 64, 2) mk_fwd(Args args) {
    extern __shared__ __attribute__((aligned(16))) unsigned char lds[];
    Ctx C; C.lds = lds; C.tid = threadIdx.x; C.lane = C.tid & 63; C.wave = __builtin_amdgcn_readfirstlane(C.tid >> 6);
    C.G = gridDim.x; { const int bx = blockIdx.x; C.vcu = (C.G % 8 == 0) ? (bx % 8) * (C.G / 8) + bx / 8 : bx; }
    LAS unsigned char* lds3 = (LAS unsigned char*)lds;
    volatile LAS unsigned* MISC = (volatile LAS unsigned*)(lds3 + MISC_OFF);
    for (int u = C.tid; u < (LDS_BYTES - LDSCTL_OFF) / 4; u += NWAVES * 64) ((LAS unsigned*)(lds3 + LDSCTL_OFF))[u] = 0u;
    __syncthreads();
    unsigned char* ws = args.ws;
    gu32* ctl = (gu32*)(ws + WS_CTL);
    XcdBarrier bar; bar.bar = (unsigned*)(ctl + CW_BAR); bar.x = 0; bar.st = nullptr;
    if (N_LAUNCHES == 1) bar = xcd_barrier_post((unsigned*)(ctl + CW_BAR), MISC + 8);
    const bool merged23 = false && (N_LAUNCHES == 1) && C.G == 256;
    const bool grouped = (N_LAUNCHES == 1);
    if (grouped && C.tid == 0) __hip_atomic_store((unsigned*)ctl + CW_XID + C.vcu, xb_xcc_id() + 1u, RLX_AGENT);
    const int lo = args.ph_lo, hi = args.ph_hi;
#ifdef ONLY_PHASE
#define IN(k) ((k) == ONLY_PHASE && lo <= (k) && (k) < hi)
#else
#define IN(k) (lo <= (k) && (k) < hi)
#endif
#ifndef PROBE_XBAR
#define PROBE_XBAR 0
#endif
#define SEAM(k) do { if (IN(k) && IN((k) + 1)) { xcd_barrier(bar); if ((k) == 6) for (int xb_ = 0; xb_ < PROBE_XBAR; ++xb_) xcd_barrier(bar); } } while (0)
#define GSEAM(k, n) do { if (IN(k) && IN((k) + 1)) { if (grouped) grp_barrier(ctl, C.vcu, 4u * (n), MISC + 10); else xcd_barrier(bar); } } while (0)
#ifndef PROBE_MASK
#define PROBE_MASK 0
#endif
#define REPS(k) ((((PROBE_MASK) >> (k)) & 1) ? 2 : 1)
    bf16* xb = (bf16*)(ws + WS_XB);
    if (IN(0)) { for (int rep = 0; rep < REPS(0); ++rep) { p0_prologue(args, C); __syncthreads(); } SEAM(0); }
    if (grouped) { if (C.tid == 0) { const unsigned* xi = (const unsigned*)ctl + CW_XID + (C.vcu & ~3); const unsigned a0 = xb_ld((unsigned*)xi), a1 = xb_ld((unsigned*)xi + 1), a2 = xb_ld((unsigned*)xi + 2), a3 = xb_ld((unsigned*)xi + 3);
          MISC[10] = (a0 != 0u && a0 == a1 && a0 == a2 && a0 == a3) ? 1u : 2u;
          const unsigned* xj = (const unsigned*)ctl + CW_XID + (C.vcu & ~15); bool same16 = a0 != 0u;
          for (int i = 0; i < 16; ++i) same16 = same16 && (xb_ld((unsigned*)xj + i) == a0);
          MISC[11] = same16 ? 1u : 2u; }
        __syncthreads(); }
    if (IN(1)) for (int rep = 0; rep < REPS(1); ++rep) {
        pg8::Gemm g{xb, (const bf16*)(ws + WS_WIN0), M, EV_N - 512, DMODEL}; pg8::StaticOrder S; S.init(M, EV_N - 512, C.G, (int)blockIdx.x);
        pg8::EpiProj<0> E{(const float*)(ws + WS_RA0), (const float*)(ws + WS_ROPE), (bf16*)(ws + WS_QKV), nullptr, nullptr, (const float*)(ws + WS_GAIN), (float*)(ws + WS_KSUM), 0};
        pg8::gemm_phase<pg8::EpiProj<0>, pg8::StaticOrder, true, true>(lds3, g, S, E);
        if (rep + 1 == REPS(1)) SEAM(1); }
    if (IN(2)) {
        const int nr = C.G / 2;
        if (C.vcu < nr) { p2_route(args, C, C.vcu, nr);
            if (merged23) { sub_barrier(ctl, CW_GRP16 + 64 * (C.vcu >> 4), 16u, MISC + 11); const int hh = C.vcu >> 4;
                for (int idx = C.vcu & 15; idx < 62; idx += 16) p3_lists_item(args, C, hh + 8 * (idx / 31), idx % 31); } }
        else { pg8::Gemm g{xb, (const bf16*)(ws + WS_WIN0) + (size_t)(EV_N - 512) * DMODEL, M, 512, DMODEL}; PairOrder S{C.vcu - nr};
            pg8::EpiProj<0> E{(const float*)(ws + WS_RA0), (const float*)(ws + WS_ROPE), (bf16*)(ws + WS_QKV), nullptr, nullptr, (const float*)(ws + WS_GAIN), (float*)(ws + WS_KSUM), 12};
            pg8::gemm_phase<pg8::EpiProj<0>, PairOrder, true, true>(lds3, g, S, E); }
        SEAM(2); }
    if (IN(3) && !merged23) { for (int rep = 0; rep < REPS(3); ++rep) p3_lists(args, C); SEAM(3); }
    if (IN(4)) { for (int rep = 0; rep < REPS(4); ++rep) p4_attn_l0a(args, C); SEAM(4); }
    if (IN(5)) { for (int rep = 0; rep < REPS(5); ++rep) p5_attn_l0b(args, C); GSEAM(5, 1); }
    if (IN(6)) {
        pg8::Gemm g{(const bf16*)(ws + WS_AO), (const bf16*)(ws + WS_WOUT0), M, DMODEL, DMODEL};
        pg8::EpiResid E{args.in[0], args.out, xb, (float*)(ws + WS_RSP)};
        { GroupOrder S{4, C.vcu, C.G >> 2, M / 256}; pg8::gemm_phase<pg8::EpiResid, GroupOrder, true, true>(lds3, g, S, E); }
        GSEAM(6, 2); }
    if (IN(7)) for (int rep = 0; rep < REPS(7); ++rep) {
        pg8::Gemm g{xb, (const bf16*)(ws + WS_WQ0), M, DMODEL, DMODEL};
        pg8::EpiPeerQ E{(const float*)(ws + WS_RSP), (bf16*)(ws + WS_QP)};
        { GroupOrder S{4, C.vcu, C.G >> 2, M / 256}; pg8::gemm_phase<pg8::EpiPeerQ, GroupOrder, true, true>(lds3, g, S, E); }
        if (rep + 1 == REPS(7)) GSEAM(7, 3); }
    if (IN(8)) { peer_phase<false>(args, C, 0); GSEAM(8, 4); }
    if (IN(9)) for (int rep = 0; rep < REPS(9); ++rep) {
        pg8::Gemm g{xb, (const bf16*)(ws + WS_WIN1), M, OD_N, DMODEL};
        pg8::EpiProj<1> E{(const float*)(ws + WS_RA1), (const float*)(ws + WS_ROPE), (bf16*)(ws + WS_QKV), (bf16*)(ws + WS_QKV + 32 * MiB), (bf16*)(ws + WS_QKV + 36 * MiB), (const float*)(ws + WS_GAIN) + 256, nullptr, 0};
        { GroupOrder S{5, C.vcu, C.G >> 2, M / 256}; pg8::gemm_phase<pg8::EpiProj<1>, GroupOrder, true, true>(lds3, g, S, E); }
        if (CONV_L1_LATE == 2 && rep == 0) conv_pull(args, C, 1);
        if (rep + 1 == REPS(9)) SEAM(9); }
    if (IN(10)) { for (int rep = 0; rep < REPS(10); ++rep) p8_attn_l1(args, C); GSEAM(10, 5); }
    if (IN(11)) {
        pg8::Gemm g{(const bf16*)(ws + WS_AO), (const bf16*)(ws + WS_WOUT1), M, DMODEL, DMODEL};
        pg8::EpiResid E{args.out, args.out, xb, (float*)(ws + WS_RSP)};
        { GroupOrder S{4, C.vcu, C.G >> 2, M / 256}; pg8::gemm_phase<pg8::EpiResid, GroupOrder, true, true>(lds3, g, S, E); }
        GSEAM(11, 6); }
    if (IN(12)) for (int rep = 0; rep < REPS(12); ++rep) {
        pg8::Gemm g{xb, (const bf16*)(ws + WS_WQ1), M, DMODEL, DMODEL};
        pg8::EpiPeerQ E{(const float*)(ws + WS_RSP), (bf16*)(ws + WS_QP)};
        { GroupOrder S{4, C.vcu, C.G >> 2, M / 256}; pg8::gemm_phase<pg8::EpiPeerQ, GroupOrder, true, true>(lds3, g, S, E); }
        if (rep + 1 == REPS(12)) GSEAM(12, 7); }
    if (IN(13)) { peer_phase<true>(args, C, 1); }
#undef IN
#undef SEAM
}

extern "C" void kernel_launch(void* const* d_in, const int* in_sizes, int n_in, void* d_out, int out_size, void* d_ws, size_t ws_size, hipStream_t stream) {
    static int grid = 0;
    if (grid == 0) {
        if (n_in != 19 || in_sizes[0] != M * DMODEL || out_size != M * DMODEL || ws_size < WS_END) { fprintf(stderr, "kernel_launch: unexpected shapes (n_in %d, in0 %d, out %d, ws %zu); nothing launched\n", n_in, n_in > 0 ? in_sizes[0] : -1, out_size, ws_size); grid = -1; return; }
        int dev = 0, cus = 0, per_cu = 0;
        if (hipGetDevice(&dev) != hipSuccess || hipDeviceGetAttribute(&cus, hipDeviceAttributeMultiprocessorCount, dev) != hipSuccess) { grid = -1; return; }
        if (hipFuncSetAttribute((const void*)mk_fwd, hipFuncAttributeMaxDynamicSharedMemorySize, LDS_BYTES) != hipSuccess) { fprintf(stderr, "kernel_launch: hipFuncSetAttribute failed\n"); grid = -1; return; }
        if (hipOccupancyMaxActiveBlocksPerMultiprocessor(&per_cu, (const void*)mk_fwd, NWAVES * 64, LDS_BYTES) != hipSuccess || per_cu < 1) { fprintf(stderr, "kernel_launch: occupancy query reports %d workgroups per CU\n", per_cu); }
        (void)hipGetLastError();
        grid = cus > 256 ? 256 : (cus / 8) * 8;
        if (grid != 256) fprintf(stderr, "kernel_launch: %d CUs; the phase schedules assume 256\n", grid);
    }
    if (grid < 0) return;
    if (hipMemsetAsync((char*)d_ws + WS_CTL, 0, CTL_ZERO_BYTES, stream) != hipSuccess) { fprintf(stderr, "kernel_launch: hipMemsetAsync failed\n"); return; }
    Args a{};
    for (int i = 0; i < 19; ++i) a.in[i] = (const float*)d_in[i];
    a.out = (float*)d_out; a.ws = (unsigned char*)d_ws;
    for (int li = 0; li < N_LAUNCHES; ++li) {
        a.ph_lo = (N_LAUNCHES == 1) ? 0 : li; a.ph_hi = (N_LAUNCHES == 1) ? N_PHASES : li + 1; a.li = li;
        hipLaunchKernelGGL(mk_fwd, dim3(grid), dim3(NWAVES * 64), LDS_BYTES, stream, a);
        const hipError_t le = hipPeekAtLastError();
        if (le != hipSuccess) { fprintf(stderr, "kernel_launch: launch %d failed: %s\n", li, hipGetErrorName(le)); break; }
    }
}
```

```cpp
#define MK_N_LAUNCHES 1
#include <hip/hip_runtime.h>
#include <cstdio>
#include <cstdint>
namespace pg8 {
#define PG8_LAS __attribute__((address_space(3)))
typedef unsigned short bf16_t;
typedef short bf16x8 __attribute__((ext_vector_type(8)));
typedef float f32x4 __attribute__((ext_vector_type(4)));
typedef unsigned u32x4 __attribute__((ext_vector_type(4)));
constexpr int BM = 256, BK = 64, HALF = 128, HTB = HALF * BK * 2  , STAGE_BYTES = 8 * HTB, NXCD = 8, WGM = 8;

__host__ __device__ __forceinline__ int lds_byte(int r, int c) { const int st = (r >> 4) * 2 + (c >> 5), rr = r & 15, cc = c & 31, ob = rr * 64 + cc * 2; return st * 1024 + (ob ^ (((ob >> 9) & 1) << 5)); }
__host__ __device__ __forceinline__ void stage_rc(int b, int& R, int& C) { const int st = b / 1024, sb = b % 1024, swz = sb ^ (((sb >> 9) & 1) << 5); R = (st >> 1) * 16 + swz / 64; C = (st & 1) * 32 + (swz % 64) / 2; }
__host__ __device__ __forceinline__ int perm32(int rho) { const int n = rho >> 4, i = rho & 15; return 8 * (i >> 2) + 4 * n + (i & 3); }

struct Unit { int pm, pn; };
struct Gemm { const bf16_t* A; const bf16_t* Bt; int M, N, K; };

struct StaticOrder {
    int nM, nN, nwg, G, c;
    __host__ __device__ void init(int M, int N, int G_, int c_) { nM = M / BM; nN = N / BM; nwg = nM * nN; G = G_; c = c_; }
    __host__ __device__ bool next(int i, Unit& u) const {
        const long L = (long)i * G + c; if (L >= nwg) return false;
        int wgid = (int)L; { const int q = nwg / NXCD, r = nwg % NXCD, xcd = wgid % NXCD, off = wgid / NXCD; wgid = (xcd < r ? xcd * (q + 1) : r * (q + 1) + (xcd - r) * q) + off; }
        const int nig = WGM * nN, gid = wgid / nig, fm = gid * WGM, gsz = (nM - fm) < WGM ? (nM - fm) : WGM;
        u.pm = fm + ((wgid % nig) % gsz); u.pn = (wgid % nig) / gsz; return true;
    }
    __device__ __forceinline__ void a_ready(const Unit&) const {}
    __device__ __forceinline__ void done(const Unit&) const {}
};

__device__ __forceinline__ unsigned cvt_pk_bf16(float lo, float hi) { unsigned r; asm volatile("v_cvt_pk_bf16_f32 %0, %1, %2" : "=v"(r) : "v"(lo), "v"(hi)); return r; }
typedef float f32x2 __attribute__((ext_vector_type(2)));
__device__ __forceinline__ f32x2 gelu_pk(f32x2 v) {
    const f32x2 av = __builtin_elementwise_abs(v), d = av * 0.2316418882f + 1.0f;
    f32x2 t; t.x = __builtin_amdgcn_rcpf(d.x); t.y = __builtin_amdgcn_rcpf(d.y);
    f32x2 q = t * 0.5307027145f + (-0.7265760135f); q = q * t + 0.7107068705f; q = q * t + (-0.142248368f); q = q * t + 0.127414796f; q = q * t;
    const f32x2 s = (v * v) * (-0.72134752044f);
    f32x2 e; e.x = __builtin_amdgcn_exp2f(s.x); e.y = __builtin_amdgcn_exp2f(s.y);
    const f32x2 m = v * (q * e), r = v - m;
    f32x2 o; o.x = v.x < 0.f ? m.x : r.x; o.y = v.y < 0.f ? m.y : r.y; return o;
}

template <int ACT  > struct EpiBf16 {
    static constexpr bool PERM = true, AFTER_DRAIN = false; static_assert(ACT == 0 || ACT == 1, "EpiBf16: ACT is 0 (none) or 1 (gelu_pk)");
    bf16_t* O; int ldc; const float* bias; int split_cols; size_t split_stride; float scale0;
    __device__ __forceinline__ void operator()(const f32x4 (&acc)[2][2][4][2], const Unit& u, int wr, int wc, int fr, int fq) const {
        const int row0 = u.pm * BM + wr * 64 + fr; int colt = u.pn * BM; bf16_t* base = O;
        float sc = 1.f; if (split_cols) { const int t = colt / split_cols; base += (size_t)t * split_stride; colt -= t * split_cols; if (t == 0) sc = scale0; }
        const int col0 = colt + wc * 32 + 8 * fq, bcol0 = u.pn * BM + wc * 32 + 8 * fq;
        f32x4 bv[2][2];
#pragma unroll
        for (int bj = 0; bj < 2; ++bj)
#pragma unroll
            for (int n = 0; n < 2; ++n) bv[bj][n] = bias ? *(const f32x4*)(bias + bcol0 + bj * HALF + 4 * n) : (f32x4){0.f, 0.f, 0.f, 0.f};
#pragma unroll
        for (int ai = 0; ai < 2; ++ai)
#pragma unroll
            for (int m = 0; m < 4; ++m) { bf16_t* rowp = base + (size_t)(row0 + ai * HALF + m * 16) * ldc + col0;
#pragma unroll
                for (int bj = 0; bj < 2; ++bj) { f32x4 v0 = acc[ai][bj][m][0] + bv[bj][0], v1 = acc[ai][bj][m][1] + bv[bj][1];
                    if (ACT == 1) { f32x2 a = gelu_pk((f32x2){v0[0], v0[1]}), b = gelu_pk((f32x2){v0[2], v0[3]}), c = gelu_pk((f32x2){v1[0], v1[1]}), d = gelu_pk((f32x2){v1[2], v1[3]});
                        v0 = (f32x4){a.x, a.y, b.x, b.y}; v1 = (f32x4){c.x, c.y, d.x, d.y}; }
                    v0 = v0 * sc; v1 = v1 * sc; u32x4 w; w.x = cvt_pk_bf16(v0[0], v0[1]); w.y = cvt_pk_bf16(v0[2], v0[3]); w.z = cvt_pk_bf16(v1[0], v1[1]); w.w = cvt_pk_bf16(v1[2], v1[3]);
                    *(u32x4*)(rowp + bj * HALF) = w; } }
    }
};

template <class Epi, class Sched, bool ALIGN_EPI = false, bool SP2 = false>
__device__ __forceinline__ void gemm_phase(PG8_LAS unsigned char* lds, const Gemm g, const Sched& S, const Epi& E) {
    const int tid = threadIdx.x, wid = __builtin_amdgcn_readfirstlane(tid >> 6), lane = tid & 63, wr = wid >> 2, wc = wid & 3, fr = lane & 15, fq = lane >> 4;
    const int K = g.K, nt = K / BK;
    unsigned voffA[2], voffB[2];
#pragma unroll
    for (int i = 0; i < 2; ++i) { int R, C; stage_rc(tid * 16 + i * 8192, R, C); const int Rb = Epi::PERM ? ((R & ~31) + perm32(R & 31)) : R;
        voffA[i] = (unsigned)(R * K + C) * 2u; voffB[i] = (unsigned)(Rb * K + C) * 2u; }
    const size_t kstep = (size_t)(BK * 2);
    const size_t hstep = (size_t)HALF * K * 2;
    const size_t tstep = 2 * hstep;
    const unsigned ldsw = (unsigned)wid * 1024u;
    const int aoff = lds_byte(wr * 64 + fr, fq * 8), boff = lds_byte(wc * 32 + fr, fq * 8);
#define PG8_SA(b, h) (((b) * 2 + (h)) * HTB)
#define PG8_SB(b, h) ((4 + (b) * 2 + (h)) * HTB)
#define PG8_STAGE(bufoff, gbase, voff) do { _Pragma("unroll") for (int _i = 0; _i < 2; ++_i) \
        __builtin_amdgcn_global_load_lds((const unsigned*)((const char*)(gbase) + (voff)[_i]), (PG8_LAS unsigned*)(lds + (bufoff) + ldsw + _i * 8192), 16, 0, 0); } while (0)
#define PG8_LDA(dst, b, h) do { _Pragma("unroll") for (int m = 0; m < 4; ++m) _Pragma("unroll") for (int k = 0; k < 2; ++k) dst[m][k] = *(const PG8_LAS bf16x8*)(lds + PG8_SA(b, h) + aoff + m * 2048 + k * 1024); } while (0)
#define PG8_LDB(dst, b, h) do { _Pragma("unroll") for (int n = 0; n < 2; ++n) _Pragma("unroll") for (int k = 0; k < 2; ++k) dst[n][k] = *(const PG8_LAS bf16x8*)(lds + PG8_SB(b, h) + boff + n * 2048 + k * 1024); } while (0)
#define PG8_MMA(ai, bj, At, Bt) do { __builtin_amdgcn_s_setprio(1); _Pragma("unroll") for (int m = 0; m < 4; ++m) _Pragma("unroll") for (int n = 0; n < 2; ++n) _Pragma("unroll") for (int k = 0; k < 2; ++k) \
        acc[ai][bj][m][n] = __builtin_amdgcn_mfma_f32_16x16x32_bf16(Bt[n][k], At[m][k], acc[ai][bj][m][n], 0, 0, 0); __builtin_amdgcn_s_setprio(0); } while (0)
#define PG8_WAIT_V(n) asm volatile("s_waitcnt vmcnt(" #n ")" ::: "memory")
#define PG8_WAIT_L(n) asm volatile("s_waitcnt lgkmcnt(" #n ")" ::: "memory")
#define PG8_BAR __builtin_amdgcn_s_barrier()
#define PG8_SCHED __builtin_amdgcn_sched_barrier(0)
    Unit cur, nxt; int ui = 0;
    if (!S.next(0, cur)) return;
    f32x4 acc[2][2][4][2];
#pragma unroll
    for (int a = 0; a < 2; ++a)
#pragma unroll
        for (int b = 0; b < 2; ++b)
#pragma unroll
            for (int m = 0; m < 4; ++m)
#pragma unroll
                for (int n = 0; n < 2; ++n) acc[a][b][m][n] = (f32x4){0.f, 0.f, 0.f, 0.f};
    bf16x8 At[4][2], B0[2][2], B1[2][2];
    const char* cA = (const char*)g.A + (size_t)cur.pm * tstep; const char* cB = (const char*)g.Bt + (size_t)cur.pn * tstep;
    S.a_ready(cur);
    if constexpr (SP2) {
        PG8_STAGE(PG8_SB(0, 0), cB, voffB); PG8_STAGE(PG8_SB(0, 1), cB + hstep, voffB); PG8_STAGE(PG8_SA(0, 0), cA, voffA); PG8_STAGE(PG8_SA(0, 1), cA + hstep, voffA);
        if (wr == 1) PG8_BAR;
        PG8_WAIT_V(2); PG8_BAR;
        PG8_STAGE(PG8_SB(1, 0), cB + kstep, voffB); PG8_STAGE(PG8_SA(1, 0), cA + kstep, voffA); PG8_STAGE(PG8_SB(1, 1), cB + hstep + kstep, voffB);
        PG8_WAIT_V(6); PG8_BAR;
    } else {
        PG8_STAGE(PG8_SB(0, 0), cB, voffB); PG8_STAGE(PG8_SA(0, 0), cA, voffA); PG8_STAGE(PG8_SB(0, 1), cB + hstep, voffB); PG8_STAGE(PG8_SA(0, 1), cA + hstep, voffA);
        if (wr == 1) PG8_BAR;
        PG8_WAIT_V(4); PG8_BAR;
        PG8_STAGE(PG8_SB(1, 0), cB + kstep, voffB); PG8_STAGE(PG8_SA(1, 0), cA + kstep, voffA); PG8_STAGE(PG8_SB(1, 1), cB + hstep + kstep, voffB);
        PG8_WAIT_V(6); PG8_BAR;
    }
    for (;;) {
        const bool has_next = S.next(ui + 1, nxt);
        const char* nA = has_next ? (const char*)g.A + (size_t)nxt.pm * tstep : cA; const char* nB = has_next ? (const char*)g.Bt + (size_t)nxt.pn * tstep : cB;
        for (int t = 0; t < nt; t += 2) {
            const bool last = (t == nt - 2);
            const char* a1 = cA + (size_t)(t + 1) * kstep;
            const char* a2 = last ? nA : cA + (size_t)(t + 2) * kstep; const char* b2 = last ? nB : cB + (size_t)(t + 2) * kstep;
            const char* a3 = a2 + kstep; const char* b3 = b2 + kstep;
            if (last && has_next) S.a_ready(nxt);
            if constexpr (SP2) {
            PG8_LDB(B0, 0, 0); PG8_LDB(B1, 0, 1); PG8_SCHED; PG8_LDA(At, 0, 0); PG8_STAGE(PG8_SA(1, 1), a1 + hstep, voffA);
            PG8_WAIT_V(8); PG8_WAIT_L(0); PG8_BAR; PG8_MMA(0, 0, At, B0); PG8_MMA(0, 1, At, B1); PG8_BAR; PG8_SCHED;
            PG8_LDA(At, 0, 1); PG8_STAGE(PG8_SB(0, 0), b2, voffB); PG8_STAGE(PG8_SB(0, 1), b2 + hstep, voffB); PG8_STAGE(PG8_SA(0, 0), a2, voffA);
            PG8_WAIT_V(8); PG8_WAIT_L(0); PG8_BAR; PG8_MMA(1, 0, At, B0); PG8_MMA(1, 1, At, B1); PG8_BAR; PG8_SCHED;
            PG8_LDB(B0, 1, 0); PG8_LDB(B1, 1, 1); PG8_SCHED; PG8_LDA(At, 1, 0); PG8_STAGE(PG8_SA(0, 1), a2 + hstep, voffA);
            PG8_WAIT_V(8); PG8_WAIT_L(0); PG8_BAR; PG8_MMA(0, 0, At, B0); PG8_MMA(0, 1, At, B1); PG8_BAR; PG8_SCHED;
            PG8_LDA(At, 1, 1); PG8_STAGE(PG8_SB(1, 0), b3, voffB); PG8_STAGE(PG8_SB(1, 1), b3 + hstep, voffB); PG8_STAGE(PG8_SA(1, 0), a3, voffA);
            PG8_WAIT_V(8); PG8_WAIT_L(0); PG8_BAR; PG8_MMA(1, 0, At, B0); PG8_MMA(1, 1, At, B1); PG8_BAR; PG8_SCHED;
            } else {
            PG8_LDB(B0, 0, 0); PG8_SCHED; PG8_LDA(At, 0, 0); PG8_STAGE(PG8_SA(1, 1), a1 + hstep, voffA);
            PG8_WAIT_L(8); PG8_BAR; PG8_WAIT_L(0); PG8_MMA(0, 0, At, B0); PG8_BAR; PG8_SCHED;
            PG8_LDB(B1, 0, 1); PG8_STAGE(PG8_SB(0, 0), b2, voffB);
            PG8_BAR; PG8_WAIT_L(0); PG8_MMA(0, 1, At, B1); PG8_BAR;
            PG8_LDA(At, 0, 1); PG8_STAGE(PG8_SA(0, 0), a2, voffA);
            PG8_BAR; PG8_WAIT_L(0); PG8_MMA(1, 0, At, B0); PG8_BAR; PG8_SCHED;
            PG8_STAGE(PG8_SB(0, 1), b2 + hstep, voffB);
            PG8_WAIT_V(6); PG8_BAR; PG8_MMA(1, 1, At, B1); PG8_BAR;
            PG8_LDB(B0, 1, 0); PG8_SCHED; PG8_LDA(At, 1, 0); PG8_STAGE(PG8_SA(0, 1), a2 + hstep, voffA);
            PG8_WAIT_L(8); PG8_BAR; PG8_WAIT_L(0); PG8_MMA(0, 0, At, B0); PG8_BAR; PG8_SCHED;
            PG8_LDB(B1, 1, 1); PG8_STAGE(PG8_SB(1, 0), b3, voffB);
            PG8_BAR; PG8_WAIT_L(0); PG8_MMA(0, 1, At, B1); PG8_BAR;
            PG8_LDA(At, 1, 1); PG8_STAGE(PG8_SA(1, 0), a3, voffA);
            PG8_BAR; PG8_WAIT_L(0); PG8_MMA(1, 0, At, B0); PG8_BAR; PG8_SCHED;
            PG8_STAGE(PG8_SB(1, 1), b3 + hstep, voffB);
            PG8_WAIT_V(6); PG8_BAR; PG8_MMA(1, 1, At, B1); PG8_BAR;
            }
        }
        if constexpr (ALIGN_EPI) { if (wr == 0) PG8_BAR; }
        if constexpr (!Epi::AFTER_DRAIN) { E(acc, cur, wr, wc, fr, fq); S.done(cur); }
        if (!has_next) break;
#pragma unroll
        for (int a = 0; a < 2; ++a)
#pragma unroll
            for (int b = 0; b < 2; ++b)
#pragma unroll
                for (int m = 0; m < 4; ++m)
#pragma unroll
                    for (int n = 0; n < 2; ++n) acc[a][b][m][n] = (f32x4){0.f, 0.f, 0.f, 0.f};
        cur = nxt; cA = nA; cB = nB; ++ui;
        if constexpr (ALIGN_EPI) { if (wr == 1) PG8_BAR; }
    }
    PG8_WAIT_V(0);
    if constexpr (!ALIGN_EPI) { if (wr == 0) PG8_BAR; }
    PG8_BAR;
    if constexpr (Epi::AFTER_DRAIN) { E.fused(acc, cur, wr, wc, fr, fq, lds, wid, lane); S.done(cur); }
#undef PG8_SA
#undef PG8_SB
#undef PG8_STAGE
#undef PG8_LDA
#undef PG8_LDB
#undef PG8_MMA
#undef PG8_WAIT_V
#undef PG8_WAIT_L
#undef PG8_BAR
#undef PG8_SCHED
}
}
namespace pg8 {
typedef unsigned u32x2 __attribute__((ext_vector_type(2)));
constexpr float RMS_EPS = 1e-6f;
constexpr float QC2 = 0.125f * 1.4426950408889634f;
constexpr int MROWS = 16384;

template <int LAYER> struct EpiProj {
    static constexpr bool PERM = true, AFTER_DRAIN = false;
    const float* rrow; const float* cs; bf16_t* base; bf16_t* k1; bf16_t* v1; const float* gains; float* ksum; int pn_off;
    __device__ __forceinline__ void operator()(const f32x4 (&acc)[2][2][4][2], const Unit& u, int wr, int wc, int fr, int fq) const {
        int kind; bf16_t* dst; int pitch, col, head = 0; const float* gain;
        if (LAYER == 0) { const int pnx = u.pn + pn_off; const int grp = pnx >> 1; head = (pnx & 1) * 4 + wc; dst = base + (size_t)grp * ((size_t)MROWS * 512); pitch = 512; col = head * 64 + 16 * fq;
            kind = grp == 0 ? (1 | 2 | 4) : grp == 1 ? (1 | 2 | 16) : grp == 3 ? (1 | 4) : grp == 4 ? 1 : grp == 6 ? 8 : 0;
            gain = gains + 64 * (grp == 0 ? 0 : grp == 1 ? 1 : grp == 3 ? 2 : 3); }
        else { if (u.pn < 4) { dst = base; pitch = 1024; col = (u.pn * 4 + wc) * 64 + 16 * fq; kind = 1 | 2 | 4; gain = gains; }
               else if (wc < 2) { dst = k1; pitch = 128; col = wc * 64 + 16 * fq; kind = 1 | 2; gain = gains + 64; }
               else { dst = v1; pitch = 128; col = (wc - 2) * 64 + 16 * fq; kind = 0; gain = gains + 64; } }
        f32x4 gv[2][2];
#pragma unroll
        for (int bj = 0; bj < 2; ++bj)
#pragma unroll
            for (int n = 0; n < 2; ++n) gv[bj][n] = *(const f32x4*)(gain + 16 * fq + 8 * bj + 4 * n);
        f32x4 ks[2][2];
#pragma unroll
        for (int bj = 0; bj < 2; ++bj)
#pragma unroll
            for (int n = 0; n < 2; ++n) ks[bj][n] = (f32x4){0.f, 0.f, 0.f, 0.f};
#pragma unroll
        for (int ai = 0; ai < 2; ++ai)
#pragma unroll
            for (int m = 0; m < 4; ++m) {
                const int row = u.pm * BM + ai * HALF + wr * 64 + m * 16 + fr; const float rs = rrow[row];
                f32x4 v[2][2];
#pragma unroll
                for (int bj = 0; bj < 2; ++bj)
#pragma unroll
                    for (int n = 0; n < 2; ++n) v[bj][n] = acc[ai][bj][m][n] * rs;
                if (kind & 1) { float ss = 0.f;
#pragma unroll
                    for (int bj = 0; bj < 2; ++bj)
#pragma unroll
                        for (int n = 0; n < 2; ++n) { const f32x4 x = v[bj][n]; ss += (x[0] * x[0] + x[1] * x[1]) + (x[2] * x[2] + x[3] * x[3]); }
                    ss += __shfl_xor(ss, 16); ss += __shfl_xor(ss, 32);
                    const float ri = 1.0f / sqrtf(ss * (1.0f / 64.0f) + RMS_EPS);
#pragma unroll
                    for (int bj = 0; bj < 2; ++bj)
#pragma unroll
                        for (int n = 0; n < 2; ++n) v[bj][n] = (v[bj][n] * ri) * gv[bj][n]; }
                if ((kind & 2) && fq == 0) { const float* cp = cs + (size_t)(row & 8191) * 16;
#pragma unroll
                    for (int n = 0; n < 2; ++n) { const f32x4 c = *(const f32x4*)(cp + 4 * n), s = *(const f32x4*)(cp + 8 + 4 * n); const f32x4 x1 = v[0][n], x2 = v[1][n];
                        v[0][n] = x1 * c - x2 * s; v[1][n] = x2 * c + x1 * s; } }
                if (kind & 16) {
#pragma unroll
                    for (int bj = 0; bj < 2; ++bj)
#pragma unroll
                        for (int n = 0; n < 2; ++n) ks[bj][n] += v[bj][n]; }
                if (kind & 4) {
#pragma unroll
                    for (int bj = 0; bj < 2; ++bj)
#pragma unroll
                        for (int n = 0; n < 2; ++n) v[bj][n] = v[bj][n] * QC2; }
                if (kind & 8) {
#pragma unroll
                    for (int bj = 0; bj < 2; ++bj)
#pragma unroll
                        for (int n = 0; n < 2; ++n)
#pragma unroll
                            for (int j = 0; j < 4; ++j) v[bj][n][j] = 1.0f / (1.0f + __expf(-v[bj][n][j])); }
                bf16_t* rp = dst + (size_t)row * pitch + col;
#pragma unroll
                for (int bj = 0; bj < 2; ++bj) { u32x4 w; w.x = cvt_pk_bf16(v[bj][0][0], v[bj][0][1]); w.y = cvt_pk_bf16(v[bj][0][2], v[bj][0][3]); w.z = cvt_pk_bf16(v[bj][1][0], v[bj][1][1]); w.w = cvt_pk_bf16(v[bj][1][2], v[bj][1][3]);
                    *(u32x4*)(rp + 8 * bj) = w; }
            }
        if (LAYER == 0 && (kind & 16)) {
#pragma unroll
            for (int bj = 0; bj < 2; ++bj)
#pragma unroll
                for (int n = 0; n < 2; ++n)
#pragma unroll
                    for (int j = 0; j < 4; ++j) { float s = ks[bj][n][j]; s += __shfl_xor(s, 1); s += __shfl_xor(s, 2); s += __shfl_xor(s, 4); s += __shfl_xor(s, 8); ks[bj][n][j] = s; }
            if (fr == 0) { float* kp = ksum + ((size_t)((u.pm * 2 + wr) * 8 + head)) * 64 + 16 * fq;
#pragma unroll
                for (int bj = 0; bj < 2; ++bj)
#pragma unroll
                    for (int n = 0; n < 2; ++n) *(f32x4*)(kp + 8 * bj + 4 * n) = ks[bj][n]; }
        }
    }
};

struct EpiResid {
    static constexpr bool PERM = false, AFTER_DRAIN = false;
    const float* xin; float* xout; bf16_t* xb; float* rsp;
    __device__ __forceinline__ void operator()(const f32x4 (&acc)[2][2][4][2], const Unit& u, int wr, int wc, int fr, int fq) const {
        const int col0 = u.pn * BM + wc * 32 + 4 * fq;
#pragma unroll
        for (int ai = 0; ai < 2; ++ai)
#pragma unroll
            for (int m = 0; m < 4; ++m) { const int row = u.pm * BM + ai * HALF + wr * 64 + m * 16 + fr; float ss = 0.f;
#pragma unroll
                for (int bj = 0; bj < 2; ++bj)
#pragma unroll
                    for (int n = 0; n < 2; ++n) { const size_t off = (size_t)row * 1024 + col0 + bj * HALF + n * 16;
                        const f32x4 o = *(const f32x4*)(xin + off) + acc[ai][bj][m][n]; *(f32x4*)(xout + off) = o;
                        ss += (o[0] * o[0] + o[1] * o[1]) + (o[2] * o[2] + o[3] * o[3]);
                        u32x2 w; w.x = cvt_pk_bf16(o[0], o[1]); w.y = cvt_pk_bf16(o[2], o[3]); *(u32x2*)(xb + off) = w; }
                ss += __shfl_xor(ss, 16); ss += __shfl_xor(ss, 32);
                if (fq == 0) rsp[(size_t)row * 16 + u.pn * 4 + wc] = ss; }
    }
};

struct EpiPeerQ {
    static constexpr bool PERM = true, AFTER_DRAIN = false;
    const float* rsp; bf16_t* qp;
    __device__ __forceinline__ void operator()(const f32x4 (&acc)[2][2][4][2], const Unit& u, int wr, int wc, int fr, int fq) const {
        const int col0 = u.pn * BM + wc * 32 + 8 * fq;
#pragma unroll
        for (int ai = 0; ai < 2; ++ai)
#pragma unroll
            for (int m = 0; m < 4; ++m) { const int row = u.pm * BM + ai * HALF + wr * 64 + m * 16 + fr;
                const f32x4 a = *(const f32x4*)(rsp + (size_t)row * 16), b = *(const f32x4*)(rsp + (size_t)row * 16 + 4), c = *(const f32x4*)(rsp + (size_t)row * 16 + 8), d = *(const f32x4*)(rsp + (size_t)row * 16 + 12);
                const float ss = ((a[0] + a[1]) + (a[2] + a[3])) + ((b[0] + b[1]) + (b[2] + b[3])) + ((c[0] + c[1]) + (c[2] + c[3])) + ((d[0] + d[1]) + (d[2] + d[3]));
                const float rs = 1.0f / sqrtf(ss * (1.0f / 1024.0f) + RMS_EPS);
                bf16_t* rp = qp + (size_t)row * 1024 + col0;
#pragma unroll
                for (int bj = 0; bj < 2; ++bj) { const f32x4 v0 = acc[ai][bj][m][0] * rs, v1 = acc[ai][bj][m][1] * rs; u32x4 w; w.x = cvt_pk_bf16(v0[0], v0[1]); w.y = cvt_pk_bf16(v0[2], v0[3]); w.z = cvt_pk_bf16(v1[0], v1[1]); w.w = cvt_pk_bf16(v1[2], v1[3]);
                    *(u32x4*)(rp + bj * HALF) = w; } }
    }
};
}
#include <hip/hip_bf16.h>
#include <cmath>
namespace attn_body {
using bf16=__hip_bfloat16;
using bf16x8=__attribute__((ext_vector_type(8)))short;
using s16x4=__attribute__((ext_vector_type(4)))short;
using f32x16=__attribute__((ext_vector_type(16)))float;
using u32x4=__attribute__((ext_vector_type(4)))unsigned;
constexpr int BATCH=2,SEQ=8192,D=64;
constexpr int NW=8,QBLK=32,QB=QBLK*NW,KVBLK=64,NQB=SEQ/QB;
constexpr int ATTN_UNIT_ROWS=QB;
__device__ __forceinline__ int crow(int r,int hi){return (r&3)+8*(r>>2)+4*hi;}
#define SBAR() __builtin_amdgcn_sched_barrier(0)
typedef __attribute__((address_space(3))) const float* lds_cfptr;
typedef float f32x4a __attribute__((ext_vector_type(4)));
__device__ __forceinline__ float badd_s(float a,float b){float r;asm("v_add_f32_e32 %0, %1, %2":"=v"(r):"v"(a),"v"(b));return r;}
template<int VAR,bool BAND> __device__ __forceinline__ void bias_tile(f32x16&p0,f32x16&p1,int t,int jb,int qrel,int hi,lds_cfptr ftab,unsigned selm,int t0,float negs){
  const float NEG=-INFINITY;
  if(VAR==1){ const lds_cfptr f=ftab+64*t+4*hi;
    #pragma unroll
    for(int g=0;g<4;++g){ const f32x4a a=*(const __attribute__((address_space(3))) f32x4a*)(f+8*g); const f32x4a c=*(const __attribute__((address_space(3))) f32x4a*)(f+32+8*g);
      #pragma unroll
      for(int j=0;j<4;++j){p0[4*g+j]+=negs-a[j];p1[4*g+j]+=negs-c[j];} } }
  else { float s=negs;
    if(VAR==0){ if(!BAND||jb<0){ const bool ok=((selm>>((t0+t)>>2))&1u)!=0u; s=ok?negs:NEG; } }
    #pragma unroll
    for(int r=0;r<16;++r){p0[r]+=s;p1[r]+=s;} }
  if(BAND){
    if(VAR==2){ const int kb=64*jb+4*hi;
      #pragma unroll
      for(int r=0;r<16;++r){const int kv=kb+(r&3)+8*(r>>2); if(kv>qrel||kv<=qrel-128)p0[r]=NEG; if(kv+32>qrel||kv+32<=qrel-128)p1[r]=NEG;} }
    else if(jb>=0&&VAR!=3){ const int kb=64*jb+4*hi;
      #pragma unroll
      for(int r=0;r<16;++r){const int kv=kb+(r&3)+8*(r>>2); if(kv>qrel)p0[r]=NEG; if(kv+32>qrel)p1[r]=NEG;} }
  }
}
struct UnitArgs { const bf16*Q; const bf16*K; const bf16*V; bf16*O; int qcol,kcol,ocol; const float*Fl2; const bf16*gate; const unsigned*sel; const float*sinkp; float bl2x2; const unsigned short*glist; int gn; bf16*PO; float*LSE; int kvres; };

constexpr int NSLOT=3, SLOTB=8192;
constexpr int LDS_K=0, LDS_V=NSLOT*SLOTB, LDS_WS=2*NSLOT*SLOTB, LDS_OST=LDS_WS+NW*256*4, LDS_F=90112, LDS_BYTES=LDS_F+SEQ*4;
constexpr float C2=0.125f*1.4426950408889634f;
__device__ __forceinline__ void glds16(const void*gsrc,unsigned lds_dst){unsigned keep;
  asm volatile("s_mov_b32 %0, m0\n\ts_mov_b32 m0, %2\n\ts_nop 0\n\tglobal_load_lds_dwordx4 %1, off\n\ts_mov_b32 m0, %0":"=&s"(keep):"v"(gsrc),"s"(lds_dst):"memory");}
__device__ __forceinline__ float max3f(float a,float b,float c){float r;asm("v_max3_f32 %0, %1, %2, %3":"=v"(r):"v"(a),"v"(b),"v"(c));return r;}
__device__ __forceinline__ float max2f(float a,float b){float r;asm("v_max_f32_e32 %0, %1, %2":"=v"(r):"v"(a),"v"(b));return r;}
__device__ __forceinline__ float fadd_s(float a,float b){float r;asm("v_add_f32_e32 %0, %1, %2":"=v"(r):"v"(a),"v"(b));return r;}
__device__ __forceinline__ float fsub_s(float a,float b){float r;asm("v_sub_f32_e32 %0, %1, %2":"=v"(r):"v"(a),"v"(b));return r;}
typedef float f32x2_t __attribute__((ext_vector_type(2))); typedef __bf16 bf16x2_t __attribute__((ext_vector_type(2)));
__device__ __forceinline__ unsigned cvtpk_s(float lo,float hi){f32x2_t v={lo,hi};bf16x2_t b=__builtin_convertvector(v,bf16x2_t);return __builtin_bit_cast(unsigned,b);}
#define WAIT_BAR(N) asm volatile("s_waitcnt vmcnt(" #N ") lgkmcnt(0)\n\ts_barrier":::"memory")

__device__ __forceinline__ void qkt(f32x16&p0,f32x16&p1,const char*Kslot,const bf16x8*qr,const f32x16&negm,int r32,int hi){
  const char*kb=Kslot+hi*1024+r32*16;
  #pragma unroll
  for(int d0=0;d0<4;++d0){
    const bf16x8 b0=*reinterpret_cast<const bf16x8*>(kb+d0*2048);
    const bf16x8 b1=*reinterpret_cast<const bf16x8*>(kb+d0*2048+512);
    if(d0==0){p0=__builtin_amdgcn_mfma_f32_32x32x16_bf16(b0,qr[0],negm,0,0,0);p1=__builtin_amdgcn_mfma_f32_32x32x16_bf16(b1,qr[0],negm,0,0,0);}
    else{p0=__builtin_amdgcn_mfma_f32_32x32x16_bf16(b0,qr[d0],p0,0,0,0);p1=__builtin_amdgcn_mfma_f32_32x32x16_bf16(b1,qr[d0],p1,0,0,0);}}
}
typedef __attribute__((address_space(3))) const char* lds_cptr;
typedef short v4i16_t __attribute__((ext_vector_type(4)));
__device__ __forceinline__ void kload8(bf16x8*kf,lds_cptr kp){
  kf[0]=*(const __attribute__((address_space(3))) bf16x8*)(kp);      kf[1]=*(const __attribute__((address_space(3))) bf16x8*)(kp+512);
  kf[2]=*(const __attribute__((address_space(3))) bf16x8*)(kp+2048); kf[3]=*(const __attribute__((address_space(3))) bf16x8*)(kp+2560);
  kf[4]=*(const __attribute__((address_space(3))) bf16x8*)(kp+4096); kf[5]=*(const __attribute__((address_space(3))) bf16x8*)(kp+4608);
  kf[6]=*(const __attribute__((address_space(3))) bf16x8*)(kp+6144); kf[7]=*(const __attribute__((address_space(3))) bf16x8*)(kp+6656);
}
__device__ __forceinline__ void kload2(bf16x8*kf,lds_cptr kp,int j){ kf[2*j]=*(const __attribute__((address_space(3))) bf16x8*)(kp+j*2048); kf[2*j+1]=*(const __attribute__((address_space(3))) bf16x8*)(kp+j*2048+512); }
__device__ __forceinline__ s16x4 vtr(lds_cptr p){ return __builtin_bit_cast(s16x4,__builtin_amdgcn_ds_read_tr16_b64_v4i16((__attribute__((address_space(3))) v4i16_t*)p)); }
__device__ __forceinline__ float rowmax(const f32x16&p0,const f32x16&p1){
  float a=max3f(p0[0],p0[1],p1[0]),b=max3f(p0[2],p0[3],p1[1]);a=max3f(a,p1[2],p1[3]);
  #pragma unroll
  for(int r=4;r<16;r+=4){a=max3f(a,p0[r],p0[r+1]);b=max3f(b,p0[r+2],p0[r+3]);a=max3f(a,p1[r],p1[r+1]);b=max3f(b,p1[r+2],p1[r+3]);}
  const float m=max2f(a,b);
  auto rr=__builtin_amdgcn_permlane32_swap(__float_as_uint(m),__float_as_uint(m),false,false);
  return max2f(__uint_as_float(rr[0]),__uint_as_float(rr[1]));
}
__device__ __forceinline__ void pv(f32x16*o,int vb,bf16x8 pa0,bf16x8 pa1,bf16x8 pa2,bf16x8 pa3){
  #pragma unroll
  for(int d0=0;d0<2;++d0){s16x4 lo[4],hi[4];
    #pragma unroll
    for(int ks=0;ks<4;++ks){
      asm volatile("ds_read_b64_tr_b16 %0,%1 offset:%c2":"=&v"(lo[ks]):"v"(vb),"i"(d0*4096+ks*1024):"memory");
      asm volatile("ds_read_b64_tr_b16 %0,%1 offset:%c2":"=&v"(hi[ks]):"v"(vb),"i"(d0*4096+ks*1024+512):"memory");}
    asm volatile("s_waitcnt lgkmcnt(0)":::"memory");SBAR();
    #define PK(k) (bf16x8){lo[k][0],lo[k][1],lo[k][2],lo[k][3],hi[k][0],hi[k][1],hi[k][2],hi[k][3]}
    o[d0]=__builtin_amdgcn_mfma_f32_32x32x16_bf16(pa0,PK(0),o[d0],0,0,0);
    o[d0]=__builtin_amdgcn_mfma_f32_32x32x16_bf16(pa1,PK(1),o[d0],0,0,0);
    o[d0]=__builtin_amdgcn_mfma_f32_32x32x16_bf16(pa2,PK(2),o[d0],0,0,0);
    o[d0]=__builtin_amdgcn_mfma_f32_32x32x16_bf16(pa3,PK(3),o[d0],0,0,0);
    #undef PK
  }
}

#ifndef ATTN_STORE16
#define ATTN_STORE16(p,v) (*(u32x4*)(p)=(v))
#endif
template<int VAR,int THRL,int DMQ,int DMK,int DMO> __device__ __forceinline__ void attn_unit(int b,int qb,const UnitArgs&A,char*shm){
  int tid_=threadIdx.x; asm volatile("":"+v"(tid_)); const int tid=tid_,lane=tid&63,r32=lane&31,hi=lane>>5; const int wid=__builtin_amdgcn_readfirstlane(tid>>6);
  const long rowbase=(long)b*SEQ; const int q0=qb*QB;
  const lds_cptr shm3=(lds_cptr)shm;
  int t0=0, NT=4*qb+4; float rowc=0.f; unsigned selm=0u;
  if(VAR==2){ t0=qb?4*qb-2:0; NT=qb?6:4; }
  if(VAR==3||VAR==4){ t0=4*qb; NT=4; }
  int gpos=q0+wid*QBLK+r32; bool gvalid=true;
  if(VAR==3){ const int gi=wid*QBLK+r32; gvalid=gi<A.gn; gpos=(int)A.glist[gvalid?gi:0]; }
  if(VAR==4){ selm=A.sel[gpos]; }
  if(VAR==0){ selm=A.sel[q0+wid*QBLK+r32]; asm volatile("":"+s"(NT)); }
  if(VAR==1){ const float fq0=A.Fl2[q0]; const int ntile=4*qb+4;
    const bool k0=(lane<ntile)?(A.bl2x2+fq0-A.Fl2[64*lane+63]>=-160.f):true;
    const bool k1=(lane+64<ntile)?(A.bl2x2+fq0-A.Fl2[64*(lane+64)+63]>=-160.f):true;
    const unsigned long long m0=__ballot(k0), m1=__ballot(k1);
    int first=m0?(int)__builtin_ctzll(m0):64+(int)__builtin_ctzll(m1|(1ull<<63));
    first&=~1; if(first>4*qb)first=4*qb;
    t0=__builtin_amdgcn_readfirstlane(first); NT=4*qb+4-t0;
    __attribute__((address_space(3))) float*ft=(__attribute__((address_space(3))) float*)(shm3+LDS_F);
    for(int i=tid;i<64*NT;i+=NW*64)ft[i]=A.Fl2[64*t0+i]-fq0;
    rowc=A.Fl2[q0+wid*QBLK+r32]-fq0;
    asm volatile("s_waitcnt vmcnt(0) lgkmcnt(0)\n\ts_barrier":::"memory");
  }
  const lds_cfptr ftab=(lds_cfptr)(shm3+LDS_F);
  const bf16*Qrow=A.Q+(rowbase+gpos)*DMQ+A.qcol;
  const bf16*Kh=A.K+(rowbase+(long)t0*KVBLK)*DMK+A.kcol,*Vh=A.V+(rowbase+(long)t0*KVBLK)*DMK+A.kcol;
  const int NTu=NT; int wofs=0, jofs=0;
  if(VAR==2&&NT==6){ const int tl=(wid>>1)<2?(wid>>1):2; t0+=tl; NT=4; wofs=tl*8192; jofs=tl-2; }
  const unsigned lds0=(unsigned)(uintptr_t)shm;
  constexpr bool RES=(VAR>=2); constexpr int NSL=(VAR==2)?6:(RES?4:3), LV=NSL*SLOTB, LWS=2*NSL*SLOTB, LOST=LWS+NW*256*4;
  float*wsf=(float*)(shm+LWS)+wid*256;
  const bf16*ksrc=Kh+(long)lane*DMK+wid*8;
  const bf16*vsrc=Vh+(long)(16*(wid&3)+(lane>>2))*DMK+(wid>>2)*32+(lane&3)*8;
  const unsigned kdst=lds0+LDS_K+wid*1024, vdst=lds0+LV+wid*1024;
  #define DMA_K(t,slot) glds16(ksrc+(long)(t)*KVBLK*DMK,(unsigned)__builtin_amdgcn_readfirstlane(kdst+(slot)))
  #define DMA_V(t,slot) glds16(vsrc+(long)(t)*KVBLK*DMK,(unsigned)__builtin_amdgcn_readfirstlane(vdst+(slot)))
  const int vb0=(int)(lds0+LV)+wofs+((lane>>4)&1)*32+(lane&3)*8+(4*hi+((lane&15)>>2))*64;
  const char*Kbase=shm+LDS_K+wofs; bf16x8 kf[8];
  const lds_cptr kp0=shm3+LDS_K+wofs+hi*1024+r32*16; const lds_cptr vp0=shm3+LV+wofs+((lane>>4)&1)*32+(lane&3)*8+(4*hi+((lane&15)>>2))*64;
  const bool kvres=(VAR==3||VAR==2)&&A.kvres;
  if(!kvres){DMA_K(0,0);DMA_V(0,0);DMA_K(1,SLOTB); if(RES){DMA_V(1,SLOTB);}}
  bf16x8 qr[4];
  #pragma unroll
  for(int d0=0;d0<4;++d0)qr[d0]=*reinterpret_cast<const bf16x8*>(&Qrow[d0*16+hi*8]);
  float lse0=-INFINITY,lse1=-INFINITY,lse2=-INFINITY,sinkv=0.f;
  if(VAR==3){ selm=A.sel[gpos]; }
  if(VAR==4){ const int ns=__builtin_popcount(selm); if(ns>0)lse0=A.LSE[(long)gpos*3+0]; if(ns>1)lse1=A.LSE[(long)gpos*3+1]; if(ns>2)lse2=A.LSE[(long)gpos*3+2]; }
  if(VAR==2){ sinkv=A.sinkp[0]; }
  float mhat=0.f,l_reg=0.f;f32x16 o[2];o[0]=f32x16{};o[1]=f32x16{};const f32x16 negm=f32x16{};
  const int qrel=wid*QBLK+r32;
  #define CMASK(P0,P1,t) bias_tile<VAR,true>(P0,P1,(t),(t)-(NT-4)+jofs,qrel,hi,ftab,selm,t0,rowc-mhat)
  bool resc=false;
  #define START(P0,P1) do{ const float rm=rowmax(P0,P1); resc=false; \
    { const float dl=max2f(rm,-30.f); mhat=fadd_s(mhat,dl); \
      _Pragma("unroll") for(int r=0;r<16;++r){P0[r]=fsub_s(P0[r],dl);P1[r]=fsub_s(P1[r],dl);} \
      } \
    _Pragma("unroll") for(int r=0;r<16;++r)P0[r]=__builtin_amdgcn_exp2f(P0[r]); }while(0)
  #define RESC() do{ if(resc){ asm volatile("s_waitcnt lgkmcnt(0)":::"memory"); \
      _Pragma("unroll") for(int d_=0;d_<2;++d_) _Pragma("unroll") for(int r=0;r<16;++r)o[d_][r]*=wsf[crow(r,hi)]; } }while(0)
  f32x16 pA0,pA1,pB0,pB1;
  int sl_prev=0,sl_cur=0,sl_next=SLOTB;
  #define ROT() do{sl_prev=sl_cur;sl_cur=sl_next;sl_next=(sl_next==(NSL-1)*SLOTB)?0:sl_next+SLOTB;}while(0)
  if(!kvres){DMA_K(2,2*SLOTB);}
  if(RES){ if(!kvres){DMA_V(2,2*SLOTB);DMA_K(3,3*SLOTB);DMA_V(3,3*SLOTB); if(VAR==2&&NTu>4){DMA_K(4,4*SLOTB);DMA_V(4,4*SLOTB);DMA_K(5,5*SLOTB);DMA_V(5,5*SLOTB);} WAIT_BAR(0);} } else {WAIT_BAR(3);}
  qkt(pA0,pA1,Kbase,qr,negm,r32,hi);asm volatile("s_nop 15\n\ts_nop 7":"+v"(pA0),"+v"(pA1));CMASK(pA0,pA1,0);
  START(pA0,pA1);
  _Pragma("unroll") for(int r=0;r<16;++r)pA1[r]=__builtin_amdgcn_exp2f(pA1[r]);
  if(!RES){ WAIT_BAR(0);
  DMA_K(3,0);DMA_V(1,SLOTB); }
  ROT();
  kload8(kf,kp0+sl_cur);
  if(!RES){WAIT_BAR(2);}
  s16x4 vlo[8],vhi[8]; u32x4 pw0,pw1,pw2,pw3;
  #define PKW(P,B) cvtpk_s(P[B],P[B+1])
  #define PAF(k) __builtin_bit_cast(bf16x8,pw##k)
  #define VFR(i) (bf16x8){vlo[i][0],vlo[i][1],vlo[i][2],vlo[i][3],vhi[i][0],vhi[i][1],vhi[i][2],vhi[i][3]}
  #define PIN(x) asm volatile("":"+v"(x))
  #define MX3(a,b,c) __builtin_fmaxf(__builtin_fmaxf((a),(b)),(c))
  #define GAPA(MF,A0,A1,A2,A3,W0,W1,PW) do{ MF; sacc+=A0; sacc+=A1; sacc+=A2; sacc+=A3; PIN(sacc); W0; W1; PIN(PW); SBAR(); }while(0)
  #define EX(v) __builtin_amdgcn_exp2f(v)
  #define GAPB(MF,X,B) do{ MF; X[B]=EX(X[B]); X[B+1]=EX(X[B+1]); X[B+2]=EX(X[B+2]); X[B+3]=EX(X[B+3]); PIN(X); SBAR(); }while(0)
  #define VRD(i) do{ vlo[i]=vtr(vp_+(((i)>>2)*4096+((i)&3)*1024)); vhi[i]=vtr(vp_+(((i)>>2)*4096+((i)&3)*1024+512)); }while(0)
  #define KRD(G,j) do{ if(G){ kload2(kf,kp0+sl_next,j); SBAR(); } }while(0)
  #define STEP(C0,C1,P0,P1,t,GK,GV,GL) do{ SBAR(); \
    const lds_cptr vp_=vp0+sl_prev; \
    VRD(0); SBAR(); float sacc=(P0[0]+P0[1]); \
    GAPA(C0=__builtin_amdgcn_mfma_f32_32x32x16_bf16(kf[0],qr[0],negm,0,0,0), P0[2],P0[3],P0[4],P0[5],     pw0[0]=PKW(P0,0), pw0[1]=PKW(P0,2), pw0); \
    VRD(4); SBAR(); GAPA(C1=__builtin_amdgcn_mfma_f32_32x32x16_bf16(kf[1],qr[0],negm,0,0,0), P0[6],P0[7],P0[8],P0[9],     pw0[2]=PKW(P0,4), pw0[3]=PKW(P0,6), pw0); \
    VRD(1); SBAR(); GAPA(C0=__builtin_amdgcn_mfma_f32_32x32x16_bf16(kf[2],qr[1],C0,0,0,0),   P0[10],P0[11],P0[12],P0[13], pw1[0]=PKW(P0,8), pw1[1]=PKW(P0,10), pw1); \
    VRD(5); SBAR(); GAPA(C1=__builtin_amdgcn_mfma_f32_32x32x16_bf16(kf[3],qr[1],C1,0,0,0),   P0[14],P0[15],P1[0],P1[1],   pw1[2]=PKW(P0,12),pw1[3]=PKW(P0,14), pw1); \
    VRD(2); SBAR(); GAPA(C0=__builtin_amdgcn_mfma_f32_32x32x16_bf16(kf[4],qr[2],C0,0,0,0),   P1[2],P1[3],P1[4],P1[5],     pw2[0]=PKW(P1,0), pw2[1]=PKW(P1,2), pw2); \
    VRD(6); SBAR(); GAPA(C1=__builtin_amdgcn_mfma_f32_32x32x16_bf16(kf[5],qr[2],C1,0,0,0),   P1[6],P1[7],P1[8],P1[9],     pw2[2]=PKW(P1,4), pw2[3]=PKW(P1,6), pw2); \
    VRD(3); SBAR(); GAPA(C0=__builtin_amdgcn_mfma_f32_32x32x16_bf16(kf[6],qr[3],C0,0,0,0),   P1[10],P1[11],P1[12],P1[13], pw3[0]=PKW(P1,8), pw3[1]=PKW(P1,10), pw3); \
    VRD(7); SBAR(); GAPA(C1=__builtin_amdgcn_mfma_f32_32x32x16_bf16(kf[7],qr[3],C1,0,0,0),   P1[14],P1[15],0.f,0.f,       pw3[2]=PKW(P1,12),pw3[3]=PKW(P1,14), pw3); \
    l_reg+=sacc; \
    if(GK){DMA_K((t)+3,sl_cur);} if(GV){DMA_V((t)+1,sl_next);} \
    CMASK(C0,C1,t); \
    { float a=MX3(C0[0],C0[1],C1[0]),b=MX3(C0[2],C0[3],C1[1]); a=MX3(a,C1[2],C1[3]); \
      _Pragma("unroll") for(int r=4;r<16;r+=4){a=MX3(a,C0[r],C0[r+1]);b=MX3(b,C0[r+2],C0[r+3]);a=MX3(a,C1[r],C1[r+1]);b=MX3(b,C1[r+2],C1[r+3]);} \
      float rm=__builtin_fmaxf(a,b); { auto rr=__builtin_amdgcn_permlane32_swap(__float_as_uint(rm),__float_as_uint(rm),false,false); rm=__builtin_fmaxf(__uint_as_float(rr[0]),__uint_as_float(rr[1])); } \
      resc=false; \
      if(__builtin_expect(__any(rm>(float)THRL),0)){ const float dl=__builtin_fmaxf(rm,0.f); mhat+=dl; \
        _Pragma("unroll") for(int r=0;r<16;++r){C0[r]-=dl;C1[r]-=dl;} \
        const float f=__builtin_amdgcn_exp2f(-dl); l_reg*=f; if(hi==0)wsf[r32]=f; resc=true; } } \
    SBAR(); \
    GAPB(o[0]=__builtin_amdgcn_mfma_f32_32x32x16_bf16(PAF(0),VFR(0),o[0],0,0,0), C0,0); \
    GAPB(o[1]=__builtin_amdgcn_mfma_f32_32x32x16_bf16(PAF(0),VFR(4),o[1],0,0,0), C0,4); \
    KRD(GL,0); GAPB(o[0]=__builtin_amdgcn_mfma_f32_32x32x16_bf16(PAF(1),VFR(1),o[0],0,0,0), C0,8); \
    KRD(GL,1); GAPB(o[1]=__builtin_amdgcn_mfma_f32_32x32x16_bf16(PAF(1),VFR(5),o[1],0,0,0), C0,12); \
    KRD(GL,2); GAPB(o[0]=__builtin_amdgcn_mfma_f32_32x32x16_bf16(PAF(2),VFR(2),o[0],0,0,0), C1,0); \
    KRD(GL,3); GAPB(o[1]=__builtin_amdgcn_mfma_f32_32x32x16_bf16(PAF(2),VFR(6),o[1],0,0,0), C1,4); \
    GAPB(o[0]=__builtin_amdgcn_mfma_f32_32x32x16_bf16(PAF(3),VFR(3),o[0],0,0,0), C1,8); \
    GAPB(o[1]=__builtin_amdgcn_mfma_f32_32x32x16_bf16(PAF(3),VFR(7),o[1],0,0,0), C1,12); \
    }while(0)
  int t=1;
  #undef CMASK
  #define CMASK(P0,P1,t) bias_tile<VAR,false>(P0,P1,(t),-1,qrel,hi,ftab,selm,t0,rowc-mhat)
  for(;t+5<NT;t+=2){
    STEP(pB0,pB1,pA0,pA1,t,true,true,true);     WAIT_BAR(2); RESC(); ROT();
    STEP(pA0,pA1,pB0,pB1,t+1,true,true,true);   WAIT_BAR(2); RESC(); ROT();
  }
  #undef CMASK
  #define CMASK(P0,P1,t) bias_tile<VAR,true>(P0,P1,(t),(t)-(NT-4)+jofs,qrel,hi,ftab,selm,t0,rowc-mhat)
  #define ENDW(tt) do{ if((tt)+3<NT){WAIT_BAR(2);} else if((tt)+2<NT){WAIT_BAR(1);} else {WAIT_BAR(0);} }while(0)
  for(;t+1<NT;t+=2){
    if(RES){ STEP(pB0,pB1,pA0,pA1,t,false,false,(t+1<NT)); RESC(); ROT(); STEP(pA0,pA1,pB0,pB1,t+1,false,false,(t+2<NT)); RESC(); ROT(); }
    else {
    STEP(pB0,pB1,pA0,pA1,t,(t+3<NT),(t+1<NT),(t+1<NT));       ENDW(t);   RESC(); ROT();
    STEP(pA0,pA1,pB0,pB1,t+1,(t+4<NT),(t+2<NT),(t+2<NT));     ENDW(t+1); RESC(); ROT(); }
  }
  STEP(pB0,pB1,pA0,pA1,NT-1,false,false,false); RESC();
  { float sacc=pB0[0]+pB0[1]; _Pragma("unroll") for(int r=2;r<16;++r)sacc+=pB0[r]; _Pragma("unroll") for(int r=0;r<16;++r)sacc+=pB1[r]; l_reg+=sacc;
    pw0=(u32x4){PKW(pB0,0),PKW(pB0,2),PKW(pB0,4),PKW(pB0,6)};pw1=(u32x4){PKW(pB0,8),PKW(pB0,10),PKW(pB0,12),PKW(pB0,14)};pw2=(u32x4){PKW(pB1,0),PKW(pB1,2),PKW(pB1,4),PKW(pB1,6)};pw3=(u32x4){PKW(pB1,8),PKW(pB1,10),PKW(pB1,12),PKW(pB1,14)};
    SBAR(); pv(o,vb0+sl_cur,PAF(0),PAF(1),PAF(2),PAF(3)); }
  #undef PKW
  #undef PAF
  #undef VFR
  #undef PIN
  #undef MX3
  #undef GAPA
  #undef GAPB
  #undef EX
  #undef VRD
  #undef KRD
  #undef STEP
  #undef ENDW
  {auto rr=__builtin_amdgcn_permlane32_swap(__float_as_uint(l_reg),__float_as_uint(l_reg),false,false);l_reg=__uint_as_float(rr[0])+__uint_as_float(rr[1]);}
  if(VAR==2)l_reg+=__builtin_amdgcn_exp2f(sinkv*1.4426950408889634f-mhat);
  if(VAR==3&&hi==0){ const int slot=__builtin_popcount(selm&((1u<<qb)-1u)); const int dst=gvalid?gpos*3+slot:-1; wsf[64+r32]=__int_as_float(dst);
    if(gvalid)A.LSE[(long)gpos*3+slot]=mhat+__builtin_amdgcn_logf(l_reg); }
  if(VAR==4&&hi==0){ const int ns=__builtin_popcount(selm); const float lo=mhat+__builtin_amdgcn_logf(l_reg);
    const float l0=lse0, l1=lse1, l2=lse2; (void)ns;
    const float mm=__builtin_fmaxf(__builtin_fmaxf(lo,l0),__builtin_fmaxf(l1,l2));
    const float e0=__builtin_amdgcn_exp2f(lo-mm), e1=__builtin_amdgcn_exp2f(l0-mm), e2=__builtin_amdgcn_exp2f(l1-mm), e3=__builtin_amdgcn_exp2f(l2-mm), inv=__builtin_amdgcn_rcpf((e0+e1)+(e2+e3));
    wsf[64+4*r32]=e0*inv; wsf[65+4*r32]=e1*inv; wsf[66+4*r32]=e2*inv; wsf[67+4*r32]=e3*inv; }
  if(hi==0)wsf[32+r32]=l_reg;asm volatile("s_waitcnt lgkmcnt(0)":::"memory");
  float rli[16];
  #pragma unroll
  for(int r=0;r<16;++r)rli[r]=__builtin_amdgcn_rcpf(wsf[32+crow(r,hi)]);
  bf16*Ow=A.O+(rowbase+q0+wid*QBLK)*DMO+A.ocol;
  { bf16*stg=(bf16*)(shm+LOST)+wid*2048;
    #pragma unroll
    for(int r=0;r<16;++r){const int orow=crow(r,hi);
      #pragma unroll
      for(int d0=0;d0<2;++d0)stg[orow*64+d0*32+r32]=__float2bfloat16(o[d0][r]*rli[r]);}
    asm volatile("s_waitcnt lgkmcnt(0)":::"memory");
    #pragma unroll
    for(int once_=0;once_<1;++once_){ u32x4 gl[4]; u32x4 pl[4][3];
    if(VAR==1){
      #pragma unroll
      for(int i=0;i<4;++i)gl[i]=*(const u32x4*)(A.gate+(rowbase+q0+wid*QBLK+i*8+(lane>>3))*512+(lane&7)*8); }
    if(VAR==4){
      #pragma unroll
      for(int i=0;i<4;++i)
        #pragma unroll
        for(int sl=0;sl<3;++sl)pl[i][sl]=*(const u32x4*)(A.PO+((long)(q0+wid*QBLK+i*8+(lane>>3))*3+sl)*64+(lane&7)*8); }
    #pragma unroll
    for(int i=0;i<4;++i){const int row=i*8+(lane>>3),ch=lane&7; u32x4 v=*(const u32x4*)(stg+row*64+ch*8);
      if(VAR==1){ const u32x4 g=gl[i];
        #pragma unroll
        for(int j=0;j<4;++j){ const float vl=__uint_as_float(v[j]<<16)*__uint_as_float(g[j]<<16), vh=__uint_as_float(v[j]&0xffff0000u)*__uint_as_float(g[j]&0xffff0000u); v[j]=cvtpk_s(vl,vh); } }
      if(VAR==3){ const int dst=__float_as_int(wsf[64+row]); if(dst>=0)ATTN_STORE16(A.PO+(long)dst*64+ch*8,v); }
      else if(VAR==4){ const float w0=wsf[64+4*row],w1=wsf[65+4*row],w2=wsf[66+4*row],w3=wsf[67+4*row];
        float acc8[8];
        #pragma unroll
        for(int j=0;j<4;++j){ acc8[2*j]=w0*__uint_as_float(v[j]<<16); acc8[2*j+1]=w0*__uint_as_float(v[j]&0xffff0000u); }
        #pragma unroll
        for(int sl=0;sl<3;++sl){ const float ws_=sl==0?w1:sl==1?w2:w3; const u32x4 p=pl[i][sl];
          #pragma unroll
          for(int j=0;j<4;++j){ acc8[2*j]+=ws_!=0.f?ws_*__uint_as_float(p[j]<<16):0.f; acc8[2*j+1]+=ws_!=0.f?ws_*__uint_as_float(p[j]&0xffff0000u):0.f; } }
        #pragma unroll
        for(int j=0;j<4;++j)v[j]=cvtpk_s(acc8[2*j],acc8[2*j+1]);
        ATTN_STORE16(Ow+(long)row*DMO+ch*8,v); }
      else ATTN_STORE16(Ow+(long)row*DMO+ch*8,v);} } }
  asm volatile("s_waitcnt lgkmcnt(0)\n\ts_barrier":::"memory");
  #undef DMA_K
  #undef DMA_V
  #undef CMASK
  #undef START
  #undef RESC
  #undef ROT
}
constexpr int ATTN_LDS_BYTES=LDS_BYTES;
#undef SBAR
#undef WAIT_BAR
}
#define GAS __attribute__((address_space(1)))
#define LAS __attribute__((address_space(3)))
typedef unsigned short bf16;
typedef unsigned v4u __attribute__((ext_vector_type(4)));
typedef float f32x4 __attribute__((ext_vector_type(4)));
typedef short bf16x8 __attribute__((ext_vector_type(8)));
typedef GAS unsigned gu32;
typedef GAS unsigned long long gu64;
#define RLX_AGENT __ATOMIC_RELAXED, __HIP_MEMORY_SCOPE_AGENT
#define LDS_WAIT() asm volatile("s_waitcnt lgkmcnt(0)" ::: "memory")
#define VM_WAIT() asm volatile("s_waitcnt vmcnt(0)" ::: "memory")
__device__ __forceinline__ unsigned long long rt() { return __builtin_amdgcn_s_memrealtime(); }
__device__ __forceinline__ unsigned f2bf(float f) { unsigned u = __builtin_bit_cast(unsigned, f); return (u + 0x7fffu + ((u >> 16) & 1u)) >> 16; }
__device__ __forceinline__ unsigned pk2(float lo, float hi) { return f2bf(lo) | (f2bf(hi) << 16); }

#define XB_TMO      128
#define XB_XCNT(j)  (256  + 64 * (j))
#define XB_XSUB(j)  (1280 + 64 * (j))
#define XB_XGEN(j)  (2304 + 64 * (j))
#define XB_TOP      3328
#define XB_TOPGEN   3392
#define XCD_BAR_WORDS 3456
#define XB_SPIN_CAP (1u << 18)

__device__ __forceinline__ unsigned xb_ld(unsigned* p)              { return __hip_atomic_load(p, __ATOMIC_RELAXED, __HIP_MEMORY_SCOPE_AGENT); }
__device__ __forceinline__ unsigned xb_add(unsigned* p, unsigned v) { return __hip_atomic_fetch_add(p, v, __ATOMIC_RELAXED, __HIP_MEMORY_SCOPE_AGENT); }
__device__ __forceinline__ unsigned xb_xcc_id() { return (unsigned)__builtin_amdgcn_s_getreg((3 << 11) | 20) & 0xFu; }
#define XB_SPIN(cond, bar) do { unsigned _sp = 0; while (cond) { __builtin_amdgcn_s_sleep(1); \
    if ((++_sp & 255u) == 0u) { if (xb_ld(&(bar)[XB_TMO])) break; if (_sp > XB_SPIN_CAP) { atomicAdd(&(bar)[XB_TMO], 1u); break; } } } } while (0)

struct XcdBarrier {
    unsigned* bar; unsigned x;
    volatile LAS unsigned* st;
};

__device__ __forceinline__ XcdBarrier xcd_barrier_post(unsigned* bar, volatile LAS unsigned* st) {
    XcdBarrier b; b.bar = bar; b.x = xb_xcc_id(); b.st = st;
    if (threadIdx.x == 0) (void)xb_add(&bar[XB_XCNT(b.x)], 1u);
    return b;
}
__device__ __forceinline__ void xcd_barrier_complete(unsigned* bar, unsigned x, unsigned& nloc, unsigned& nx) {
    const unsigned G = gridDim.x * gridDim.y * gridDim.z;
    unsigned sum, cnt, mine, sp = 0u;
    for (;;) {
        sum = 0u; cnt = 0u; mine = 0u;
#pragma unroll
        for (unsigned j = 0; j < 16; ++j) { const unsigned c = xb_ld(&bar[XB_XCNT(j)]); sum += c; cnt += (c > 0u) ? 1u : 0u; mine = (j == x) ? c : mine; }
        if (sum == G) break;
        __builtin_amdgcn_s_sleep(1);
        if ((++sp & 255u) == 0u) { if (xb_ld(&bar[XB_TMO])) break; if (sp > XB_SPIN_CAP) { atomicAdd(&bar[XB_TMO], 1u); break; } }
    }
    nloc = mine > 0u ? mine : 1u; nx = cnt > 0u ? cnt : 1u;
}

__device__ __forceinline__ void xcd_barrier(const XcdBarrier& b) {
    asm volatile("s_waitcnt vmcnt(0)" ::: "memory");
    __syncthreads();
    if (threadIdx.x == 0) {
        unsigned* bar = b.bar;
        __builtin_amdgcn_s_waitcnt(0);
        unsigned nloc = b.st[0], nx = b.st[1];
        if (nloc == 0u) { xcd_barrier_complete(bar, b.x, nloc, nx); b.st[0] = nloc; b.st[1] = nx; }
        const unsigned old = xb_add(&bar[XB_XSUB(b.x)], 1u);
        const unsigned gen = old / nloc;
        if (old + 1u == (gen + 1u) * nloc) {
            __builtin_amdgcn_fence(__ATOMIC_RELEASE, "agent");
            asm volatile("s_waitcnt vmcnt(0)" ::: "memory");
            const unsigned og = xb_add(&bar[XB_TOP], 1u);
            const unsigned tg = og / nx;
            if (og + 1u == (tg + 1u) * nx) xb_add(&bar[XB_TOPGEN], 1u);
            else XB_SPIN(xb_ld(&bar[XB_TOPGEN]) == tg, bar);
            __builtin_amdgcn_fence(__ATOMIC_ACQUIRE, "agent");
            xb_add(&bar[XB_XGEN(b.x)], 1u);
            asm volatile("s_waitcnt vmcnt(0)" ::: "memory");
        } else {
            XB_SPIN(xb_ld(&bar[XB_XGEN(b.x)]) == gen, bar);
            __builtin_amdgcn_fence(__ATOMIC_ACQUIRE, "agent");
            asm volatile("s_waitcnt vmcnt(0)" ::: "memory");
        }
    }
    __syncthreads();
}
constexpr int NWAVES = 8;
constexpr int BATCH = 2, SEQ = 8192, DMODEL = 1024, M = BATCH * SEQ;
constexpr int EV_COLS = 3592, EV_N = 3584, OD_N = 1280;
constexpr int NEXP = 16384;
constexpr float L2E = 1.4426950408889634f;
constexpr float RMS_EPS = 1e-6f;

#ifndef MK_N_LAUNCHES
#define MK_N_LAUNCHES 1
#endif
constexpr int N_PHASES = 14;
constexpr int N_LAUNCHES = MK_N_LAUNCHES;

constexpr size_t MiB = 1u << 20;
constexpr size_t WS_CTL = 0, CTL_ZERO_BYTES = 1 * MiB;
constexpr size_t WS_WIN0 = 2 * MiB, WS_WOUT0 = 9 * MiB, WS_WQ0 = 11 * MiB, WS_WIN1 = 13 * MiB, WS_WOUT1 = 16 * MiB, WS_WQ1 = 18 * MiB;
constexpr size_t WS_SK = 20 * MiB;
constexpr size_t WS_ROPE = 21 * MiB;
constexpr size_t WS_RA0 = 22 * MiB, WS_RA1 = 22 * MiB + 65536;
constexpr size_t WS_LF = 23 * MiB;
constexpr size_t WS_FL2 = 24 * MiB;
constexpr size_t WS_KSUM = 25 * MiB;
constexpr size_t WS_SEL = 26 * MiB;
constexpr size_t WS_GAIN = 28 * MiB;
constexpr size_t WS_TSC = 29 * MiB;
constexpr size_t WS_RSP = 27 * MiB;
constexpr size_t WS_XB = 32 * MiB;
constexpr size_t WS_QKV = 64 * MiB;
constexpr size_t WS_AO = 176 * MiB;
constexpr size_t WS_QP = 208 * MiB;
constexpr size_t WS_TAB = 240 * MiB;
constexpr size_t WS_UL = 368 * MiB;
constexpr size_t WS_LIST = 385 * MiB;
constexpr size_t WS_CNT = 389 * MiB;
constexpr size_t WS_LSE = 390 * MiB;
constexpr size_t WS_PO = 392 * MiB;
constexpr size_t WS_END = 440 * MiB;
constexpr int CW_BAR = 4096;

constexpr int RING_BYTES = 131072;
constexpr int LDS_BYTES = 147456;
constexpr int LDSCTL_OFF = LDS_BYTES - 512, MISC_OFF = LDSCTL_OFF + 64;

typedef unsigned v2u __attribute__((ext_vector_type(2)));
typedef __bf16 bf16x2v __attribute__((ext_vector_type(2)));
__device__ __forceinline__ float bflo(unsigned w) { return __uint_as_float(w << 16); }
__device__ __forceinline__ float bfhi(unsigned w) { return __uint_as_float(w & 0xffff0000u); }
__device__ __forceinline__ float dot2bf(unsigned a, unsigned b, float c) { return __builtin_amdgcn_fdot2_f32_bf16(__builtin_bit_cast(bf16x2v, a), __builtin_bit_cast(bf16x2v, b), c, false); }
#define DPPF(x, ctrl) __builtin_bit_cast(float, __builtin_amdgcn_update_dpp(0, __builtin_bit_cast(int, x), ctrl, 0xf, 0xf, false))
#define RDLF(x, l) __builtin_bit_cast(float, __builtin_amdgcn_readlane(__builtin_bit_cast(int, x), l))
__device__ __forceinline__ float wave_sum(float v) {
    v += DPPF(v, 0xB1); v += DPPF(v, 0x4E); v += DPPF(v, 0x124); v += DPPF(v, 0x128);
    return (RDLF(v, 0) + RDLF(v, 16)) + (RDLF(v, 32) + RDLF(v, 48));
}
__device__ __forceinline__ float wave_max(float v) {
    v = fmaxf(v, DPPF(v, 0xB1)); v = fmaxf(v, DPPF(v, 0x4E)); v = fmaxf(v, DPPF(v, 0x124)); v = fmaxf(v, DPPF(v, 0x128));
    return fmaxf(fmaxf(RDLF(v, 0), RDLF(v, 16)), fmaxf(RDLF(v, 32), RDLF(v, 48)));
}

struct Args { const float* in[19]; float* out; unsigned char* ws; int ph_lo, ph_hi, li, pad; };
struct Ctx { unsigned char* lds; int tid, lane, wave, vcu, G; };

__device__ __forceinline__ int perm_src_col(int c) { const int r = c & 255; return (c & ~255) + 64 * ((r >> 5) & 3) + 16 * ((r >> 3) & 3) + 8 * (r >> 7) + (r & 7); }
__device__ __forceinline__ void p0_transpose_item(const float* W, int Nsrc, const float* gain, bool permc, bf16* WT, LAS float* scr, int item, int nblk, int lane) {
    const int kb = item / nblk, nb = item % nblk, k0 = 64 * kb, n0 = 32 * nb;
    const int sc = permc ? perm_src_col(n0 + (lane & 31)) : n0 + (lane & 31);
    const int c = lane & 7;
    f32x4 ga = {1.f, 1.f, 1.f, 1.f}, gb = ga;
    if (gain) { ga = *(const f32x4*)(gain + k0 + 8 * c); gb = *(const f32x4*)(gain + k0 + 8 * c + 4); }
    { const float* wp = W + (size_t)(k0 + (lane >> 5)) * Nsrc + sc; float wv[32];
#pragma unroll
      for (int i = 0; i < 32; ++i) wv[i] = wp[(size_t)(2 * i) * Nsrc];
#pragma unroll
      for (int i = 0; i < 32; ++i) scr[(2 * i + (lane >> 5)) * 33 + (lane & 31)] = wv[i]; }
    LDS_WAIT(); asm volatile("" ::: "memory");
#pragma unroll
    for (int j = 0; j < 4; ++j) { const int n = (lane >> 3) + 8 * j; const LAS float* s = scr + (8 * c) * 33 + n;
        v4u o; o.x = pk2(s[0 * 33] * ga.x, s[1 * 33] * ga.y); o.y = pk2(s[2 * 33] * ga.z, s[3 * 33] * ga.w); o.z = pk2(s[4 * 33] * gb.x, s[5 * 33] * gb.y); o.w = pk2(s[6 * 33] * gb.z, s[7 * 33] * gb.w);
        *(GAS v4u*)(WT + (size_t)(n0 + n) * 1024 + k0 + 8 * c) = o; }
    LDS_WAIT(); asm volatile("" ::: "memory");
}
__device__ __forceinline__ void sincos_d(float af, float& s, float& c) {
    const double a = (double)af, k = __builtin_rint(a * 0.15915494309189535), r = (a - k * 6.283185307179586) - k * 2.4492935982947064e-16, r2 = r * r;
    double ts = 1.0, tc = 1.0, ss = 1.0, cc = 1.0;
#pragma unroll
    for (int i = 1; i <= 13; ++i) { tc *= r2 * (-1.0 / (double)((2 * i - 1) * (2 * i))); ts *= r2 * (-1.0 / (double)((2 * i) * (2 * i + 1))); cc += tc; ss += ts; }
    s = (float)(r * ss); c = (float)cc;
}
#ifndef CONV_L1_LATE
#define CONV_L1_LATE 2
#endif
constexpr int CW_CONV = 2048;
typedef unsigned v6u __attribute__((ext_vector_type(6)));
typedef unsigned v3u __attribute__((ext_vector_type(3)));
struct UB { v4u a4, b4; v2u a2, b2; };
typedef _Float16 h32 __attribute__((ext_vector_type(32)));
__device__ __forceinline__ void conv_rows4_fp6(const Args& a, unsigned char* ws, int layer, int t, int e0, int lane) {
    const int slot = 2 * layer + t; float* tsc = (float*)(ws + WS_TSC);
    const int sub = lane >> 5, blk = (lane >> 4) & 1, li = lane & 15;
    const f32x4* sp = (const f32x4*)(a.in[17 + t] + ((size_t)layer * NEXP + e0 + sub) * 1024 + 512 * blk + 4 * li);
    f32x4 v[2][8];
#pragma unroll
    for (int r2 = 0; r2 < 2; ++r2)
#pragma unroll
        for (int q = 0; q < 8; ++q) v[r2][q] = __builtin_nontemporal_load(sp + r2 * 512 + 16 * q);
#pragma unroll
    for (int r2 = 0; r2 < 2; ++r2) { float mx = 0.f;
#pragma unroll
        for (int q = 0; q < 8; ++q) mx = fmaxf(mx, fmaxf(fmaxf(fabsf(v[r2][q].x), fabsf(v[r2][q].y)), fmaxf(fabsf(v[r2][q].z), fabsf(v[r2][q].w))));
        mx = fmaxf(mx, __shfl_xor(mx, 1)); mx = fmaxf(mx, __shfl_xor(mx, 2)); mx = fmaxf(mx, __shfl_xor(mx, 4)); mx = fmaxf(mx, __shfl_xor(mx, 8)); mx = fmaxf(mx, __shfl_xor(mx, 16));
        const float step = mx > 0.f ? mx * (1.0f / 7.5f) : 1.0f, inv = 1.0f / step;
        h32 hv;
#pragma unroll
        for (int q = 0; q < 8; ++q) { hv[4 * q] = (_Float16)(v[r2][q].x * inv); hv[4 * q + 1] = (_Float16)(v[r2][q].y * inv); hv[4 * q + 2] = (_Float16)(v[r2][q].z * inv); hv[4 * q + 3] = (_Float16)(v[r2][q].w * inv); }
        const v6u pk = __builtin_amdgcn_cvt_scalef32_pk32_fp6_f16(hv, 1.0f);
        unsigned char* op = ws + WS_TAB + (size_t)slot * 32 * MiB + (size_t)(e0 + 2 * r2 + sub) * 768;
        *(v4u*)(op + 256 * blk + 16 * li) = (v4u){pk[0], pk[1], pk[2], pk[3]}; *(v2u*)(op + 512 + 128 * blk + 8 * li) = (v2u){pk[4], pk[5]};
        if ((lane & 31) == 0) tsc[slot * NEXP + e0 + 2 * r2 + sub] = step; }
}
__device__ __forceinline__ void conv_rows4(const Args& a, unsigned char* ws, int layer, int t, int e0, int lane) {
    if (t) { conv_rows4_fp6(a, ws, layer, t, e0, lane); return; }
    const int slot = 2 * layer + t; float* tsc = (float*)(ws + WS_TSC);
    const f32x4* sp = (const f32x4*)(a.in[17 + t] + ((size_t)layer * NEXP + e0) * 1024) + lane;
    f32x4 v[4][4];
#pragma unroll
    for (int r = 0; r < 4; ++r)
#pragma unroll
        for (int j = 0; j < 4; ++j) v[r][j] = __builtin_nontemporal_load(sp + r * 256 + 64 * j);
#pragma unroll
    for (int r = 0; r < 4; ++r) { float mx = 0.f;
#pragma unroll
        for (int j = 0; j < 4; ++j) mx = fmaxf(mx, fmaxf(fmaxf(fabsf(v[r][j].x), fabsf(v[r][j].y)), fmaxf(fabsf(v[r][j].z), fabsf(v[r][j].w))));
        mx = wave_max(mx); const float step = mx > 0.f ? mx * (t ? 1.0f / 240.0f : 1.0f / 127.0f) : 1.0f, inv = 1.0f / step;
        unsigned* op = (unsigned*)(ws + WS_TAB + (size_t)slot * 32 * MiB + (size_t)(e0 + r) * 1024) + lane;
#pragma unroll
        for (int j = 0; j < 4; ++j) {
            if (t) { int w = 0; w = __builtin_amdgcn_cvt_pk_fp8_f32(v[r][j].x * inv, v[r][j].y * inv, w, false); w = __builtin_amdgcn_cvt_pk_fp8_f32(v[r][j].z * inv, v[r][j].w * inv, w, true); op[64 * j] = (unsigned)w; }
            else { const int q0 = (int)rintf(v[r][j].x * inv), q1 = (int)rintf(v[r][j].y * inv), q2 = (int)rintf(v[r][j].z * inv), q3 = (int)rintf(v[r][j].w * inv);
                op[64 * j] = (unsigned)(q0 & 255) | ((unsigned)(q1 & 255) << 8) | ((unsigned)(q2 & 255) << 16) | ((unsigned)(q3 & 255) << 24); } }
        if (lane == 0) tsc[slot * NEXP + e0 + r] = step; }
}
__device__ __forceinline__ void conv_pull(const Args& a, const Ctx& C, int layer) {
    volatile LAS unsigned* box = (volatile LAS unsigned*)(C.lds + LDSCTL_OFF + 256);
    gu32* cnt = (gu32*)(a.ws + WS_CTL) + CW_CONV + 64 * layer;
    for (;;) {
        if (C.tid == 0) box[0] = __hip_atomic_fetch_add(cnt, 1u, RLX_AGENT);
        __syncthreads();
        const unsigned c = box[0];
        __syncthreads();
        if (c >= 512u) break;
        const int t = (int)(c >> 8), e0 = (int)(c & 255u) * 64 + C.wave * 8;
        conv_rows4(a, a.ws, layer, t, e0, C.lane); conv_rows4(a, a.ws, layer, t, e0 + 4, C.lane);
    }
}
__device__ __forceinline__ void p0_prologue(const Args& a, const Ctx& C) {
    unsigned char* ws = a.ws;
    const int gw = C.vcu * NWAVES + C.wave, NGW = C.G * NWAVES, gt = C.vcu * (NWAVES * 64) + C.tid, NGT = C.G * NWAVES * 64;
    const float* x = a.in[0]; const float* an = a.in[1]; const float* fn = a.in[2]; const float* ev_w_in = a.in[3]; const float* fbias = a.in[4];
    LAS float* wf = (LAS float*)(C.lds + 69632);
    for (int i = C.tid; i < 1024; i += NWAVES * 64) { const float g = an[i];
#pragma unroll
        for (int h = 0; h < 8; ++h) wf[h * 1024 + i] = ev_w_in[(size_t)i * EV_COLS + EV_N + h] * g; }
    __syncthreads();
    for (int stage = 0; stage < 2; ++stage) {
      if ((stage ^ (C.wave & 1)) == 0) {
    LAS float* scr = (LAS float*)(C.lds + C.wave * 8704);
    constexpr int I_IN0 = 16 * (EV_N / 32), I_SQ = 16 * 32, I_IN1 = 16 * (OD_N / 32);
    constexpr int NITEMS = I_IN0 + 2 * I_SQ + I_IN1 + 2 * I_SQ;
#ifndef PROBE_TR_REPS
#define PROBE_TR_REPS 1
#endif
    for (int rep_ = 0; rep_ < PROBE_TR_REPS; ++rep_)
    for (int it = gw; it < NITEMS; it += NGW) {
        int r = it;
        if (r < I_IN0) { p0_transpose_item(ev_w_in, EV_COLS, an, true, (bf16*)(ws + WS_WIN0), scr, r, EV_N / 32, C.lane); continue; } r -= I_IN0;
        if (r < I_SQ) { p0_transpose_item(a.in[9], 1024, nullptr, false, (bf16*)(ws + WS_WOUT0), scr, r, 32, C.lane); continue; } r -= I_SQ;
        if (r < I_SQ) { p0_transpose_item(a.in[15], 1024, fn, false, (bf16*)(ws + WS_WQ0), scr, r, 32, C.lane); continue; } r -= I_SQ;
        if (r < I_IN1) { p0_transpose_item(a.in[10], OD_N, an + 1024, true, (bf16*)(ws + WS_WIN1), scr, r, OD_N / 32, C.lane); continue; } r -= I_IN1;
        if (r < I_SQ) { p0_transpose_item(a.in[14], 1024, nullptr, false, (bf16*)(ws + WS_WOUT1), scr, r, 32, C.lane); continue; } r -= I_SQ;
        p0_transpose_item(a.in[15] + (size_t)1024 * 1024, 1024, fn + 1024, false, (bf16*)(ws + WS_WQ1), scr, r, 32, C.lane);
    }
    { bf16* xb = (bf16*)(ws + WS_XB); float* ra0 = (float*)(ws + WS_RA0); float* lf = (float*)(ws + WS_LF);
#ifndef PROBE_ROW_REPS
#define PROBE_ROW_REPS 1
#endif
      for (int rep_ = 0; rep_ < PROBE_ROW_REPS; ++rep_) {
      f32x4 vn[4];
      if (gw < M) { const GAS f32x4* xr0 = (const GAS f32x4*)(x + (size_t)gw * DMODEL) + C.lane;
#pragma unroll
          for (int j = 0; j < 4; ++j) vn[j] = xr0[64 * j]; }
      for (int m = gw; m < M; m += NGW) {
        f32x4 v[4]; float s = 0.f; float fa[8];
#pragma unroll
        for (int j = 0; j < 4; ++j) v[j] = vn[j];
        if (m + NGW < M) { const GAS f32x4* xr1 = (const GAS f32x4*)(x + (size_t)(m + NGW) * DMODEL) + C.lane;
#pragma unroll
            for (int j = 0; j < 4; ++j) vn[j] = xr1[64 * j]; }
#pragma unroll
        for (int h = 0; h < 8; ++h) fa[h] = 0.f;
#pragma unroll
        for (int j = 0; j < 4; ++j) { s += (v[j].x * v[j].x + v[j].y * v[j].y) + (v[j].z * v[j].z + v[j].w * v[j].w);
#pragma unroll
            for (int h = 0; h < 8; ++h) { const f32x4 w = *(const LAS f32x4*)(wf + h * 1024 + 256 * j + 4 * C.lane); fa[h] += (v[j].x * w.x + v[j].y * w.y) + (v[j].z * w.z + v[j].w * w.w); } }
        const float r = 1.0f / sqrtf(wave_sum(s) * (1.0f / DMODEL) + RMS_EPS);
        GAS unsigned long long* o8 = (GAS unsigned long long*)(xb + (size_t)m * DMODEL) + C.lane;
#pragma unroll
        for (int j = 0; j < 4; ++j) o8[64 * j] = (unsigned long long)pk2(v[j].x, v[j].y) | ((unsigned long long)pk2(v[j].z, v[j].w) << 32);
        float mine = 0.f;
#pragma unroll
        for (int h = 0; h < 8; ++h) { const float t = wave_sum(fa[h]); if (C.lane == h) mine = t; }
        if (C.lane < 8) { const float z = r * mine + fbias[C.lane]; lf[(size_t)m * 8 + C.lane] = z >= 0.f ? -log1pf(expf(-z)) : z - log1pf(expf(z)); }
        if (C.lane == 0) ra0[m] = r;
      } } }
      } else {
#ifndef PROBE_CONV_REPS
#define PROBE_CONV_REPS 1
#endif
      for (int rep_ = 0; rep_ < PROBE_CONV_REPS; ++rep_) for (int r4 = gw; r4 < NEXP / CONV_L1_LATE; r4 += NGW) { const int tl = r4 / (NEXP / 4), e0 = (r4 % (NEXP / 4)) * 4; conv_rows4(a, ws, tl >> 1, tl & 1, e0, C.lane); }
      }
    }
    {
      const float* sk = a.in[16];
      for (size_t i = gt; i < (size_t)262144 / 8; i += NGT) { const f32x4 p = *((const f32x4*)sk + 2 * i), q = *((const f32x4*)sk + 2 * i + 1);
            v4u o; o.x = pk2(p.x, p.y); o.y = pk2(p.z, p.w); o.z = pk2(q.x, q.y); o.w = pk2(q.z, q.w); *((v4u*)(ws + WS_SK) + i) = o; } }
    if (gt < 384) { const int g = gt >> 6, d = gt & 63; const float* src = g == 0 ? a.in[5] : g == 1 ? a.in[6] : g == 2 ? a.in[7] : g == 3 ? a.in[8] : g == 4 ? a.in[11] : a.in[12]; ((float*)(ws + WS_GAIN))[gt] = src[d]; }
    { float* cs = (float*)(ws + WS_ROPE);
      for (int i = gt; i < SEQ * 8; i += NGT) { const int pos = i >> 3, f = i & 7; const float inv = powf(500000.0f, -0.125f * (float)f), ang = (float)pos * inv; float s, c; sincos_d(ang, s, c);
          cs[pos * 16 + f] = c; cs[pos * 16 + 8 + f] = s; } }
}

__device__ __forceinline__ void p2_route(const Args& a, const Ctx& C, int rid, int nr) {
    unsigned char* ws = a.ws;
    for (int sq = rid; sq < 16; sq += nr) { const int b = sq >> 3, h = sq & 7; const float* lf = (const float*)(ws + WS_LF); float* fl2 = (float*)(ws + WS_FL2) + (size_t)sq * SEQ;
        LAS double* wtot = (LAS double*)(C.lds + 32768);
        double loc[16]; double run = 0.0;
#pragma unroll
        for (int i = 0; i < 16; ++i) { run += (double)lf[((size_t)b * SEQ + 16 * C.tid + i) * 8 + h]; loc[i] = run; }
        double inc = run;
#pragma unroll
        for (int o = 1; o < 64; o <<= 1) { const double y = __shfl_up(inc, o); if (C.lane >= o) inc += y; }
        if (C.lane == 63) wtot[C.wave] = inc;
        __syncthreads();
        double base = inc - run;
        for (int w = 0; w < C.wave; ++w) base += wtot[w];
#pragma unroll
        for (int i = 0; i < 16; ++i) fl2[16 * C.tid + i] = (float)((base + loc[i]) * 1.4426950408889634);
    }
    __syncthreads();
    for (int u0 = 2 * rid; u0 < 512; u0 += 2 * nr) { const int unit = u0 + (C.tid >> 8), qi = C.tid & 255, half = C.tid >> 8; const int b = unit >> 8, h = (unit >> 5) & 7, qb = unit & 31;
      __syncthreads();
      if (unit < 512) {
        LAS float* km = (LAS float*)(C.lds) + half * 2048;
        const float* ksum = (const float*)(ws + WS_KSUM);
        float k0v[8], k1v[8];
#pragma unroll
        for (int it = 0; it < 8; ++it) { const int i = qi + 256 * it, j = i >> 6, d = i & 63; const size_t p0 = ((size_t)(((b * 32 + j) * 2 + 0) * 8 + h)) * 64 + d, p1 = ((size_t)(((b * 32 + j) * 2 + 1) * 8 + h)) * 64 + d;
            const bool in = i < qb * 64; k0v[it] = in ? ksum[p0] : 0.f; k1v[it] = in ? ksum[p1] : 0.f; }
#pragma unroll
        for (int it = 0; it < 8; ++it) { const int i = qi + 256 * it; if (i < qb * 64) km[i] = (k0v[it] + k1v[it]) * (1.0f / 256.0f); }
      }
      __syncthreads();
      if (unit < 512) {
        const LAS float* km = (const LAS float*)(C.lds) + half * 2048;
        const bf16* qa = (const bf16*)(ws + WS_QKV);
        const v4u* qp = (const v4u*)(qa + ((size_t)b * SEQ + 256 * qb + qi) * 512 + h * 64);
        float q[64];
#pragma unroll
        for (int c = 0; c < 8; ++c) { const v4u w = qp[c];
#pragma unroll
            for (int j = 0; j < 4; ++j) { q[8 * c + 2 * j] = bflo(w[j]); q[8 * c + 2 * j + 1] = bfhi(w[j]); } }
        float v0 = -INFINITY, v1 = -INFINITY, v2 = -INFINITY; int i0 = -1, i1 = -1, i2 = -1;
        for (int j = 0; j < qb; ++j) { float g0 = 0.f, g1 = 0.f, g2 = 0.f, g3 = 0.f;
#pragma unroll
            for (int d = 0; d < 64; d += 4) { const f32x4 k = *(const LAS f32x4*)(km + j * 64 + d); g0 += q[d] * k.x; g1 += q[d + 1] * k.y; g2 += q[d + 2] * k.z; g3 += q[d + 3] * k.w; }
            const float g = (g0 + g1) + (g2 + g3);
            if (g > v0) { v2 = v1; i2 = i1; v1 = v0; i1 = i0; v0 = g; i0 = j; } else if (g > v1) { v2 = v1; i2 = i1; v1 = g; i1 = j; } else if (g > v2) { v2 = g; i2 = j; } }
        unsigned msk = 0u; if (i0 >= 0) msk |= 1u << i0; if (i1 >= 0) msk |= 1u << i1; if (i2 >= 0) msk |= 1u << i2;
        ((unsigned*)(ws + WS_SEL))[((size_t)(b * 8 + h)) * SEQ + 256 * qb + qi] = msk;
      }
    }
}

__device__ __forceinline__ void p3_lists_item(const Args& a, const Ctx& C, int bh, int j) {
    unsigned char* ws = a.ws; LAS unsigned* wc = (LAS unsigned*)(C.lds);
    const unsigned* sel = (const unsigned*)(ws + WS_SEL) + (size_t)bh * SEQ;
    unsigned short* out = (unsigned short*)(ws + WS_LIST) + (size_t)bh * 126976 + (8192 * j - 128 * j * (j + 1));
    unsigned sv[16];
#pragma unroll
    for (int it = 0; it < 16; ++it) { const int q = 256 * (j + 1) + NWAVES * 64 * it + C.tid; sv[it] = q < SEQ ? sel[q] : 0u; }
    unsigned fm = 0u; unsigned short below[16];
#pragma unroll
    for (int it = 0; it < 16; ++it) { const int q = 256 * (j + 1) + NWAVES * 64 * it + C.tid; const bool f = q < SEQ && ((sv[it] >> j) & 1u);
        const unsigned long long m = __ballot(f); below[it] = (unsigned short)__builtin_popcountll(m & ((1ull << C.lane) - 1ull)); fm |= f ? (1u << it) : 0u;
        if (C.lane == 0) wc[it * NWAVES + C.wave] = (unsigned)__builtin_popcountll(m); }
    __syncthreads();
    unsigned base = 0u;
#pragma unroll
    for (int it = 0; it < 16; ++it) { unsigned off = base, tot = 0u;
#pragma unroll
        for (int w = 0; w < NWAVES; ++w) { const unsigned c = wc[it * NWAVES + w]; if (w < C.wave) off += c; tot += c; }
        if ((fm >> it) & 1u) out[off + below[it]] = (unsigned short)(256 * (j + 1) + NWAVES * 64 * it + C.tid);
        base += tot; }
    if (C.tid == 0) ((int*)(ws + WS_CNT))[bh * 32 + j] = (int)base;
    __syncthreads();
}
__device__ __forceinline__ void p3_lists(const Args& a, const Ctx& C) {
    for (int item = C.vcu; item < 16 * 31; item += C.G) p3_lists_item(a, C, item / 31, item % 31);
}

__device__ __forceinline__ void p4_attn_l0a(const Args& a, const Ctx& C) {
    unsigned char* ws = a.ws; const attn_body::bf16* qkv = (const attn_body::bf16*)(ws + WS_QKV); const size_t BUF = (size_t)M * 512;
    char* shm = (char*)C.lds;
    LAS int* upref = (LAS int*)(C.lds + 124928);
    const int* cnt = (const int*)(ws + WS_CNT);
    { int v = 0; if (C.tid < 496) v = (cnt[(C.tid / 31) * 32 + (C.tid % 31)] + 255) >> 8;
      int inc = v;
#pragma unroll
      for (int o = 1; o < 64; o <<= 1) { const int y = __shfl_up(inc, o); if (C.lane >= o) inc += y; }
      LAS int* wtot = (LAS int*)(C.lds + 127232 + 2048);
      if (C.lane == 63) wtot[C.wave] = inc;
      __syncthreads();
      int base = 0;
      for (int w2 = 0; w2 < C.wave; ++w2) base += wtot[w2];
      if (C.tid < 496) upref[C.tid] = base + inc - v;
      if (C.tid == 495) upref[496] = base + inc; }
    __syncthreads();
    const int U = upref[496];
    LAS int* bnd = (LAS int*)(C.lds + 127232);
    if (C.wave == 0) {
        constexpr float CG = 11.0f, CT = 1.3f, CFO = 4.0f;
        const float gq_ = wave_max(fabsf(a.in[7][C.lane])), gk_ = wave_max(fabsf(a.in[8][C.lane]));
        const float bl_ = 2.0f * (64.0f * gq_ * gk_ * attn_body::C2 * 1.02f + 1.0f);
        float cfv[4], s4 = 0.f, f4 = 0.f;
#pragma unroll
        for (int k = 0; k < 4; ++k) { const int c = 4 * C.lane + k; cfv[k] = 0.f;
            if (c < C.G && c < 256) { const int bh = c >> 4, sq = c & 15; const float fend = ((const float*)(ws + WS_FL2))[(size_t)bh * SEQ + SEQ - 1];
                const float slope = fmaxf(-fend * (1.0f / (float)(SEQ - 1)), 1e-6f); const float wtf = (160.0f + bl_) / (slope * 64.0f) + 3.0f; const int wt = wtf < 128.f ? (int)wtf : 128;
                const int ta = 4 * sq + 4 < wt + 4 ? 4 * sq + 4 : wt + 4, tb = 4 * (31 - sq) + 4 < wt + 4 ? 4 * (31 - sq) + 4 : wt + 4;
                cfv[k] = CT * (float)(ta + tb) + 2.0f * CFO; }
            f4 += cfv[k]; }
        const float target = ((float)U * CG + wave_sum(f4)) / (float)C.G;
        float sh[4];
#pragma unroll
        for (int k = 0; k < 4; ++k) { sh[k] = (4 * C.lane + k < C.G) ? fmaxf(0.f, (target - cfv[k]) * (1.0f / CG)) : 0.f; s4 += sh[k]; }
        float inc = s4;
#pragma unroll
        for (int o = 1; o < 64; o <<= 1) { const float y = __shfl_up(inc, o); if (C.lane >= o) inc += y; }
        const float tots = __shfl(inc, 63), scale = tots > 0.f ? (float)U / tots : 0.f;
        float run = inc - s4;
#pragma unroll
        for (int k = 0; k < 4; ++k) { run += sh[k]; int e = (int)(run * scale + 0.5f); e = e < U ? e : U; if (4 * C.lane + k >= C.G - 1) e = U; if (4 * C.lane + k < 256) bnd[4 * C.lane + k] = e; }
    }
    __syncthreads();
    const int u0 = C.vcu ? bnd[C.vcu - 1] : 0, u1 = bnd[C.vcu];
#ifndef PROBE_GREP
#define PROBE_GREP 1
#endif
    for (int grep_ = 0; grep_ < PROBE_GREP; ++grep_)
    for (int u = u0; u < u1; ++u) {
        int lo = 0, hi = 496;
        while (hi - lo > 1) { const int mid = (lo + hi) >> 1; if (upref[mid] <= u) lo = mid; else hi = mid; }
        const int item = lo, c = u - upref[lo], bh = item / 31, j = item % 31, b = bh >> 3, h = bh & 7, n = cnt[bh * 32 + j] - 256 * c;
        attn_body::UnitArgs um; um.Q = qkv; um.K = qkv + BUF; um.V = qkv + 2 * BUF; um.O = nullptr; um.qcol = h * 64; um.kcol = h * 64; um.ocol = 0;
        um.Fl2 = nullptr; um.gate = nullptr; um.sel = (const unsigned*)(ws + WS_SEL) + (size_t)bh * SEQ; um.sinkp = nullptr; um.bl2x2 = 0.f;
        um.glist = (const unsigned short*)(ws + WS_LIST) + (size_t)bh * 126976 + (8192 * j - 128 * j * (j + 1)) + 256 * c; um.gn = n < 256 ? n : 256;
        um.PO = (attn_body::bf16*)(ws + WS_PO) + (size_t)bh * SEQ * 192; um.LSE = (float*)(ws + WS_LSE) + (size_t)bh * SEQ * 3;
        um.kvres = (u > u0 && c > 0) ? 1 : 0;
        attn_body::attn_unit<3, 8, 512, 512, 1024>(b, j, um, shm);
    }
    { const int bh = C.vcu >> 4, s = C.vcu & 15, b = bh >> 3, h = bh & 7;
      const float gq = wave_max(fabsf(a.in[7][C.lane])), gk = wave_max(fabsf(a.in[8][C.lane]));
      const float bl2x2 = 2.0f * (64.0f * gq * gk * attn_body::C2 * 1.02f + 1.0f);
      attn_body::UnitArgs uf; uf.Q = qkv + 3 * BUF; uf.K = qkv + 4 * BUF; uf.V = qkv + 5 * BUF; uf.O = (attn_body::bf16*)(ws + WS_AO); uf.qcol = h * 64; uf.kcol = h * 64; uf.ocol = 512 + h * 64;
      uf.Fl2 = (const float*)(ws + WS_FL2) + (size_t)bh * SEQ; uf.gate = qkv + 6 * BUF + h * 64; uf.sel = nullptr; uf.sinkp = nullptr; uf.bl2x2 = bl2x2;
      uf.glist = nullptr; uf.gn = 0; uf.PO = nullptr; uf.LSE = nullptr; uf.kvres = 0;
      if (C.vcu < 256)
#ifndef PROBE_FREP
#define PROBE_FREP 1
#endif
          for (int i = 0; i < 2 * PROBE_FREP; ++i) attn_body::attn_unit<1, 8, 512, 512, 1024>(b, (i & 1) ? s : 31 - s, uf, shm); }
}
__device__ __forceinline__ void p5_attn_l0b(const Args& a, const Ctx& C) {
    unsigned char* ws = a.ws; const attn_body::bf16* qkv = (const attn_body::bf16*)(ws + WS_QKV); const size_t BUF = (size_t)M * 512;
    for (int pmb = C.vcu >> 2; pmb < M / 256; pmb += C.G >> 2)
    for (int i = 0; i < 2; ++i) {
    const int b = pmb >> 5, qbk = pmb & 31, h = (C.vcu & 3) * 2 + i, bh = b * 8 + h;
    attn_body::UnitArgs um; um.Q = qkv; um.K = qkv + BUF; um.V = qkv + 2 * BUF; um.O = (attn_body::bf16*)(ws + WS_AO); um.qcol = h * 64; um.kcol = h * 64; um.ocol = h * 64;
    um.Fl2 = nullptr; um.gate = nullptr; um.sel = (const unsigned*)(ws + WS_SEL) + (size_t)bh * SEQ; um.sinkp = nullptr; um.bl2x2 = 0.f;
    um.glist = nullptr; um.gn = 0; um.PO = (attn_body::bf16*)(ws + WS_PO) + (size_t)bh * SEQ * 192; um.LSE = (float*)(ws + WS_LSE) + (size_t)bh * SEQ * 3; um.kvres = 0;
    char* shm = (char*)C.lds;
    attn_body::attn_unit<4, 8, 512, 512, 1024>(b, qbk, um, shm); }
}
__device__ __forceinline__ void p8_attn_l1(const Args& a, const Ctx& C) {
    unsigned char* ws = a.ws;
    char* shm = (char*)C.lds;
    for (int pmb = C.vcu >> 2; pmb < M / 256; pmb += C.G >> 2)
    for (int i = 0; i < 4; ++i) {
    const int b = pmb >> 5, qbk = pmb & 31, hq = (C.vcu & 3) * 4 + i;
    attn_body::UnitArgs u; u.Q = (const attn_body::bf16*)(ws + WS_QKV); u.K = (const attn_body::bf16*)(ws + WS_QKV + 32 * MiB); u.V = (const attn_body::bf16*)(ws + WS_QKV + 36 * MiB); u.O = (attn_body::bf16*)(ws + WS_AO);
    u.qcol = hq * 64; u.kcol = (hq >> 3) * 64; u.ocol = hq * 64; u.Fl2 = nullptr; u.gate = nullptr; u.sel = nullptr; u.sinkp = a.in[13] + hq; u.bl2x2 = 0.f; u.glist = nullptr; u.gn = 0; u.PO = nullptr; u.LSE = nullptr; u.kvres = 0;
    u.kvres = i > 0 ? 1 : 0;
    attn_body::attn_unit<2, 8, 1024, 128, 1024>(b, qbk, u, shm); }
}

constexpr int SC_LD = 129;
constexpr int PL_TOPIDX = 256 * SC_LD * 4;
constexpr int PL_ALDS = PL_TOPIDX + 4096;
constexpr int PL_END = PL_ALDS + 4096;
static_assert(PL_END <= LDSCTL_OFF, "PEER LDS map");
__device__ __forceinline__ float gelu_erf(float v) { return 0.5f * v * (1.0f + erff(v * 0.70710678118654752f)); }

__device__ const unsigned char PEER_CAND[52] = {0,1,2,3,4,5,6,7,8,9,10,11,12,13,14,15,16,17,18,19,20,21,22,23,32,33,34,35,36,48,49,50,51,64,65,66,80,81,96,97,112,113,128,144,160,176,192,208,224,240,255,255};
template <int XM> __device__ __forceinline__ void merge16(float (&L)[16]) {
    float R[16];
#pragma unroll
    for (int i = 0; i < 16; ++i) R[i] = __shfl_xor(L[15 - i], XM);
#pragma unroll
    for (int i = 0; i < 16; ++i) L[i] = fmaxf(L[i], R[i]);
#pragma unroll
    for (int d = 8; d >= 1; d >>= 1)
#pragma unroll
        for (int i = 0; i < 16; ++i) if ((i & d) == 0) { const float hi = fmaxf(L[i], L[i + d]), lo = fminf(L[i], L[i + d]); L[i] = hi; L[i + d] = lo; }
}
constexpr int PL_SEQ = 32768, PL_HIST = 98304, PL_AL = 102400;
template <bool LAST> __device__ __forceinline__ void peer_phase(const Args& a, const Ctx& C, int layer) {
    unsigned char* ws = a.ws;
    const bf16* qp = (const bf16*)(ws + WS_QP);
    const bf16* skb = (const bf16*)(ws + WS_SK) + (size_t)layer * 131072;
    const unsigned char* Dt = ws + WS_TAB + (size_t)(2 * layer) * 32 * MiB;
    const unsigned char* Ut = ws + WS_TAB + (size_t)(2 * layer + 1) * 32 * MiB;
    const float* tsc = (const float*)(ws + WS_TSC) + (size_t)(2 * layer) * NEXP;
    const float* rsp = (const float*)(ws + WS_RSP);
    const float* gffn = a.in[2] + layer * 1024;
    float* xio = a.out;
    v2u* UL = (v2u*)(ws + WS_UL);
    LAS float* sc = (LAS float*)C.lds;
    LAS unsigned char* topidx = (LAS unsigned char*)(C.lds + PL_TOPIDX);
    const int w = C.wave;
    LAS unsigned char* candl = (LAS unsigned char*)(C.lds + PL_TOPIDX + 4096);
    if (C.tid < 52) candl[C.tid] = PEER_CAND[C.tid];
    __syncthreads();
    for (int grp = C.vcu; grp < M / 64; grp += C.G) {
#ifndef PROBE_ROUTE_REPS
#define PROBE_ROUTE_REPS 1
#endif
      bf16x8 kf0[2][8], kf1[2][8];
      { int tk_ = C.tid; asm volatile("" : "+v"(tk_)); const int lane0 = tk_ & 63, l15k = lane0 & 15, lgk = lane0 >> 4;
#pragma unroll
        for (int p = 0; p < 2; ++p) { const bf16* kb = skb + ((size_t)(w * 2 + p) * 128 + l15k) * 64 + 8 * lgk;
#pragma unroll
            for (int nt = 0; nt < 8; ++nt) { kf0[p][nt] = *(const bf16x8*)(kb + (size_t)nt * 16 * 64); kf1[p][nt] = *(const bf16x8*)(kb + (size_t)nt * 16 * 64 + 32); } } }
      for (int tl_ = 0; tl_ < 4 * PROBE_ROUTE_REPS; ++tl_) { const int tl = tl_ & 3;
        const int tok0 = grp * 64 + tl * 16;
        int tid_ = C.tid; asm volatile("" : "+v"(tid_));
        const int tid = tid_, lane = tid & 63, l15 = lane & 15, lg = lane >> 4;
#ifndef PROBE_RA
#define PROBE_RA 1
#define PROBE_RB 1
#define PROBE_RC 1
#endif
        for (int ra_ = 0; ra_ < PROBE_RA; ++ra_) {
            typedef float f32x4v __attribute__((ext_vector_type(4)));
#pragma unroll
            for (int p = 0; p < 2; ++p) {
                const bf16* qrow = qp + (size_t)(tok0 + l15) * 1024 + 128 * w + 64 * p + 8 * lg;
                const bf16x8 a0 = *(const bf16x8*)(qrow), a1 = *(const bf16x8*)(qrow + 32);
#pragma unroll
                for (int nt = 0; nt < 8; ++nt) {
                    const bf16x8 b0 = kf0[p][nt], b1 = kf1[p][nt];
                    f32x4v acc = {0.f, 0.f, 0.f, 0.f};
                    acc = __builtin_amdgcn_mfma_f32_16x16x32_bf16(a0, b0, acc, 0, 0, 0);
                    acc = __builtin_amdgcn_mfma_f32_16x16x32_bf16(a1, b1, acc, 0, 0, 0);
#pragma unroll
                    for (int r = 0; r < 4; ++r) sc[((w * 2 + p) * 16 + 4 * lg + r) * SC_LD + 16 * nt + l15] = acc[r];
                }
            }
        }
        LDS_WAIT(); asm volatile("" ::: "memory");
        for (int rb_ = 0; rb_ < PROBE_RB; ++rb_) { const int prob = lane >> 1, kh = lane & 1, P = w * 32 + prob;
            const LAS float* row = sc + P * SC_LD + 64 * kh;
            float L[16];
#pragma unroll
            for (int i = 0; i < 16; ++i) L[i] = -INFINITY;
            for (int k0 = 0; k0 < 64; k0 += 8) {
#pragma unroll
                for (int kk = 0; kk < 8; ++kk) { const int k = k0 + kk;
                    const float v = __uint_as_float((__float_as_uint(row[k]) & 0xffffff80u) | (unsigned)(127 - (64 * kh + k)));
#pragma unroll
                    for (int i = 15; i >= 1; --i) L[i] = __builtin_amdgcn_fmed3f(L[i - 1], v, L[i]);
                    L[0] = fmaxf(L[0], v); }
            }
            merge16<1>(L);
            if (kh == 0) { unsigned pk[4];
#pragma unroll
                for (int i = 0; i < 4; ++i) pk[i] = (127u - (__float_as_uint(L[4 * i]) & 127u)) | ((127u - (__float_as_uint(L[4 * i + 1]) & 127u)) << 8) | ((127u - (__float_as_uint(L[4 * i + 2]) & 127u)) << 16) | ((127u - (__float_as_uint(L[4 * i + 3]) & 127u)) << 24);
                *(LAS v4u*)(topidx + P * 16) = (v4u){pk[0], pk[1], pk[2], pk[3]}; }
        }
        LDS_WAIT(); asm volatile("" ::: "memory");
        for (int rc_ = 0; rc_ < PROBE_RC; ++rc_) {
            const int token = lane >> 2, sub = lane & 3, P1 = (w * 2) * 16 + token, P2 = P1 + 16;
            float L[16];
#pragma unroll
            for (int i = 0; i < 16; ++i) L[i] = -INFINITY;
#pragma unroll
            for (int n = 0; n < 13; ++n) { const unsigned code = candl[4 * n + sub]; const unsigned aa = (code >> 4) & 15u, bb = code & 15u;
                const unsigned k1 = topidx[P1 * 16 + aa], k2 = topidx[P2 * 16 + bb];
                const float sm = sc[P1 * SC_LD + k1] + sc[P2 * SC_LD + k2];
                const float v = code == 255u ? -INFINITY : __uint_as_float((__float_as_uint(sm) & 0xffffff00u) | (255u - code));
#pragma unroll
                for (int i = 15; i >= 1; --i) L[i] = __builtin_amdgcn_fmed3f(L[i - 1], v, L[i]);
                L[0] = fmaxf(L[0], v); }
            merge16<1>(L); merge16<2>(L);
            float ts[4]; unsigned myidx[4]; float mx = -INFINITY;
#pragma unroll
            for (int j = 0; j < 4; ++j) { const float lv = sub == 0 ? L[j] : sub == 1 ? L[4 + j] : sub == 2 ? L[8 + j] : L[12 + j];
                const unsigned code = 255u - (__float_as_uint(lv) & 255u), aa = code >> 4, bb = code & 15u;
                const unsigned k1 = topidx[P1 * 16 + aa], k2 = topidx[P2 * 16 + bb];
                ts[j] = sc[P1 * SC_LD + k1] + sc[P2 * SC_LD + k2]; myidx[j] = k1 * 128u + k2; mx = fmaxf(mx, ts[j]); }
            mx = fmaxf(mx, __shfl_xor(mx, 1)); mx = fmaxf(mx, __shfl_xor(mx, 2));
            float sum = 0.f;
#pragma unroll
            for (int j = 0; j < 4; ++j) { ts[j] = __expf(ts[j] - mx); sum += ts[j]; }
            sum += __shfl_xor(sum, 1); sum += __shfl_xor(sum, 2);
            const float inv = 1.0f / sum;
#pragma unroll
            for (int j = 0; j < 4; ++j) UL[(size_t)(tok0 + token) * 128 + w * 16 + 4 * sub + j] = (v2u){myidx[j], __float_as_uint(ts[j] * inv)};
        }
        LDS_WAIT(); asm volatile("" ::: "memory");
      }
      __syncthreads();
#define SW_LOAD(buf, T, sq_, i) do { const unsigned e_ = sq_[128 * g + (i)].x; const unsigned char* rp_ = (T) + (size_t)e_ * 1024 + 16 * li; \
            _Pragma("unroll") for (int c = 0; c < 4; ++c) buf[c] = *(const v4u*)(rp_ + 256 * c); } while (0)
      {
        int ln_ = C.tid; asm volatile("" : "+v"(ln_)); const int lane = ln_ & 63, g = lane >> 4, li = lane & 15;
        LAS v2u* seq0 = (LAS v2u*)(C.lds + PL_SEQ) + (w * 2 + 0) * 512;
        LAS v2u* seq1 = (LAS v2u*)(C.lds + PL_SEQ) + (w * 2 + 1) * 512;
        LAS unsigned* hist = (LAS unsigned*)(C.lds + PL_HIST) + w * 128;
        LAS int* al0 = (LAS int*)(C.lds + PL_AL) + (w * 2 + 0) * 512;
        LAS int* al1 = (LAS int*)(C.lds + PL_AL) + (w * 2 + 1) * 512;
        v4u xq[2][4]; float sxp[2];
#pragma unroll 1
        for (int pass = 0; pass < 2; ++pass) { v4u xqt[4]; float sxt;
          const int tokb = grp * 64 + 32 * pass + 4 * w, row = tokb + g;
          LAS v2u* seq = pass ? seq1 : seq0;
          hist[lane] = 0u; hist[64 + lane] = 0u;
          const float* xr = xio + (size_t)row * 1024 + 16 * li;
          { float rn; { const f32x4 ra = *(const f32x4*)(rsp + (size_t)row * 16), rb = *(const f32x4*)(rsp + (size_t)row * 16 + 4), rc = *(const f32x4*)(rsp + (size_t)row * 16 + 8), rd = *(const f32x4*)(rsp + (size_t)row * 16 + 12);
                const float ss = ((ra[0] + ra[1]) + (ra[2] + ra[3])) + ((rb[0] + rb[1]) + (rb[2] + rb[3])) + ((rc[0] + rc[1]) + (rc[2] + rc[3])) + ((rd[0] + rd[1]) + (rd[2] + rd[3]));
                rn = 1.0f / sqrtf(ss * (1.0f / 1024.0f) + RMS_EPS); }
            f32x4 n[4][4]; float mx = 0.f;
#pragma unroll
            for (int c = 0; c < 4; ++c)
#pragma unroll
                for (int j = 0; j < 4; ++j) { n[c][j] = *(const f32x4*)(xr + 256 * c + 4 * j) * rn * *(const f32x4*)(gffn + 256 * c + 16 * li + 4 * j);
                    mx = fmaxf(mx, fmaxf(fmaxf(fabsf(n[c][j].x), fabsf(n[c][j].y)), fmaxf(fabsf(n[c][j].z), fabsf(n[c][j].w)))); }
            mx = fmaxf(mx, __shfl_xor(mx, 8)); mx = fmaxf(mx, __shfl_xor(mx, 4)); mx = fmaxf(mx, __shfl_xor(mx, 2)); mx = fmaxf(mx, __shfl_xor(mx, 1));
            const float sx = mx > 0.f ? mx * (1.0f / 127.0f) : 1.0f, inv = 1.0f / sx; sxt = sx;
#pragma unroll
            for (int c = 0; c < 4; ++c)
#pragma unroll
                for (int j = 0; j < 4; ++j) { const int q0 = (int)rintf(n[c][j].x * inv), q1 = (int)rintf(n[c][j].y * inv), q2 = (int)rintf(n[c][j].z * inv), q3 = (int)rintf(n[c][j].w * inv);
                    xqt[c][j] = (unsigned)(q0 & 255) | ((unsigned)(q1 & 255) << 8) | ((unsigned)(q2 & 255) << 16) | ((unsigned)(q3 & 255) << 24); } }
          if (pass == 0) { sxp[0] = sxt;
#pragma unroll
              for (int c = 0; c < 4; ++c) xq[0][c] = xqt[c]; }
          else { sxp[1] = sxt;
#pragma unroll
              for (int c = 0; c < 4; ++c) xq[1][c] = xqt[c]; }
          { unsigned pe[8], pgb[8], prank[8];
            LDS_WAIT();
#pragma unroll
            for (int s8 = 0; s8 < 8; ++s8) { const v2u u = UL[(size_t)(tokb + (s8 >> 1)) * 128 + 64 * (s8 & 1) + lane]; pe[s8] = u.x; pgb[s8] = u.y;
                prank[s8] = __hip_atomic_fetch_add(hist + 32 * (s8 >> 1) + ((u.x >> 9) & 31u), 1u, __ATOMIC_RELAXED, __HIP_MEMORY_SCOPE_WAVEFRONT); }
            LDS_WAIT();
            unsigned c0 = hist[lane], c1 = hist[64 + lane], i0 = c0, i1 = c1;
#pragma unroll
            for (int o = 1; o < 32; o <<= 1) { const unsigned y0 = __shfl_up(i0, o), y1 = __shfl_up(i1, o); if ((lane & 31) >= o) { i0 += y0; i1 += y1; } }
            LDS_WAIT();
            hist[lane] = i0 - c0; hist[64 + lane] = i1 - c1;
            LDS_WAIT();
#pragma unroll
            for (int s8 = 0; s8 < 8; ++s8) seq[128 * (s8 >> 1) + hist[32 * (s8 >> 1) + ((pe[s8] >> 9) & 31u)] + prank[s8]] = (v2u){pe[s8], pgb[s8]};
            LDS_WAIT(); }
        }
#define SW_DOWN(buf, xqp, alp, i) do { int sacc = 0; _Pragma("unroll") for (int c = 0; c < 4; ++c) { sacc = __builtin_amdgcn_sdot4((int)buf[c].x, (int)xqp[c].x, sacc, false); sacc = __builtin_amdgcn_sdot4((int)buf[c].y, (int)xqp[c].y, sacc, false); \
                sacc = __builtin_amdgcn_sdot4((int)buf[c].z, (int)xqp[c].z, sacc, false); sacc = __builtin_amdgcn_sdot4((int)buf[c].w, (int)xqp[c].w, sacc, false); } \
            sacc += __shfl_xor(sacc, 8); sacc += __shfl_xor(sacc, 4); sacc += __shfl_xor(sacc, 2); sacc += __shfl_xor(sacc, 1); \
            if (li == 0) alp[128 * g + (i)] = sacc; } while (0)
        {
#define DLD(buf, k, par) do { if ((k) < 256) { if (par) SW_LOAD(buf, Dt, seq1, (k) >> 1); else SW_LOAD(buf, Dt, seq0, (k) >> 1); } } while (0)
#define DCP(buf, k, par) do { if ((k) < 256) { if (par) SW_DOWN(buf, xq[1], al1, (k) >> 1); else SW_DOWN(buf, xq[0], al0, (k) >> 1); } } while (0)
v4u b0[4], b1[4], b2[4], b3[4], b4[4];
          DLD(b0, 0, 0); DLD(b1, 1, 1); DLD(b2, 2, 0); DLD(b3, 3, 1);
#pragma unroll 1
          for (int kb = 0; kb < 256; kb += 10) {
              DLD(b4, kb + 4, 0); DCP(b0, kb + 0, 0);
              DLD(b0, kb + 5, 1); DCP(b1, kb + 1, 1);
              DLD(b1, kb + 6, 0); DCP(b2, kb + 2, 0);
              DLD(b2, kb + 7, 1); DCP(b3, kb + 3, 1);
              DLD(b3, kb + 8, 0); DCP(b4, kb + 4, 0);
              DLD(b4, kb + 9, 1); DCP(b0, kb + 5, 1);
              DLD(b0, kb + 10, 0); DCP(b1, kb + 6, 0);
              DLD(b1, kb + 11, 1); DCP(b2, kb + 7, 1);
              DLD(b2, kb + 12, 0); DCP(b3, kb + 8, 0);
              DLD(b3, kb + 13, 1); DCP(b4, kb + 9, 1);
          }
#undef DLD
#undef DCP
        }
#undef SW_DOWN
        LDS_WAIT();
        float tsinv[2];
#pragma unroll
        for (int pass = 0; pass < 2; ++pass) { LAS int* al = pass ? al1 : al0; LAS float* cl = (LAS float*)al; LAS v2u* seq = pass ? seq1 : seq0; const float sx = sxp[pass];
          const float sx0 = __uint_as_float(__builtin_amdgcn_readlane(__float_as_uint(sx), 0)), sx1 = __uint_as_float(__builtin_amdgcn_readlane(__float_as_uint(sx), 16)),
                      sx2 = __uint_as_float(__builtin_amdgcn_readlane(__float_as_uint(sx), 32)), sx3 = __uint_as_float(__builtin_amdgcn_readlane(__float_as_uint(sx), 48));
          float cv[8];
#pragma unroll
          for (int s8 = 0; s8 < 8; ++s8) { const int idx = 64 * s8 + lane; const v2u ent = seq[idx]; const unsigned ee = ent.x;
              const float sd = tsc[ee], su = tsc[NEXP + ee]; const float sxl = (s8 >> 1) == 0 ? sx0 : (s8 >> 1) == 1 ? sx1 : (s8 >> 1) == 2 ? sx2 : sx3;
              const float av = (float)al[idx]; cv[s8] = __uint_as_float(ent.y) * su * gelu_erf(av * (sd * sxl)); }
          float tsl = 1.f;
#pragma unroll
          for (int t4 = 0; t4 < 4; ++t4) { const float m = wave_max(fmaxf(fabsf(cv[2 * t4]), fabsf(cv[2 * t4 + 1])));
              const float sc = m > 0.f ? exp2f(-ceilf(log2f(m))) : 1.f;
              cl[128 * t4 + lane] = cv[2 * t4] * sc; cl[128 * t4 + 64 + lane] = cv[2 * t4 + 1] * sc; if (g == t4) tsl = sc; }
          tsinv[pass] = 1.0f / tsl; }
        LDS_WAIT();
        { const LAS float* cl0 = (const LAS float*)al0; const LAS float* cl1 = (const LAS float*)al1;
          typedef _Float16 h2 __attribute__((ext_vector_type(2)));
          h2 acc0[2][16], acc1[2][16];
#pragma unroll
          for (int c = 0; c < 2; ++c)
#pragma unroll
              for (int i = 0; i < 16; ++i) { acc0[c][i] = (h2){(_Float16)0.f, (_Float16)0.f}; acc1[c][i] = (h2){(_Float16)0.f, (_Float16)0.f}; }
#define SW_LOADU(buf, sq_, i) do { const unsigned e_ = sq_[128 * g + (i)].x; const unsigned char* rp_ = Ut + (size_t)e_ * 768; \
            buf[0].a4 = *(const v4u*)(rp_ + 16 * li); buf[0].b4 = *(const v4u*)(rp_ + 256 + 16 * li); buf[0].a2 = *(const v2u*)(rp_ + 512 + 8 * li); buf[0].b2 = *(const v2u*)(rp_ + 640 + 8 * li); } while (0)
#define SW_UP(buf, accp, clp, i) do { const _Float16 ch_ = (_Float16)clp[128 * g + (i)]; const h2 cc_ = {ch_, ch_}; \
            _Pragma("unroll") for (int c = 0; c < 2; ++c) { const v6u s6_ = c ? (v6u){buf[0].b4.x, buf[0].b4.y, buf[0].b4.z, buf[0].b4.w, buf[0].b2.x, buf[0].b2.y} : (v6u){buf[0].a4.x, buf[0].a4.y, buf[0].a4.z, buf[0].a4.w, buf[0].a2.x, buf[0].a2.y}; \
                const h32 r_ = __builtin_amdgcn_cvt_scalef32_pk32_f16_fp6(s6_, 1.0f); \
                _Pragma("unroll") for (int q = 0; q < 16; ++q) { const h2 t_ = {r_[2 * q], r_[2 * q + 1]}; accp[c][q] = t_ * cc_ + accp[c][q]; } \
                asm volatile("" : "+v"(accp[c][0]), "+v"(accp[c][1]), "+v"(accp[c][2]), "+v"(accp[c][3]), "+v"(accp[c][4]), "+v"(accp[c][5]), "+v"(accp[c][6]), "+v"(accp[c][7]), \
                                  "+v"(accp[c][8]), "+v"(accp[c][9]), "+v"(accp[c][10]), "+v"(accp[c][11]), "+v"(accp[c][12]), "+v"(accp[c][13]), "+v"(accp[c][14]), "+v"(accp[c][15])); } } while (0)
          {
#define ULD(buf, k, par) do { if ((k) < 256) { if (par) SW_LOADU(buf, seq1, (k) >> 1); else SW_LOADU(buf, seq0, (k) >> 1); } } while (0)
#define UCP(buf, k, par) do { if ((k) < 256) { if (par) SW_UP(buf, acc1, cl1, (k) >> 1); else SW_UP(buf, acc0, cl0, (k) >> 1); } } while (0)
UB b0[4], b1[4], b2[4], b3[4], b4[4], b5[4], b6[4], b7[4];
          ULD(b0, 0, 0); ULD(b1, 1, 1); ULD(b2, 2, 0); ULD(b3, 3, 1); ULD(b4, 4, 0); ULD(b5, 5, 1); ULD(b6, 6, 0);
#pragma unroll 1
          for (int kb = 0; kb < 256; kb += 8) {
              ULD(b7, kb + 7, 1); UCP(b0, kb + 0, 0);
              ULD(b0, kb + 8, 0); UCP(b1, kb + 1, 1);
              ULD(b1, kb + 9, 1); UCP(b2, kb + 2, 0);
              ULD(b2, kb + 10, 0); UCP(b3, kb + 3, 1);
              ULD(b3, kb + 11, 1); UCP(b4, kb + 4, 0);
              ULD(b4, kb + 12, 0); UCP(b5, kb + 5, 1);
              ULD(b5, kb + 13, 1); UCP(b6, kb + 6, 0);
              ULD(b6, kb + 14, 0); UCP(b7, kb + 7, 1);
          }
#undef ULD
#undef UCP
          }
#undef SW_UP
#undef SW_LOADU
#define SW_OUT(accp, pass) do { const int row = grp * 64 + 32 * (pass) + 4 * w + g; float* xr = xio + (size_t)row * 1024 + 4 * li; float ss = 0.f; const float ti_ = tsinv[pass]; \
            _Pragma("unroll") for (int c = 0; c < 2; ++c) { \
                _Pragma("unroll") for (int q = 0; q < 8; ++q) { float* xp_ = xr + 512 * c + 64 * q; \
                    const f32x4 y = *(const f32x4*)xp_ + (f32x4){(float)accp[c][2 * q].x, (float)accp[c][2 * q].y, (float)accp[c][2 * q + 1].x, (float)accp[c][2 * q + 1].y} * ti_; *(f32x4*)xp_ = y; \
                    ss += (y.x * y.x + y.y * y.y) + (y.z * y.z + y.w * y.w); \
                    if (!LAST) { bf16* xb = (bf16*)(ws + WS_XB) + (size_t)row * 1024 + 512 * c + 64 * q + 4 * li; *(v2u*)xb = (v2u){pk2(y.x, y.y), pk2(y.z, y.w)}; } } } \
            if (!LAST) { ss += __shfl_xor(ss, 8); ss += __shfl_xor(ss, 4); ss += __shfl_xor(ss, 2); ss += __shfl_xor(ss, 1); \
                if (li == 0) ((float*)(ws + WS_RA1))[row] = 1.0f / sqrtf(ss * (1.0f / 1024.0f) + RMS_EPS); } } while (0)
          SW_OUT(acc0, 0); SW_OUT(acc1, 1);
#undef SW_OUT
        }
      }
#undef SW_LOAD
      __syncthreads();
    }
}

constexpr int CW_GRP = 8192, CW_XID = 16384;
struct GroupOrder {
    int nN, c, G4, nM;
    __device__ bool next(int i, pg8::Unit& u) const {
        const bool five = nN == 5 && (c & 3) == 0; const int j = five ? (i >> 1) : i, pm = (c >> 2) + j * G4; if (pm >= nM) return false;
        u.pm = pm; u.pn = (five && (i & 1)) ? 4 : (c & 3); return true; }
    __device__ __forceinline__ void a_ready(const pg8::Unit&) const {}
    __device__ __forceinline__ void done(const pg8::Unit&) const {}
};
__device__ __forceinline__ void sub_barrier(gu32* ctl, int cword, unsigned target, volatile LAS unsigned* same_xcd) {
    asm volatile("s_waitcnt vmcnt(0)" ::: "memory");
    __syncthreads();
    if (threadIdx.x == 0) {
        unsigned* cnt = (unsigned*)ctl + cword; unsigned* bar = (unsigned*)ctl + CW_BAR;
        if (same_xcd[0] != 1u) { __builtin_amdgcn_fence(__ATOMIC_RELEASE, "agent"); asm volatile("s_waitcnt vmcnt(0)" ::: "memory"); }
        (void)xb_add(cnt, 1u);
        XB_SPIN(xb_ld(cnt) < target, bar);
        __builtin_amdgcn_fence(__ATOMIC_ACQUIRE, "agent");
        asm volatile("s_waitcnt vmcnt(0)" ::: "memory");
    }
    __syncthreads();
}

__device__ __forceinline__ void grp_barrier(gu32* ctl, int vcu, unsigned target, volatile LAS unsigned* same_xcd) { sub_barrier(ctl, CW_GRP + 64 * (vcu >> 2), target, same_xcd); }
constexpr int CW_GRP16 = 12288;
struct PairOrder { int c; __device__ bool next(int i, pg8::Unit& u) const { if (i) return false; u.pm = c >> 1; u.pn = c & 1; return true; }
    __device__ __forceinline__ void a_ready(const pg8::Unit&) const {} __device__ __forceinline__ void done(const pg8::Unit&) const {} };

__global__ void __launch_bounds__(NWAVES * 64, 2) mk_fwd(Args args) {
    extern __shared__ __attribute__((aligned(16))) unsigned char lds[];
    Ctx C; C.lds = lds; C.tid = threadIdx.x; C.lane = C.tid & 63; C.wave = __builtin_amdgcn_readfirstlane(C.tid >> 6);
    C.G = gridDim.x; { const int bx = blockIdx.x; C.vcu = (C.G % 8 == 0) ? (bx % 8) * (C.G / 8) + bx / 8 : bx; }
    LAS unsigned char* lds3 = (LAS unsigned char*)lds;
    volatile LAS unsigned* MISC = (volatile LAS unsigned*)(lds3 + MISC_OFF);
    for (int u = C.tid; u < (LDS_BYTES - LDSCTL_OFF) / 4; u += NWAVES * 64) ((LAS unsigned*)(lds3 + LDSCTL_OFF))[u] = 0u;
    __syncthreads();
    unsigned char* ws = args.ws;
    gu32* ctl = (gu32*)(ws + WS_CTL);
    XcdBarrier bar; bar.bar = (unsigned*)(ctl + CW_BAR); bar.x = 0; bar.st = nullptr;
    if (N_LAUNCHES == 1) bar = xcd_barrier_post((unsigned*)(ctl + CW_BAR), MISC + 8);
    const bool merged23 = false && (N_LAUNCHES == 1) && C.G == 256;
    const bool grouped = (N_LAUNCHES == 1);
    if (grouped && C.tid == 0) __hip_atomic_store((unsigned*)ctl + CW_XID + C.vcu, xb_xcc_id() + 1u, RLX_AGENT);
    const int lo = args.ph_lo, hi = args.ph_hi;
#ifdef ONLY_PHASE
#define IN(k) ((k) == ONLY_PHASE && lo <= (k) && (k) < hi)
#else
#define IN(k) (lo <= (k) && (k) < hi)
#endif
#ifndef PROBE_XBAR
#define PROBE_XBAR 0
#endif
#define SEAM(k) do { if (IN(k) && IN((k) + 1)) { xcd_barrier(bar); if ((k) == 6) for (int xb_ = 0; xb_ < PROBE_XBAR; ++xb_) xcd_barrier(bar); } } while (0)
#define GSEAM(k, n) do { if (IN(k) && IN((k) + 1)) { if (grouped) grp_barrier(ctl, C.vcu, 4u * (n), MISC + 10); else xcd_barrier(bar); } } while (0)
#ifndef PROBE_MASK
#define PROBE_MASK 0
#endif
#define REPS(k) ((((PROBE_MASK) >> (k)) & 1) ? 2 : 1)
    bf16* xb = (bf16*)(ws + WS_XB);
    if (IN(0)) { for (int rep = 0; rep < REPS(0); ++rep) { p0_prologue(args, C); __syncthreads(); } SEAM(0); }
    if (grouped) { if (C.tid == 0) { const unsigned* xi = (const unsigned*)ctl + CW_XID + (C.vcu & ~3); const unsigned a0 = xb_ld((unsigned*)xi), a1 = xb_ld((unsigned*)xi + 1), a2 = xb_ld((unsigned*)xi + 2), a3 = xb_ld((unsigned*)xi + 3);
          MISC[10] = (a0 != 0u && a0 == a1 && a0 == a2 && a0 == a3) ? 1u : 2u;
          const unsigned* xj = (const unsigned*)ctl + CW_XID + (C.vcu & ~15); bool same16 = a0 != 0u;
          for (int i = 0; i < 16; ++i) same16 = same16 && (xb_ld((unsigned*)xj + i) == a0);
          MISC[11] = same16 ? 1u : 2u; }
        __syncthreads(); }
    if (IN(1)) for (int rep = 0; rep < REPS(1); ++rep) {
        pg8::Gemm g{xb, (const bf16*)(ws + WS_WIN0), M, EV_N - 512, DMODEL}; pg8::StaticOrder S; S.init(M, EV_N - 512, C.G, (int)blockIdx.x);
        pg8::EpiProj<0> E{(const float*)(ws + WS_RA0), (const float*)(ws + WS_ROPE), (bf16*)(ws + WS_QKV), nullptr, nullptr, (const float*)(ws + WS_GAIN), (float*)(ws + WS_KSUM), 0};
        pg8::gemm_phase<pg8::EpiProj<0>, pg8::StaticOrder, true, true>(lds3, g, S, E);
        if (rep + 1 == REPS(1)) SEAM(1); }
    if (IN(2)) {
        const int nr = C.G / 2;
        if (C.vcu < nr) { p2_route(args, C, C.vcu, nr);
            if (merged23) { sub_barrier(ctl, CW_GRP16 + 64 * (C.vcu >> 4), 16u, MISC + 11); const int hh = C.vcu >> 4;
                for (int idx = C.vcu & 15; idx < 62; idx += 16) p3_lists_item(args, C, hh + 8 * (idx / 31), idx % 31); } }
        else { pg8::Gemm g{xb, (const bf16*)(ws + WS_WIN0) + (size_t)(EV_N - 512) * DMODEL, M, 512, DMODEL}; PairOrder S{C.vcu - nr};
            pg8::EpiProj<0> E{(const float*)(ws + WS_RA0), (const float*)(ws + WS_ROPE), (bf16*)(ws + WS_QKV), nullptr, nullptr, (const float*)(ws + WS_GAIN), (float*)(ws + WS_KSUM), 12};
            pg8::gemm_phase<pg8::EpiProj<0>, PairOrder, true, true>(lds3, g, S, E); }
        SEAM(2); }
    if (IN(3) && !merged23) { for (int rep = 0; rep < REPS(3); ++rep) p3_lists(args, C); SEAM(3); }
    if (IN(4)) { for (int rep = 0; rep < REPS(4); ++rep) p4_attn_l0a(args, C); SEAM(4); }
    if (IN(5)) { for (int rep = 0; rep < REPS(5); ++rep) p5_attn_l0b(args, C); GSEAM(5, 1); }
    if (IN(6)) {
        pg8::Gemm g{(const bf16*)(ws + WS_AO), (const bf16*)(ws + WS_WOUT0), M, DMODEL, DMODEL};
        pg8::EpiResid E{args.in[0], args.out, xb, (float*)(ws + WS_RSP)};
        { GroupOrder S{4, C.vcu, C.G >> 2, M / 256}; pg8::gemm_phase<pg8::EpiResid, GroupOrder, true, true>(lds3, g, S, E); }
        GSEAM(6, 2); }
    if (IN(7)) for (int rep = 0; rep < REPS(7); ++rep) {
        pg8::Gemm g{xb, (const bf16*)(ws + WS_WQ0), M, DMODEL, DMODEL};
        pg8::EpiPeerQ E{(const float*)(ws + WS_RSP), (bf16*)(ws + WS_QP)};
        { GroupOrder S{4, C.vcu, C.G >> 2, M / 256}; pg8::gemm_phase<pg8::EpiPeerQ, GroupOrder, true, true>(lds3, g, S, E); }
        if (rep + 1 == REPS(7)) GSEAM(7, 3); }
    if (IN(8)) { peer_phase<false>(args, C, 0); GSEAM(8, 4); }
    if (IN(9)) for (int rep = 0; rep < REPS(9); ++rep) {
        pg8::Gemm g{xb, (const bf16*)(ws + WS_WIN1), M, OD_N, DMODEL};
        pg8::EpiProj<1> E{(const float*)(ws + WS_RA1), (const float*)(ws + WS_ROPE), (bf16*)(ws + WS_QKV), (bf16*)(ws + WS_QKV + 32 * MiB), (bf16*)(ws + WS_QKV + 36 * MiB), (const float*)(ws + WS_GAIN) + 256, nullptr, 0};
        { GroupOrder S{5, C.vcu, C.G >> 2, M / 256}; pg8::gemm_phase<pg8::EpiProj<1>, GroupOrder, true, true>(lds3, g, S, E); }
        if (CONV_L1_LATE == 2 && rep == 0) conv_pull(args, C, 1);
        if (rep + 1 == REPS(9)) SEAM(9); }
    if (IN(10)) { for (int rep = 0; rep < REPS(10); ++rep) p8_attn_l1(args, C); GSEAM(10, 5); }
    if (IN(11)) {
        pg8::Gemm g{(const bf16*)(ws + WS_AO), (const bf16*)(ws + WS_WOUT1), M, DMODEL, DMODEL};
        pg8::EpiResid E{args.out, args.out, xb, (float*)(ws + WS_RSP)};
        { GroupOrder S{4, C.vcu, C.G >> 2, M / 256}; pg8::gemm_phase<pg8::EpiResid, GroupOrder, true, true>(lds3, g, S, E); }
        GSEAM(11, 6); }
    if (IN(12)) for (int rep = 0; rep < REPS(12); ++rep) {
        pg8::Gemm g{xb, (const bf16*)(ws + WS_WQ1), M, DMODEL, DMODEL};
        pg8::EpiPeerQ E{(const float*)(ws + WS_RSP), (bf16*)(ws + WS_QP)};
        { GroupOrder S{4, C.vcu, C.G >> 2, M / 256}; pg8::gemm_phase<pg8::EpiPeerQ, GroupOrder, true, true>(lds3, g, S, E); }
        if (rep + 1 == REPS(12)) GSEAM(12, 7); }
    if (IN(13)) { peer_phase<true>(args, C, 1); }
#undef IN
#undef SEAM
}

extern "C" void kernel_launch(void* const* d_in, const int* in_sizes, int n_in, void* d_out, int out_size, void* d_ws, size_t ws_size, hipStream_t stream) {
    static int grid = 0;
    if (grid == 0) {
        if (n_in != 19 || in_sizes[0] != M * DMODEL || out_size != M * DMODEL || ws_size < WS_END) { fprintf(stderr, "kernel_launch: unexpected shapes (n_in %d, in0 %d, out %d, ws %zu); nothing launched\n", n_in, n_in > 0 ? in_sizes[0] : -1, out_size, ws_size); grid = -1; return; }
        int dev = 0, cus = 0, per_cu = 0;
        if (hipGetDevice(&dev) != hipSuccess || hipDeviceGetAttribute(&cus, hipDeviceAttributeMultiprocessorCount, dev) != hipSuccess) { grid = -1; return; }
        if (hipFuncSetAttribute((const void*)mk_fwd, hipFuncAttributeMaxDynamicSharedMemorySize, LDS_BYTES) != hipSuccess) { fprintf(stderr, "kernel_launch: hipFuncSetAttribute failed\n"); grid = -1; return; }
        if (hipOccupancyMaxActiveBlocksPerMultiprocessor(&per_cu, (const void*)mk_fwd, NWAVES * 64, LDS_BYTES) != hipSuccess || per_cu < 1) { fprintf(stderr, "kernel_launch: occupancy query reports %d workgroups per CU\n", per_cu); }
        (void)hipGetLastError();
        grid = cus > 256 ? 256 : (cus / 8) * 8;
        if (grid != 256) fprintf(stderr, "kernel_launch: %d CUs; the phase schedules assume 256\n", grid);
    }
    if (grid < 0) return;
    if (hipMemsetAsync((char*)d_ws + WS_CTL, 0, CTL_ZERO_BYTES, stream) != hipSuccess) { fprintf(stderr, "kernel_launch: hipMemsetAsync failed\n"); return; }
    Args a{};
    for (int i = 0; i < 19; ++i) a.in[i] = (const float*)d_in[i];
    a.out = (float*)d_out; a.ws = (unsigned char*)d_ws;
    for (int li = 0; li < N_LAUNCHES; ++li) {
        a.ph_lo = (N_LAUNCHES == 1) ? 0 : li; a.ph_hi = (N_LAUNCHES == 1) ? N_PHASES : li + 1; a.li = li;
        hipLaunchKernelGGL(mk_fwd, dim3(grid), dim3(NWAVES * 64), LDS_BYTES, stream, a);
        const hipError_t le = hipPeekAtLastError();
        if (le != hipSuccess) { fprintf(stderr, "kernel_launch: launch %d failed: %s\n", li, hipGetErrorName(le)); break; }
    }
}
```
